# Optimizing an MI355X kernel written in HIP

```python
import math
import jax, jax.numpy as jnp
from jax import lax
import numpy as np

D_MODEL = 1024
BATCH = 4
SEQ = 4096
DEPTH = 1

CHUNK = 64
EPS = 1e-6

SSM_EXPAND = 2
SSM_INNER = SSM_EXPAND * D_MODEL
SSM_HEAD_DIM = 64
SSM_HEADS = SSM_INNER // SSM_HEAD_DIM
SSM_STATE = 128
SSM_GROUPS = 4
CONV_WIDTH = 4
SSM_XBC = SSM_INNER + 2 * SSM_GROUPS * SSM_STATE

RWKV_DIM = D_MODEL
RWKV_HEAD_DIM = 64
RWKV_HEADS = RWKV_DIM // RWKV_HEAD_DIM
DECAY_LORA = 64
ICLR_LORA = 64
GN_EPS = RWKV_HEAD_DIM * 1e-5
RWKV_COLS = 4 * RWKV_DIM + DECAY_LORA + ICLR_LORA

N_BRANCH = 2
IN_COLS = SSM_INNER + SSM_XBC + SSM_HEADS + RWKV_COLS + N_BRANCH * D_MODEL

kernel_name = "hybrid_ssd_rwkv7_gated_merge"


def rms_norm(x, gain, eps=EPS):
    xf = x.astype(jnp.float32)
    y = xf * lax.rsqrt(jnp.mean(xf * xf, axis=-1, keepdims=True) + eps)
    return (y * gain.astype(jnp.float32)).astype(x.dtype)


def group_rms_norm(y, gain, groups, eps=EPS):
    b, s, c = y.shape
    yg = y.reshape(b, s, groups, c // groups)
    yg = yg * lax.rsqrt(jnp.mean(yg * yg, axis=-1, keepdims=True) + eps)
    return yg.reshape(b, s, c) * gain.astype(jnp.float32)


def causal_depthwise_conv(u, w, bias):
    c = u.shape[-1]
    out = lax.conv_general_dilated(
        u, w[:, None, :].astype(u.dtype), window_strides=(1,),
        padding=[(CONV_WIDTH - 1, 0)], dimension_numbers=("NWC", "WIO", "NWC"),
        feature_group_count=c)
    return out + bias.astype(u.dtype)


def ssd_chunked(xdt, a, bm, cm):
    b, s, h, p = xdt.shape
    g, n = bm.shape[2], bm.shape[3]
    j = h // g
    c = s // CHUNK
    l = CHUNK
    X = xdt.reshape(b, c, l, g, j, p)
    Bq = bm.reshape(b, c, l, g, n)
    Cq = cm.reshape(b, c, l, g, n)
    a_cum = jnp.cumsum(a.reshape(b, c, l, g, j), axis=2)

    causal = jnp.tril(jnp.ones((l, l), dtype=bool))
    seg = a_cum[:, :, :, None] - a_cum[:, :, None, :]
    decay = jnp.exp(jnp.where(causal[None, None, :, :, None, None], seg, -jnp.inf))
    scores = jnp.einsum("bclgn,bcsgn->bclsg", Cq, Bq)
    mix = scores[..., None] * decay
    y_diag = jnp.einsum("bclsgj,bcsgjp->bclgjp", mix, X)

    decay_states = jnp.exp(a_cum[:, :, -1:] - a_cum)
    states = jnp.einsum("bclgn,bclgjp->bcgjpn", Bq, X * decay_states[..., None])
    chunk_decay = jnp.exp(a_cum[:, :, -1])

    def chunk_step(carry, inp):
        st, dec = inp
        return carry * dec[..., None, None] + st, carry

    init = jnp.zeros((b, g, j, p, n), jnp.float32)
    _, prev = lax.scan(chunk_step, init,
                       (jnp.moveaxis(states, 1, 0), jnp.moveaxis(chunk_decay, 1, 0)))
    prev = jnp.moveaxis(prev, 0, 1)

    y_off = jnp.einsum("bclgn,bcgjpn->bclgjp", Cq, prev) * jnp.exp(a_cum)[..., None]
    return (y_diag + y_off).reshape(b, s, h, p)


def mamba2_branch(z, xbc, dt_raw, conv_w, conv_b, dt_bias, a_log, d_skip, norm_gain):
    b, s, _ = z.shape
    xbc = jax.nn.silu(causal_depthwise_conv(xbc, conv_w, conv_b)).astype(jnp.float32)
    xs, bm, cm = jnp.split(xbc, [SSM_INNER, SSM_INNER + SSM_GROUPS * SSM_STATE], axis=-1)
    xs = xs.reshape(b, s, SSM_HEADS, SSM_HEAD_DIM)
    bm = bm.reshape(b, s, SSM_GROUPS, SSM_STATE)
    cm = cm.reshape(b, s, SSM_GROUPS, SSM_STATE)
    dt = jax.nn.softplus(dt_raw.astype(jnp.float32) + dt_bias.astype(jnp.float32))
    A = -jnp.exp(a_log.astype(jnp.float32))
    y = ssd_chunked(xs * dt[..., None], dt * A, bm, cm)
    y = y + d_skip.astype(jnp.float32)[:, None] * xs
    y = y.reshape(b, s, SSM_INNER) * jax.nn.silu(z.astype(jnp.float32))
    return group_rms_norm(y, norm_gain, SSM_GROUPS)


def wkv7_scan(r, w, k, v, kk, a):
    b, s, h, d = r.shape

    def step(S, inp):
        r_t, w_t, k_t, v_t, kk_t, a_t = inp
        s_kk = jnp.einsum("bhvk,bhk->bhv", S, kk_t)
        S = (S * w_t[:, :, None, :]
             - s_kk[..., None] * (kk_t * a_t)[:, :, None, :]
             + v_t[..., None] * k_t[:, :, None, :])
        return S, jnp.einsum("bhvk,bhk->bhv", S, r_t)

    xs = tuple(jnp.moveaxis(t, 1, 0) for t in (r, w, k, v, kk, a))
    S0 = jnp.zeros((b, h, d, d), jnp.float32)
    _, y = lax.scan(step, S0, xs)
    return jnp.moveaxis(y, 0, 1)


def rwkv7_branch(rw, mu, w0, w2, a0, a2, k_k, k_a, r_k, gn_gain, gn_bias):
    b, s, _ = rw.shape
    rw = rw.astype(jnp.float32)
    prev = jnp.pad(rw, ((0, 0), (1, 0), (0, 0)))[:, :-1]
    rw = rw + mu.astype(jnp.float32) * (prev - rw)
    r, k, v, g, wd, ad = jnp.split(
        rw, [RWKV_DIM, 2 * RWKV_DIM, 3 * RWKV_DIM, 4 * RWKV_DIM, 4 * RWKV_DIM + DECAY_LORA], axis=-1)
    wlog = -jax.nn.softplus(-(w0.astype(jnp.float32) + jnp.tanh(wd) @ w2.astype(jnp.float32))) - 0.5
    decay = jnp.exp(-jnp.exp(wlog))
    a = jax.nn.sigmoid(a0.astype(jnp.float32) + ad @ a2.astype(jnp.float32))
    hs = (b, s, RWKV_HEADS, RWKV_HEAD_DIM)
    kk = (k * k_k.astype(jnp.float32)).reshape(hs)
    kk = kk / jnp.maximum(jnp.linalg.norm(kk, axis=-1, keepdims=True), 1e-12)
    k = k * (1.0 + (a - 1.0) * k_a.astype(jnp.float32))
    r, k, v, decay, a = (t.reshape(hs) for t in (r, k, v, decay, a))
    y = wkv7_scan(r, decay, k, v, kk, a)
    mean = jnp.mean(y, axis=-1, keepdims=True)
    var = jnp.mean(jnp.square(y - mean), axis=-1, keepdims=True)
    y = (y - mean) * lax.rsqrt(var + GN_EPS)
    y = y.reshape(b, s, RWKV_DIM) * gn_gain.astype(jnp.float32) + gn_bias.astype(jnp.float32)
    bonus = jnp.sum(r * k * r_k.astype(jnp.float32), axis=-1, keepdims=True) * v
    y = y + bonus.reshape(b, s, RWKV_DIM)
    return y * jax.nn.silu(g)


def hybrid_layer(x, pre_gain, w_in, b_gate, conv_w, conv_b, dt_bias, a_log, d_skip,
                 ssm_norm_gain, rwkv_mu, decay_w0, decay_w2, iclr_a0, iclr_a2, k_k, k_a,
                 r_k, gn_gain, gn_bias, w_branch_ssm, w_branch_rwkv, w_out, post_gain):
    h = rms_norm(x, pre_gain)
    p = jnp.einsum("bsd,de->bse", h, w_in)
    o1 = SSM_INNER
    o2 = o1 + SSM_XBC
    o3 = o2 + SSM_HEADS
    o4 = o3 + RWKV_COLS
    z, xbc, dt_raw, rw, gates = jnp.split(p, [o1, o2, o3, o4], axis=-1)

    y_ssm = mamba2_branch(z, xbc, dt_raw, conv_w, conv_b, dt_bias, a_log, d_skip, ssm_norm_gain)
    y_rwkv = rwkv7_branch(rw, rwkv_mu, decay_w0, decay_w2, iclr_a0, iclr_a2, k_k, k_a,
                          r_k, gn_gain, gn_bias)

    gates = jax.nn.sigmoid((gates + b_gate).astype(jnp.float32))
    g_ssm, g_rwkv = jnp.split(gates, 2, axis=-1)
    merged = (g_ssm * jnp.einsum("bsc,cd->bsd", y_ssm.astype(h.dtype), w_branch_ssm)
              + g_rwkv * jnp.einsum("bsc,cd->bsd", y_rwkv.astype(h.dtype), w_branch_rwkv))
    out = jnp.einsum("bsd,de->bse", merged.astype(h.dtype), w_out)
    return x + rms_norm(out, post_gain).astype(x.dtype)


def setup_inputs(seed: int = 0) -> dict:
    key = jax.random.key(seed)
    ks = jax.random.split(key, 25)
    L = DEPTH
    f32 = jnp.float32

    def nrm(k, shape, scale):
        return jax.random.normal(k, shape, f32) * scale

    def unif(k, shape, lo, hi):
        return jax.random.uniform(k, shape, f32, lo, hi)

    x = nrm(ks[0], (BATCH, SEQ, D_MODEL), 1.0)
    pre_gain = 1.0 + nrm(ks[1], (L, D_MODEL), 0.02)
    w_in = nrm(ks[2], (L, D_MODEL, IN_COLS), D_MODEL ** -0.5)
    b_gate = nrm(ks[3], (L, N_BRANCH * D_MODEL), 0.02)
    conv_w = nrm(ks[4], (L, CONV_WIDTH, SSM_XBC), CONV_WIDTH ** -0.5)
    conv_b = nrm(ks[5], (L, SSM_XBC), 0.02)
    dt0 = jnp.exp(unif(ks[6], (L, SSM_HEADS), math.log(1e-3), math.log(1e-1)))
    dt_bias = dt0 + jnp.log(-jnp.expm1(-dt0))
    a_log = jnp.log(unif(ks[7], (L, SSM_HEADS), 1.0, 16.0))
    d_skip = 1.0 + nrm(ks[8], (L, SSM_HEADS), 0.02)
    ssm_norm_gain = 1.0 + nrm(ks[9], (L, SSM_INNER), 0.02)
    rwkv_mu = unif(ks[10], (L, RWKV_COLS), 0.0, 1.0)
    decay_w0 = unif(ks[11], (L, RWKV_DIM), -6.0, 0.0)
    decay_w2 = nrm(ks[12], (L, DECAY_LORA, RWKV_DIM), 0.1 * DECAY_LORA ** -0.5)
    iclr_a0 = nrm(ks[13], (L, RWKV_DIM), 0.1)
    iclr_a2 = nrm(ks[14], (L, ICLR_LORA, RWKV_DIM), 0.5 * ICLR_LORA ** -0.5)
    k_k = 0.85 + nrm(ks[15], (L, RWKV_DIM), 0.02)
    k_a = 1.0 + nrm(ks[16], (L, RWKV_DIM), 0.02)
    r_k = nrm(ks[17], (L, RWKV_HEADS, RWKV_HEAD_DIM), 0.1)
    gn_gain = 1.0 + nrm(ks[18], (L, RWKV_DIM), 0.02)
    gn_bias = nrm(ks[19], (L, RWKV_DIM), 0.02)
    w_branch_ssm = nrm(ks[20], (L, SSM_INNER, D_MODEL), SSM_INNER ** -0.5)
    w_branch_rwkv = nrm(ks[21], (L, RWKV_DIM, D_MODEL), RWKV_DIM ** -0.5)
    w_out = nrm(ks[22], (L, D_MODEL, D_MODEL), D_MODEL ** -0.5)
    post_gain = 1.0 + nrm(ks[23], (L, D_MODEL), 0.02)
    return {"x": x, "pre_gain": pre_gain, "w_in": w_in, "b_gate": b_gate,
            "conv_w": conv_w, "conv_b": conv_b, "dt_bias": dt_bias, "a_log": a_log,
            "d_skip": d_skip, "ssm_norm_gain": ssm_norm_gain, "rwkv_mu": rwkv_mu,
            "decay_w0": decay_w0, "decay_w2": decay_w2, "iclr_a0": iclr_a0,
            "iclr_a2": iclr_a2, "k_k": k_k, "k_a": k_a, "r_k": r_k,
            "gn_gain": gn_gain, "gn_bias": gn_bias, "w_branch_ssm": w_branch_ssm,
            "w_branch_rwkv": w_branch_rwkv, "w_out": w_out, "post_gain": post_gain}


def reference(x, pre_gain, w_in, b_gate, conv_w, conv_b, dt_bias, a_log, d_skip,
              ssm_norm_gain, rwkv_mu, decay_w0, decay_w2, iclr_a0, iclr_a2, k_k, k_a,
              r_k, gn_gain, gn_bias, w_branch_ssm, w_branch_rwkv, w_out, post_gain):
    for layer in range(DEPTH):
        x = hybrid_layer(
            x, pre_gain[layer], w_in[layer], b_gate[layer], conv_w[layer], conv_b[layer],
            dt_bias[layer], a_log[layer], d_skip[layer], ssm_norm_gain[layer],
            rwkv_mu[layer], decay_w0[layer], decay_w2[layer], iclr_a0[layer],
            iclr_a2[layer], k_k[layer], k_a[layer], r_k[layer], gn_gain[layer],
            gn_bias[layer], w_branch_ssm[layer], w_branch_rwkv[layer], w_out[layer],
            post_gain[layer])
    return x
```

```cpp
#include <hip/hip_runtime.h>
#include <cstdio>
#include <cstdint>
#define MK_N_LAUNCHES 12
namespace pg8 {
#define PG8_LAS __attribute__((address_space(3)))
typedef unsigned short bf16_t;
typedef short bf16x8 __attribute__((ext_vector_type(8)));
typedef float f32x4 __attribute__((ext_vector_type(4)));
typedef unsigned u32x4 __attribute__((ext_vector_type(4)));
constexpr int BM = 256, BK = 64, HALF = 128, HTB = HALF * BK * 2  , STAGE_BYTES = 8 * HTB, NXCD = 8, WGM = 8;

__host__ __device__ __forceinline__ int lds_byte(int r, int c) { const int st = (r >> 4) * 2 + (c >> 5), rr = r & 15, cc = c & 31, ob = rr * 64 + cc * 2; return st * 1024 + (ob ^ (((ob >> 9) & 1) << 5)); }
__host__ __device__ __forceinline__ void stage_rc(int b, int& R, int& C) { const int st = b / 1024, sb = b % 1024, swz = sb ^ (((sb >> 9) & 1) << 5); R = (st >> 1) * 16 + swz / 64; C = (st & 1) * 32 + (swz % 64) / 2; }
__host__ __device__ __forceinline__ int perm32(int rho) { const int n = rho >> 4, i = rho & 15; return 8 * (i >> 2) + 4 * n + (i & 3); }

struct Unit { int pm, pn; };
struct Gemm { const bf16_t* A; const bf16_t* Bt; int M, N, K; };

struct StaticOrder {
    int nM, nN, nwg, G, c;
    __host__ __device__ void init(int M, int N, int G_, int c_) { nM = M / BM; nN = N / BM; nwg = nM * nN; G = G_; c = c_; }
    __host__ __device__ bool next(int i, Unit& u) const {
        const long L = (long)i * G + c; if (L >= nwg) return false;
        int wgid = (int)L; { const int q = nwg / NXCD, r = nwg % NXCD, xcd = wgid % NXCD, off = wgid / NXCD; wgid = (xcd < r ? xcd * (q + 1) : r * (q + 1) + (xcd - r) * q) + off; }
        const int nig = WGM * nN, gid = wgid / nig, fm = gid * WGM, gsz = (nM - fm) < WGM ? (nM - fm) : WGM;
        u.pm = fm + ((wgid % nig) % gsz); u.pn = (wgid % nig) / gsz; return true;
    }
    __device__ __forceinline__ void a_ready(const Unit&) const {}
    __device__ __forceinline__ void done(const Unit&) const {}
};

__device__ __forceinline__ unsigned cvt_pk_bf16(float lo, float hi) { unsigned r; asm volatile("v_cvt_pk_bf16_f32 %0, %1, %2" : "=v"(r) : "v"(lo), "v"(hi)); return r; }
__device__ __forceinline__ float bf_lo(unsigned w) { return __builtin_bit_cast(float, w << 16); }
__device__ __forceinline__ float bf_hi(unsigned w) { return __builtin_bit_cast(float, w & 0xffff0000u); }
__device__ __forceinline__ float sigmoidf_(float x) { return 1.0f / (1.0f + __expf(-x)); }
typedef unsigned u32x2 __attribute__((ext_vector_type(2)));

struct EpiRW {
    static constexpr bool PERM = true, AFTER_DRAIN = false;
    bf16_t* RKVG; bf16_t* HALO; float* SMALL; int Mrows;
    __device__ __forceinline__ void operator()(const f32x4 (&acc)[2][2][4][2], const Unit& u, int wr, int wc, int fr, int fq) const {
        const int row0 = u.pm * BM + wr * 64 + fr;
        if (u.pn < 16) {
            bf16_t* base = RKVG + (size_t)(u.pn >> 2) * ((size_t)Mrows * 1024);
            const int col0 = (u.pn & 3) * 256 + wc * 32 + 8 * fq;
#pragma unroll
            for (int ai = 0; ai < 2; ++ai)
#pragma unroll
                for (int m = 0; m < 4; ++m) { const int row = row0 + ai * HALF + m * 16; bf16_t* rowp = base + (size_t)row * 1024 + col0;
#pragma unroll
                    for (int bj = 0; bj < 2; ++bj) { const f32x4 v0 = acc[ai][bj][m][0], v1 = acc[ai][bj][m][1];
                        u32x4 w; w.x = cvt_pk_bf16(v0[0], v0[1]); w.y = cvt_pk_bf16(v0[2], v0[3]); w.z = cvt_pk_bf16(v1[0], v1[1]); w.w = cvt_pk_bf16(v1[2], v1[3]);
                        *(u32x4*)(rowp + bj * HALF) = w;
                        if (m == 3 && fr == 15) *(u32x4*)(HALO + (size_t)(row >> 6) * 4096 + u.pn * 256 + wc * 32 + 8 * fq + bj * HALF) = w; } }
        } else {
            const int col0 = wc * 32 + 8 * fq;
#pragma unroll
            for (int ai = 0; ai < 2; ++ai)
#pragma unroll
                for (int m = 0; m < 4; ++m) { float* rowp = SMALL + (size_t)(row0 + ai * HALF + m * 16) * 256 + col0;
#pragma unroll
                    for (int bj = 0; bj < 2; ++bj) { *(f32x4*)(rowp + bj * HALF) = acc[ai][bj][m][0]; *(f32x4*)(rowp + bj * HALF + 4) = acc[ai][bj][m][1]; } }
        }
    }
};
struct EpiSSD {
    static constexpr bool PERM = true, AFTER_DRAIN = false;
    bf16_t* Z; bf16_t* XBC;
    __device__ __forceinline__ void operator()(const f32x4 (&acc)[2][2][4][2], const Unit& u, int wr, int wc, int fr, int fq) const {
        const int row0 = u.pm * BM + wr * 64 + fr;
        bf16_t* base; int ldc, colt;
        if (u.pn < 8) { base = Z; ldc = 2048; colt = u.pn * 256; } else { base = XBC; ldc = 3072; colt = (u.pn - 8) * 256; }
        const int col0 = colt + wc * 32 + 8 * fq;
#pragma unroll
        for (int ai = 0; ai < 2; ++ai)
#pragma unroll
            for (int m = 0; m < 4; ++m) { bf16_t* rowp = base + (size_t)(row0 + ai * HALF + m * 16) * ldc + col0;
#pragma unroll
                for (int bj = 0; bj < 2; ++bj) { const f32x4 v0 = acc[ai][bj][m][0], v1 = acc[ai][bj][m][1];
                    u32x4 w; w.x = cvt_pk_bf16(v0[0], v0[1]); w.y = cvt_pk_bf16(v0[2], v0[3]); w.z = cvt_pk_bf16(v1[0], v1[1]); w.w = cvt_pk_bf16(v1[2], v1[3]);
                    *(u32x4*)(rowp + bj * HALF) = w; } }
    }
};
struct EpiGate {
    static constexpr bool PERM = true, AFTER_DRAIN = false;
    bf16_t* O; const float* bias;
    __device__ __forceinline__ void operator()(const f32x4 (&acc)[2][2][4][2], const Unit& u, int wr, int wc, int fr, int fq) const {
        const int row0 = u.pm * BM + wr * 64 + fr; const int col0 = u.pn * BM + wc * 32 + 8 * fq;
        f32x4 bv[2][2];
#pragma unroll
        for (int bj = 0; bj < 2; ++bj)
#pragma unroll
            for (int n = 0; n < 2; ++n) bv[bj][n] = *(const f32x4*)(bias + col0 + bj * HALF + 4 * n);
#pragma unroll
        for (int ai = 0; ai < 2; ++ai)
#pragma unroll
            for (int m = 0; m < 4; ++m) { bf16_t* rowp = O + (size_t)(row0 + ai * HALF + m * 16) * 2048 + col0;
#pragma unroll
                for (int bj = 0; bj < 2; ++bj) { f32x4 v0 = acc[ai][bj][m][0] + bv[bj][0], v1 = acc[ai][bj][m][1] + bv[bj][1];
#pragma unroll
                    for (int j = 0; j < 4; ++j) { v0[j] = sigmoidf_(v0[j]); v1[j] = sigmoidf_(v1[j]); }
                    u32x4 w; w.x = cvt_pk_bf16(v0[0], v0[1]); w.y = cvt_pk_bf16(v0[2], v0[3]); w.z = cvt_pk_bf16(v1[0], v1[1]); w.w = cvt_pk_bf16(v1[2], v1[3]);
                    *(u32x4*)(rowp + bj * HALF) = w; } }
    }
};
struct EpiT1 {
    static constexpr bool PERM = false, AFTER_DRAIN = false;
    float* T1; const bf16_t* GATES;
    __device__ __forceinline__ void operator()(const f32x4 (&acc)[2][2][4][2], const Unit& u, int wr, int wc, int fr, int fq) const {
        const int row0 = u.pm * BM + wr * 64 + fr, col0 = u.pn * BM + wc * 32 + 4 * fq;
#pragma unroll
        for (int ai = 0; ai < 2; ++ai)
#pragma unroll
            for (int m = 0; m < 4; ++m) { const size_t row = (size_t)(row0 + ai * HALF + m * 16);
#pragma unroll
                for (int bj = 0; bj < 2; ++bj)
#pragma unroll
                    for (int n = 0; n < 2; ++n) { const int c = col0 + bj * HALF + n * 16; const u32x2 g = *(const u32x2*)(GATES + row * 2048 + c);
                        f32x4 v = acc[ai][bj][m][n]; v[0] *= bf_lo(g.x); v[1] *= bf_hi(g.x); v[2] *= bf_lo(g.y); v[3] *= bf_hi(g.y);
                        *(f32x4*)(T1 + row * 1024 + c) = v; } }
    }
};
struct EpiMerge {
    static constexpr bool PERM = true, AFTER_DRAIN = false;
    bf16_t* O; const float* T1; const bf16_t* GATES;
    __device__ __forceinline__ void operator()(const f32x4 (&acc)[2][2][4][2], const Unit& u, int wr, int wc, int fr, int fq) const {
        const int row0 = u.pm * BM + wr * 64 + fr; const int col0 = u.pn * BM + wc * 32 + 8 * fq;
#pragma unroll
        for (int ai = 0; ai < 2; ++ai)
#pragma unroll
            for (int m = 0; m < 4; ++m) { const size_t row = (size_t)(row0 + ai * HALF + m * 16);
#pragma unroll
                for (int bj = 0; bj < 2; ++bj) { const int c = col0 + bj * HALF;
                    const u32x4 g = *(const u32x4*)(GATES + row * 2048 + 1024 + c);
                    const f32x4 t0 = *(const f32x4*)(T1 + row * 1024 + c), t1 = *(const f32x4*)(T1 + row * 1024 + c + 4);
                    f32x4 v0 = acc[ai][bj][m][0], v1 = acc[ai][bj][m][1];
                    v0[0] = t0[0] + bf_lo(g.x) * v0[0]; v0[1] = t0[1] + bf_hi(g.x) * v0[1]; v0[2] = t0[2] + bf_lo(g.y) * v0[2]; v0[3] = t0[3] + bf_hi(g.y) * v0[3];
                    v1[0] = t1[0] + bf_lo(g.z) * v1[0]; v1[1] = t1[1] + bf_hi(g.z) * v1[1]; v1[2] = t1[2] + bf_lo(g.w) * v1[2]; v1[3] = t1[3] + bf_hi(g.w) * v1[3];
                    u32x4 w; w.x = cvt_pk_bf16(v0[0], v0[1]); w.y = cvt_pk_bf16(v0[2], v0[3]); w.z = cvt_pk_bf16(v1[0], v1[1]); w.w = cvt_pk_bf16(v1[2], v1[3]);
                    *(u32x4*)(O + row * 1024 + c) = w; } }
    }
};
struct EpiF32 {
    static constexpr bool PERM = false, AFTER_DRAIN = false;
    float* C; int ldc;
    __device__ __forceinline__ void operator()(const f32x4 (&acc)[2][2][4][2], const Unit& u, int wr, int wc, int fr, int fq) const {
        const int row0 = u.pm * BM + wr * 64 + fr, col0 = u.pn * BM + wc * 32 + 4 * fq;
#pragma unroll
        for (int ai = 0; ai < 2; ++ai)
#pragma unroll
            for (int m = 0; m < 4; ++m) { float* rowp = C + (size_t)(row0 + ai * HALF + m * 16) * ldc + col0;
#pragma unroll
                for (int bj = 0; bj < 2; ++bj)
#pragma unroll
                    for (int n = 0; n < 2; ++n) *(f32x4*)(rowp + bj * HALF + n * 16) = acc[ai][bj][m][n]; }
    }
};

template <class Epi, class Sched, bool ALIGN_EPI = false, bool SP2 = false>
__device__ __forceinline__ void gemm_phase(PG8_LAS unsigned char* lds, const Gemm g, const Sched& S, const Epi& E) {
    const int tid = threadIdx.x, wid = __builtin_amdgcn_readfirstlane(tid >> 6), lane = tid & 63, wr = wid >> 2, wc = wid & 3, fr = lane & 15, fq = lane >> 4;
    const int K = g.K, nt = K / BK;
    unsigned voffA[2], voffB[2];
#pragma unroll
    for (int i = 0; i < 2; ++i) { int R, C; stage_rc(tid * 16 + i * 8192, R, C); const int Rb = Epi::PERM ? ((R & ~31) + perm32(R & 31)) : R;
        voffA[i] = (unsigned)(R * K + C) * 2u; voffB[i] = (unsigned)(Rb * K + C) * 2u; }
    const size_t kstep = (size_t)(BK * 2);
    const size_t hstep = (size_t)HALF * K * 2;
    const size_t tstep = 2 * hstep;
    const unsigned ldsw = (unsigned)wid * 1024u;
    const int aoff = lds_byte(wr * 64 + fr, fq * 8), boff = lds_byte(wc * 32 + fr, fq * 8);
#define PG8_SA(b, h) (((b) * 2 + (h)) * HTB)
#define PG8_SB(b, h) ((4 + (b) * 2 + (h)) * HTB)
#define PG8_STAGE(bufoff, gbase, voff) do { _Pragma("unroll") for (int _i = 0; _i < 2; ++_i) \
        __builtin_amdgcn_global_load_lds((const unsigned*)((const char*)(gbase) + (voff)[_i]), (PG8_LAS unsigned*)(lds + (bufoff) + ldsw + _i * 8192), 16, 0, 0); } while (0)
#define PG8_LDA(dst, b, h) do { _Pragma("unroll") for (int m = 0; m < 4; ++m) _Pragma("unroll") for (int k = 0; k < 2; ++k) dst[m][k] = *(const PG8_LAS bf16x8*)(lds + PG8_SA(b, h) + aoff + m * 2048 + k * 1024); } while (0)
#define PG8_LDB(dst, b, h) do { _Pragma("unroll") for (int n = 0; n < 2; ++n) _Pragma("unroll") for (int k = 0; k < 2; ++k) dst[n][k] = *(const PG8_LAS bf16x8*)(lds + PG8_SB(b, h) + boff + n * 2048 + k * 1024); } while (0)
#define PG8_MMA(ai, bj, At, Bt) do { __builtin_amdgcn_s_setprio(1); _Pragma("unroll") for (int m = 0; m < 4; ++m) _Pragma("unroll") for (int n = 0; n < 2; ++n) _Pragma("unroll") for (int k = 0; k < 2; ++k) \
        acc[ai][bj][m][n] = __builtin_amdgcn_mfma_f32_16x16x32_bf16(Bt[n][k], At[m][k], acc[ai][bj][m][n], 0, 0, 0); __builtin_amdgcn_s_setprio(0); } while (0)
#define PG8_WAIT_V(n) asm volatile("s_waitcnt vmcnt(" #n ")" ::: "memory")
#define PG8_WAIT_L(n) asm volatile("s_waitcnt lgkmcnt(" #n ")" ::: "memory")
#define PG8_BAR __builtin_amdgcn_s_barrier()
#define PG8_SCHED __builtin_amdgcn_sched_barrier(0)
    Unit cur, nxt; int ui = 0;
    if (!S.next(0, cur)) return;
    f32x4 acc[2][2][4][2];
#pragma unroll
    for (int a = 0; a < 2; ++a)
#pragma unroll
        for (int b = 0; b < 2; ++b)
#pragma unroll
            for (int m = 0; m < 4; ++m)
#pragma unroll
                for (int n = 0; n < 2; ++n) acc[a][b][m][n] = (f32x4){0.f, 0.f, 0.f, 0.f};
    bf16x8 At[4][2], B0[2][2], B1[2][2];
    const char* cA = (const char*)g.A + (size_t)cur.pm * tstep; const char* cB = (const char*)g.Bt + (size_t)cur.pn * tstep;
    S.a_ready(cur);
    if constexpr (SP2) {
        PG8_STAGE(PG8_SB(0, 0), cB, voffB); PG8_STAGE(PG8_SB(0, 1), cB + hstep, voffB); PG8_STAGE(PG8_SA(0, 0), cA, voffA); PG8_STAGE(PG8_SA(0, 1), cA + hstep, voffA);
        if (wr == 1) PG8_BAR;
        PG8_WAIT_V(2); PG8_BAR;
        PG8_STAGE(PG8_SB(1, 0), cB + kstep, voffB); PG8_STAGE(PG8_SA(1, 0), cA + kstep, voffA); PG8_STAGE(PG8_SB(1, 1), cB + hstep + kstep, voffB);
        PG8_WAIT_V(6); PG8_BAR;
    } else {
        PG8_STAGE(PG8_SB(0, 0), cB, voffB); PG8_STAGE(PG8_SA(0, 0), cA, voffA); PG8_STAGE(PG8_SB(0, 1), cB + hstep, voffB); PG8_STAGE(PG8_SA(0, 1), cA + hstep, voffA);
        if (wr == 1) PG8_BAR;
        PG8_WAIT_V(4); PG8_BAR;
        PG8_STAGE(PG8_SB(1, 0), cB + kstep, voffB); PG8_STAGE(PG8_SA(1, 0), cA + kstep, voffA); PG8_STAGE(PG8_SB(1, 1), cB + hstep + kstep, voffB);
        PG8_WAIT_V(6); PG8_BAR;
    }
    for (;;) {
        const bool has_next = S.next(ui + 1, nxt);
        const char* nA = has_next ? (const char*)g.A + (size_t)nxt.pm * tstep : cA; const char* nB = has_next ? (const char*)g.Bt + (size_t)nxt.pn * tstep : cB;
        for (int t = 0; t < nt; t += 2) {
            const bool last = (t == nt - 2);
            const char* a1 = cA + (size_t)(t + 1) * kstep;
            const char* a2 = last ? nA : cA + (size_t)(t + 2) * kstep; const char* b2 = last ? nB : cB + (size_t)(t + 2) * kstep;
            const char* a3 = a2 + kstep; const char* b3 = b2 + kstep;
            if (last && has_next) S.a_ready(nxt);
            if constexpr (SP2) {
            PG8_LDB(B0, 0, 0); PG8_LDB(B1, 0, 1); PG8_SCHED; PG8_LDA(At, 0, 0); PG8_STAGE(PG8_SA(1, 1), a1 + hstep, voffA);
            PG8_WAIT_V(8); PG8_WAIT_L(0); PG8_BAR; PG8_MMA(0, 0, At, B0); PG8_MMA(0, 1, At, B1); PG8_BAR; PG8_SCHED;
            PG8_LDA(At, 0, 1); PG8_STAGE(PG8_SB(0, 0), b2, voffB); PG8_STAGE(PG8_SB(0, 1), b2 + hstep, voffB); PG8_STAGE(PG8_SA(0, 0), a2, voffA);
            PG8_WAIT_V(8); PG8_WAIT_L(0); PG8_BAR; PG8_MMA(1, 0, At, B0); PG8_MMA(1, 1, At, B1); PG8_BAR; PG8_SCHED;
            PG8_LDB(B0, 1, 0); PG8_LDB(B1, 1, 1); PG8_SCHED; PG8_LDA(At, 1, 0); PG8_STAGE(PG8_SA(0, 1), a2 + hstep, voffA);
            PG8_WAIT_V(8); PG8_WAIT_L(0); PG8_BAR; PG8_MMA(0, 0, At, B0); PG8_MMA(0, 1, At, B1); PG8_BAR; PG8_SCHED;
            PG8_LDA(At, 1, 1); PG8_STAGE(PG8_SB(1, 0), b3, voffB); PG8_STAGE(PG8_SB(1, 1), b3 + hstep, voffB); PG8_STAGE(PG8_SA(1, 0), a3, voffA);
            PG8_WAIT_V(8); PG8_WAIT_L(0); PG8_BAR; PG8_MMA(1, 0, At, B0); PG8_MMA(1, 1, At, B1); PG8_BAR; PG8_SCHED;
            } else {
            PG8_LDB(B0, 0, 0); PG8_SCHED; PG8_LDA(At, 0, 0); PG8_STAGE(PG8_SA(1, 1), a1 + hstep, voffA);
            PG8_WAIT_L(8); PG8_BAR; PG8_WAIT_L(0); PG8_MMA(0, 0, At, B0); PG8_BAR; PG8_SCHED;
            PG8_LDB(B1, 0, 1); PG8_STAGE(PG8_SB(0, 0), b2, voffB);
            PG8_BAR; PG8_WAIT_L(0); PG8_MMA(0, 1, At, B1); PG8_BAR;
            PG8_LDA(At, 0, 1); PG8_STAGE(PG8_SA(0, 0), a2, voffA);
            PG8_BAR; PG8_WAIT_L(0); PG8_MMA(1, 0, At, B0); PG8_BAR; PG8_SCHED;
            PG8_STAGE(PG8_SB(0, 1), b2 + hstep, voffB);
            PG8_WAIT_V(6); PG8_BAR; PG8_MMA(1, 1, At, B1); PG8_BAR;
            PG8_LDB(B0, 1, 0); PG8_SCHED; PG8_LDA(At, 1, 0); PG8_STAGE(PG8_SA(0, 1), a2 + hstep, voffA);
            PG8_WAIT_L(8); PG8_BAR; PG8_WAIT_L(0); PG8_MMA(0, 0, At, B0); PG8_BAR; PG8_SCHED;
            PG8_LDB(B1, 1, 1); PG8_STAGE(PG8_SB(1, 0), b3, voffB);
            PG8_BAR; PG8_WAIT_L(0); PG8_MMA(0, 1, At, B1); PG8_BAR;
            PG8_LDA(At, 1, 1); PG8_STAGE(PG8_SA(1, 0), a3, voffA);
            PG8_BAR; PG8_WAIT_L(0); PG8_MMA(1, 0, At, B0); PG8_BAR; PG8_SCHED;
            PG8_STAGE(PG8_SB(1, 1), b3 + hstep, voffB);
            PG8_WAIT_V(6); PG8_BAR; PG8_MMA(1, 1, At, B1); PG8_BAR;
            }
        }
        if constexpr (ALIGN_EPI) { if (wr == 0) PG8_BAR; }
        if constexpr (!Epi::AFTER_DRAIN) { E(acc, cur, wr, wc, fr, fq); S.done(cur); }
        if (!has_next) break;
#pragma unroll
        for (int a = 0; a < 2; ++a)
#pragma unroll
            for (int b = 0; b < 2; ++b)
#pragma unroll
                for (int m = 0; m < 4; ++m)
#pragma unroll
                    for (int n = 0; n < 2; ++n) acc[a][b][m][n] = (f32x4){0.f, 0.f, 0.f, 0.f};
        cur = nxt; cA = nA; cB = nB; ++ui;
        if constexpr (ALIGN_EPI) { if (wr == 1) PG8_BAR; }
    }
    PG8_WAIT_V(0);
    if constexpr (!ALIGN_EPI) { if (wr == 0) PG8_BAR; }
    PG8_BAR;
    if constexpr (Epi::AFTER_DRAIN) { E.fused(acc, cur, wr, wc, fr, fq, lds, wid, lane); S.done(cur); }
#undef PG8_SA
#undef PG8_SB
#undef PG8_STAGE
#undef PG8_LDA
#undef PG8_LDB
#undef PG8_MMA
#undef PG8_WAIT_V
#undef PG8_WAIT_L
#undef PG8_BAR
#undef PG8_SCHED
}
}

#ifndef PG8_SP2
#define PG8_SP2 true
#endif
#ifndef PG8_ALIGN
#define PG8_ALIGN true
#endif
constexpr int NWAVES = 8;
#ifndef MK_N_LAUNCHES
#define MK_N_LAUNCHES 1
#endif
constexpr int N_PHASES = 12;
constexpr int N_LAUNCHES = MK_N_LAUNCHES;

constexpr int NB = 4, SEQ = 4096, D = 1024, M = NB * SEQ;
constexpr int IN_COLS = 11424;
constexpr int C_Z = 0, C_XBC = 2048, C_DT = 5120, C_RW = 5152, C_WD = 9248, C_AD = 9312, C_GATE = 9376;
constexpr int NT_RW = 17, NT_SSD = 20, NT_GATE = 8, NT_IN = NT_RW + NT_SSD + NT_GATE;
constexpr int NCHUNK = SEQ / 64;
constexpr float EPS = 1e-6f, GN_EPS = 64.0f * 1e-5f;

constexpr size_t MiB = 1u << 20;
constexpr size_t WS_CTL = 0, CTL_ZERO_BYTES = 64 * 1024;
constexpr size_t WS_WIN = 1 * MiB;
constexpr size_t WS_WSSM = 24 * MiB, WS_WRWKV = 28 * MiB, WS_WOUT = 30 * MiB;
constexpr size_t WS_RKVG = 32 * MiB;
constexpr size_t WS_GH = 160 * MiB;
constexpr size_t WS_SMALL = 224 * MiB;
constexpr size_t WS_HALO = 240 * MiB;
constexpr size_t WS_SB = 242 * MiB;
constexpr size_t WS_SSQ = 243 * MiB;
constexpr size_t WS_END = 256 * MiB;
constexpr size_t WS_XBC = 32 * MiB;
constexpr size_t WS_Z = 160 * MiB;
constexpr size_t WS_GATES = 32 * MiB;
constexpr size_t WS_MERGED = 96 * MiB;
constexpr size_t WS_YRWKV = WS_RKVG + 3 * 32 * MiB;
constexpr int CW_TMO = 0, CW_CODE = 1, CW_BAR = 4096;

constexpr int RING_OFF = 0, RING_BYTES = 131072;
constexpr int LDS_BYTES = 163840;
constexpr int MISC_OFF = LDS_BYTES - 256;
constexpr int LDSCTL_OFF = MISC_OFF;

#define GAS __attribute__((address_space(1)))
#define LAS __attribute__((address_space(3)))
typedef unsigned short bf16;
typedef unsigned v4u __attribute__((ext_vector_type(4)));
typedef float f32x4 __attribute__((ext_vector_type(4)));
typedef short bf16x8 __attribute__((ext_vector_type(8)));
typedef GAS unsigned gu32;
typedef GAS unsigned long long gu64;
#define RLX_AGENT __ATOMIC_RELAXED, __HIP_MEMORY_SCOPE_AGENT
#define LDS_WAIT() asm volatile("s_waitcnt lgkmcnt(0)" ::: "memory")
#define VM_WAIT() asm volatile("s_waitcnt vmcnt(0)" ::: "memory")
__device__ __forceinline__ unsigned long long rt() { return __builtin_amdgcn_s_memrealtime(); }
__device__ __forceinline__ unsigned f2bf(float f) { unsigned u = __builtin_bit_cast(unsigned, f); return (u + 0x7fffu + ((u >> 16) & 1u)) >> 16; }
__device__ __forceinline__ unsigned pk2(float lo, float hi) { return f2bf(lo) | (f2bf(hi) << 16); }

#define XB_TMO      128
#define XB_XCNT(j)  (256  + 64 * (j))
#define XB_XSUB(j)  (1280 + 64 * (j))
#define XB_XGEN(j)  (2304 + 64 * (j))
#define XB_TOP      3328
#define XB_TOPGEN   3392
#define XCD_BAR_WORDS 3456
#define XB_SPIN_CAP (1u << 18)

__device__ __forceinline__ unsigned xb_ld(unsigned* p)              { return __hip_atomic_load(p, __ATOMIC_RELAXED, __HIP_MEMORY_SCOPE_AGENT); }
__device__ __forceinline__ unsigned xb_add(unsigned* p, unsigned v) { return __hip_atomic_fetch_add(p, v, __ATOMIC_RELAXED, __HIP_MEMORY_SCOPE_AGENT); }
__device__ __forceinline__ unsigned xb_xcc_id() { return (unsigned)__builtin_amdgcn_s_getreg((3 << 11) | 20) & 0xFu; }
#define XB_SPIN(cond, bar) do { unsigned _sp = 0; while (cond) { __builtin_amdgcn_s_sleep(1); \
    if ((++_sp & 255u) == 0u) { if (xb_ld(&(bar)[XB_TMO])) break; if (_sp > XB_SPIN_CAP) { atomicAdd(&(bar)[XB_TMO], 1u); break; } } } } while (0)

struct XcdBarrier {
    unsigned* bar; unsigned x;
    volatile LAS unsigned* st;
};

__device__ __forceinline__ XcdBarrier xcd_barrier_post(unsigned* bar, volatile LAS unsigned* st) {
    XcdBarrier b; b.bar = bar; b.x = xb_xcc_id(); b.st = st;
    if (threadIdx.x == 0) (void)xb_add(&bar[XB_XCNT(b.x)], 1u);
    return b;
}
__device__ __forceinline__ void xcd_barrier_complete(unsigned* bar, unsigned x, unsigned& nloc, unsigned& nx) {
    const unsigned G = gridDim.x * gridDim.y * gridDim.z;
    unsigned sum, cnt, mine, sp = 0u;
    for (;;) {
        sum = 0u; cnt = 0u; mine = 0u;
#pragma unroll
        for (unsigned j = 0; j < 16; ++j) { const unsigned c = xb_ld(&bar[XB_XCNT(j)]); sum += c; cnt += (c > 0u) ? 1u : 0u; mine = (j == x) ? c : mine; }
        if (sum == G) break;
        __builtin_amdgcn_s_sleep(1);
        if ((++sp & 255u) == 0u) { if (xb_ld(&bar[XB_TMO])) break; if (sp > XB_SPIN_CAP) { atomicAdd(&bar[XB_TMO], 1u); break; } }
    }
    nloc = mine > 0u ? mine : 1u; nx = cnt > 0u ? cnt : 1u;
}

__device__ __forceinline__ void xcd_barrier(const XcdBarrier& b) {
    asm volatile("s_waitcnt vmcnt(0)" ::: "memory");
    __syncthreads();
    if (threadIdx.x == 0) {
        unsigned* bar = b.bar;
        __builtin_amdgcn_s_waitcnt(0);
        unsigned nloc = b.st[0], nx = b.st[1];
        if (nloc == 0u) { xcd_barrier_complete(bar, b.x, nloc, nx); b.st[0] = nloc; b.st[1] = nx; }
        const unsigned old = xb_add(&bar[XB_XSUB(b.x)], 1u);
        const unsigned gen = old / nloc;
        if (old + 1u == (gen + 1u) * nloc) {
            __builtin_amdgcn_fence(__ATOMIC_RELEASE, "agent");
            asm volatile("s_waitcnt vmcnt(0)" ::: "memory");
            const unsigned og = xb_add(&bar[XB_TOP], 1u);
            const unsigned tg = og / nx;
            if (og + 1u == (tg + 1u) * nx) xb_add(&bar[XB_TOPGEN], 1u);
            else XB_SPIN(xb_ld(&bar[XB_TOPGEN]) == tg, bar);
            __builtin_amdgcn_fence(__ATOMIC_ACQUIRE, "agent");
            xb_add(&bar[XB_XGEN(b.x)], 1u);
            asm volatile("s_waitcnt vmcnt(0)" ::: "memory");
        } else {
            XB_SPIN(xb_ld(&bar[XB_XGEN(b.x)]) == gen, bar);
            __builtin_amdgcn_fence(__ATOMIC_ACQUIRE, "agent");
            asm volatile("s_waitcnt vmcnt(0)" ::: "memory");
        }
    }
    __syncthreads();
}
struct Args { const float* in[24]; float* out; unsigned char* ws; int ph_lo, ph_hi, li, pad; };
struct Frame {
    LAS unsigned char* lds;
    volatile LAS unsigned* MISC;
    gu32* ctl;
    int tid, lane, wave;
    int vcu, G;
    float* out; unsigned char* ws;
};
__device__ __forceinline__ float wave_sum(float v) {
#pragma unroll
    for (int o = 1; o < 64; o <<= 1) v += __shfl_xor(v, o);
    return v;
}
__device__ __forceinline__ float bf2f(bf16 v) { return __builtin_bit_cast(float, (unsigned)v << 16); }
__device__ __forceinline__ float softplusf_(float x) { return x > 20.f ? x : log1pf(__expf(x)); }
__device__ __forceinline__ float siluf_(float x) { return x / (1.0f + __expf(-x)); }
__device__ __forceinline__ float sigm_(float x) { return 1.0f / (1.0f + __expf(-x)); }

__device__ __forceinline__ void p0_transpose_item(const float* W, int ldw, int sc0, bf16* WT, int Kd, int dr0, int k0, LAS float* scr, int lane) {
    if (sc0 >= 0) {
#pragma unroll 8
        for (int i = 0; i < 32; ++i) { const int kk = 2 * i + (lane >> 5); scr[kk * 33 + (lane & 31)] = W[(size_t)(k0 + kk) * ldw + sc0 + (lane & 31)]; }
    } else {
#pragma unroll 8
        for (int i = 0; i < 32; ++i) { const int kk = 2 * i + (lane >> 5); scr[kk * 33 + (lane & 31)] = 0.f; }
    }
    LDS_WAIT(); asm volatile("" ::: "memory");
    const int c = lane & 7;
#pragma unroll
    for (int j = 0; j < 4; ++j) { const int n = (lane >> 3) + 8 * j; const LAS float* s = scr + (8 * c) * 33 + n;
        v4u o; o.x = pk2(s[0 * 33], s[1 * 33]); o.y = pk2(s[2 * 33], s[3 * 33]); o.z = pk2(s[4 * 33], s[5 * 33]); o.w = pk2(s[6 * 33], s[7 * 33]);
        *(GAS v4u*)(WT + (size_t)(dr0 + n) * Kd + k0 + 8 * c) = o; }
    LDS_WAIT(); asm volatile("" ::: "memory");
}
__device__ __forceinline__ int win_src_col(int db) {
    if (db < 128) return C_RW + 32 * db;
    if (db < 136) { const int b = db - 128; if (b == 0) return C_DT; if (b <= 2) return C_WD + 32 * (b - 1); if (b <= 4) return C_AD + 32 * (b - 3); return -1; }
    if (db < 200) return C_Z + 32 * (db - 136);
    if (db < 296) return C_XBC + 32 * (db - 200);
    return C_GATE + 32 * (db - 296);
}
__device__ __forceinline__ void p0_prologue(const Args& args, Frame& F) {
    LAS float* scr = (LAS float*)(F.lds + RING_OFF + F.wave * 16384);
    const int gw = F.vcu * NWAVES + F.wave, NGW = F.G * NWAVES;
    bf16* Win_t = (bf16*)(F.ws + WS_WIN); bf16* Wssm_t = (bf16*)(F.ws + WS_WSSM); bf16* Wrwkv_t = (bf16*)(F.ws + WS_WRWKV); bf16* Wout_t = (bf16*)(F.ws + WS_WOUT);
    constexpr int I_IN = 16 * (NT_IN * 8), I_SSM = 32 * 32, I_RW = 16 * 32, I_OUT = 16 * 32;
    constexpr int NITEMS = I_IN + I_SSM + I_RW + I_OUT;
    for (int it = gw; it < NITEMS; it += NGW) {
        int r = it;
        if (r < I_IN) { const int kb = r / (NT_IN * 8), db = r % (NT_IN * 8); p0_transpose_item(args.in[2], IN_COLS, win_src_col(db), Win_t, D, 32 * db, 64 * kb, scr, F.lane); continue; } r -= I_IN;
        if (r < I_SSM) { const int kb = r / 32, nb = r % 32; p0_transpose_item(args.in[20], D, 32 * nb, Wssm_t, 2048, 32 * nb, 64 * kb, scr, F.lane); continue; } r -= I_SSM;
        if (r < I_RW) { const int kb = r / 32, nb = r % 32; p0_transpose_item(args.in[21], D, 32 * nb, Wrwkv_t, D, 32 * nb, 64 * kb, scr, F.lane); continue; } r -= I_RW;
        { const int kb = r / 32, nb = r % 32; p0_transpose_item(args.in[22], D, 32 * nb, Wout_t, D, 32 * nb, 64 * kb, scr, F.lane); }
    }
    bf16* H = (bf16*)F.out; const float* x = args.in[0]; const float* pg = args.in[1];
    f32x4 gv[4];
#pragma unroll
    for (int j = 0; j < 4; ++j) gv[j] = ((const GAS f32x4*)pg)[F.lane + 64 * j];
    for (int m = gw; m < M; m += NGW) {
        const GAS f32x4* xr = (const GAS f32x4*)(x + (size_t)m * D) + F.lane;
        f32x4 v[4]; float s = 0.f;
#pragma unroll
        for (int j = 0; j < 4; ++j) { v[j] = xr[64 * j]; s += (v[j].x * v[j].x + v[j].y * v[j].y) + (v[j].z * v[j].z + v[j].w * v[j].w); }
        const float rstd = 1.f / sqrtf(wave_sum(s) * (1.f / D) + EPS);
        GAS unsigned long long* o8 = (GAS unsigned long long*)(H + (size_t)m * D) + F.lane;
#pragma unroll
        for (int j = 0; j < 4; ++j) { const f32x4 w = v[j] * rstd * gv[j]; o8[64 * j] = (unsigned long long)pk2(w.x, w.y) | ((unsigned long long)pk2(w.z, w.w) << 32); }
    }
}

#define TS 65
#define TL(i) (Tb + (i) * (64 * TS))
__device__ __forceinline__ void rwkv_local_simple(const Args& args, Frame& F, int unit) {
    LAS float* Tb = (LAS float*)F.lds; LAS float* PL = Tb + 9 * 64 * TS;
    const int tid = F.tid, ch = tid & 63, tq = tid >> 6;
    const int h = unit & 15, c = (unit >> 4) & 63, b = unit >> 10;
    const int row0 = b * SEQ + c * 64, hc = h * 64 + ch;
    bf16* Rb = (bf16*)(F.ws + WS_RKVG); bf16* Kb = Rb + (size_t)M * 1024; bf16* Vb = Kb + (size_t)M * 1024;
    const bf16* HALO = (const bf16*)(F.ws + WS_HALO); const float* SMALL = (const float*)(F.ws + WS_SMALL);
    const float* mu = args.in[10]; const float* w0 = args.in[11]; const float* w2 = args.in[12]; const float* a0 = args.in[13]; const float* a2 = args.in[14];
    const float* k_k = args.in[15]; const float* k_a = args.in[16]; const float* r_k = args.in[17];
    { const float muw = mu[4096 + ch], mua = mu[4160 + ch];
#pragma unroll
      for (int i = 0; i < 8; ++i) { const int t = tq + 8 * i; const size_t rg = (size_t)(row0 + t);
        const float cw = SMALL[rg * 256 + 32 + ch], ca = SMALL[rg * 256 + 96 + ch];
        float pw = 0.f, pa = 0.f; if (c * 64 + t > 0) { pw = SMALL[(rg - 1) * 256 + 32 + ch]; pa = SMALL[(rg - 1) * 256 + 96 + ch]; }
        TL(0)[t * TS + ch] = tanhf(cw + muw * (pw - cw)); TL(1)[t * TS + ch] = ca + mua * (pa - ca); } }
    __syncthreads();
    { float wl[8], al[8];
#pragma unroll
      for (int i = 0; i < 8; ++i) { wl[i] = w0[hc]; al[i] = a0[hc]; }
#pragma unroll 2
      for (int j = 0; j < 64; ++j) { const float wv = w2[j * 1024 + hc], av = a2[j * 1024 + hc];
#pragma unroll
        for (int i = 0; i < 8; ++i) { const int t = tq + 8 * i; wl[i] += TL(0)[t * TS + j] * wv; al[i] += TL(1)[t * TS + j] * av; } }
      __syncthreads();
#pragma unroll
      for (int i = 0; i < 8; ++i) { const int t = tq + 8 * i; const float wlog = -softplusf_(-wl[i]) - 0.5f; TL(2)[t * TS + ch] = -__expf(wlog); TL(3)[t * TS + ch] = sigm_(al[i]); } }
    __syncthreads();
    { const float mur = mu[hc], muk = mu[1024 + hc], muv = mu[2048 + hc], kkc = k_k[hc], kac = k_a[hc];
#pragma unroll
      for (int i = 0; i < 8; ++i) { const int t = tq + 8 * i; const size_t rg = (size_t)(row0 + t);
        const float cr = bf2f(Rb[rg * 1024 + hc]), ck = bf2f(Kb[rg * 1024 + hc]), cv = bf2f(Vb[rg * 1024 + hc]);
        float pr = 0.f, pk = 0.f, pv = 0.f;
        if (t > 0) { pr = bf2f(Rb[(rg - 1) * 1024 + hc]); pk = bf2f(Kb[(rg - 1) * 1024 + hc]); pv = bf2f(Vb[(rg - 1) * 1024 + hc]); }
        else if (c > 0) { const bf16* hr = HALO + (size_t)((row0 >> 6) - 1) * 4096; pr = bf2f(hr[hc]); pk = bf2f(hr[1024 + hc]); pv = bf2f(hr[2048 + hc]); }
        const float rr = cr + mur * (pr - cr), kx = ck + muk * (pk - ck), vv = cv + muv * (pv - cv);
        const float a = TL(3)[t * TS + ch];
        TL(4)[t * TS + ch] = kx * kkc; TL(5)[t * TS + ch] = rr; TL(6)[t * TS + ch] = kx * (1.f + (a - 1.f) * kac); TL(7)[t * TS + ch] = vv; } }
    __syncthreads();
    { float nr[8];
#pragma unroll
      for (int i = 0; i < 8; ++i) nr[i] = 0.f;
#pragma unroll 2
      for (int j = 0; j < 64; ++j) {
#pragma unroll
        for (int i = 0; i < 8; ++i) { const float q = TL(4)[(tq + 8 * i) * TS + j]; nr[i] += q * q; } }
      if (ch == 0) {
#pragma unroll 1
        for (int i = 0; i < 8; ++i) { const int t = tq + 8 * i; float s = 0.f;
#pragma unroll 2
            for (int j = 0; j < 64; ++j) s += TL(5)[t * TS + j] * TL(6)[t * TS + j] * r_k[h * 64 + j];
            ((float*)(F.ws + WS_SB))[(size_t)(row0 + t) * 16 + h] = s; } }
      __syncthreads();
#pragma unroll
      for (int i = 0; i < 8; ++i) { const int t = tq + 8 * i; const float kk = TL(4)[t * TS + ch] / fmaxf(sqrtf(nr[i]), 1e-12f); TL(4)[t * TS + ch] = kk; TL(0)[t * TS + ch] = kk * TL(3)[t * TS + ch]; } }
    __syncthreads();
    if (tid < 64) { float cl = 0.f;
#pragma unroll 4
        for (int t = 0; t < 64; ++t) { cl += TL(2)[t * TS + tid]; TL(1)[t * TS + tid] = cl; } }
    __syncthreads();
#pragma unroll
    for (int i = 0; i < 8; ++i) { const int t = tq + 8 * i; const float cl = TL(1)[t * TS + ch], ld = TL(2)[t * TS + ch]; const float en = __expf(-cl);
        TL(6)[t * TS + ch] *= en; TL(0)[t * TS + ch] *= en; TL(4)[t * TS + ch] *= __expf(cl - ld); TL(5)[t * TS + ch] *= __expf(cl); if (t == 63) PL[ch] = __expf(cl); }
    __syncthreads();
    { float qb[8], qk[8], rk[8], rb[8];
#pragma unroll
      for (int i = 0; i < 8; ++i) { qb[i] = 0.f; qk[i] = 0.f; rk[i] = 0.f; rb[i] = 0.f; }
#pragma unroll 2
      for (int j = 0; j < 64; ++j) { const float bi = TL(0)[ch * TS + j], ki = TL(6)[ch * TS + j];
#pragma unroll
        for (int i = 0; i < 8; ++i) { const int t = tq + 8 * i; const float q = TL(4)[t * TS + j], r = TL(5)[t * TS + j]; qb[i] += q * bi; qk[i] += q * ki; rk[i] += r * ki; rb[i] += r * bi; } }
      __syncthreads();
#pragma unroll
      for (int i = 0; i < 8; ++i) { const int t = tq + 8 * i; const bool st = ch < t, in = ch <= t;
        TL(1)[t * TS + ch] = st ? qb[i] : 0.f; TL(2)[t * TS + ch] = st ? qk[i] : 0.f; TL(3)[t * TS + ch] = in ? rk[i] : 0.f; TL(8)[t * TS + ch] = in ? rb[i] : 0.f; } }
    __syncthreads();
    { float o[8];
#pragma unroll
      for (int i = 0; i < 8; ++i) o[i] = 0.f;
#pragma unroll 2
      for (int j = 0; j < 64; ++j) { const float vj = TL(7)[j * TS + ch];
#pragma unroll
        for (int i = 0; i < 8; ++i) o[i] += TL(2)[(tq + 8 * i) * TS + j] * vj; }
      __syncthreads();
#pragma unroll
      for (int i = 0; i < 8; ++i) TL(2)[(tq + 8 * i) * TS + ch] = o[i]; }
    __syncthreads();
    if (tid < 128) { LAS float* tile = (tid < 64) ? TL(4) : TL(2); const int col = tid & 63;
#pragma unroll 1
        for (int t = 1; t < 64; ++t) { float s = tile[t * TS + col];
#pragma unroll 4
            for (int i = 0; i < t; ++i) s -= TL(1)[t * TS + i] * tile[i * TS + col];
            tile[t * TS + col] = s; } }
    __syncthreads();
    { float o1[8], o2[8];
#pragma unroll
      for (int i = 0; i < 8; ++i) { o1[i] = TL(5)[(tq + 8 * i) * TS + ch]; o2[i] = 0.f; }
#pragma unroll 2
      for (int j = 0; j < 64; ++j) { const float qj = TL(4)[j * TS + ch], vj = TL(7)[j * TS + ch], xj = TL(2)[j * TS + ch];
#pragma unroll
        for (int i = 0; i < 8; ++i) { const int t = tq + 8 * i; const float arb = TL(8)[t * TS + j], ark = TL(3)[t * TS + j]; o1[i] -= arb * qj; o2[i] += ark * vj - arb * xj; } }
      __syncthreads();
#pragma unroll
      for (int i = 0; i < 8; ++i) { TL(5)[(tq + 8 * i) * TS + ch] = o1[i]; TL(3)[(tq + 8 * i) * TS + ch] = o2[i]; } }
    __syncthreads();
    { float g[8], hh[8];
#pragma unroll
      for (int i = 0; i < 8; ++i) { g[i] = 0.f; hh[i] = 0.f; }
#pragma unroll 2
      for (int t = 0; t < 64; ++t) { const float qh = TL(4)[t * TS + ch], vm = TL(7)[t * TS + ch], xx = TL(2)[t * TS + ch];
#pragma unroll
        for (int i = 0; i < 8; ++i) { const int k = tq + 8 * i; const float bt = TL(0)[t * TS + k], kt = TL(6)[t * TS + k]; g[i] += bt * qh; hh[i] += kt * vm - bt * xx; } }
      bf16* GH = (bf16*)(F.ws + WS_GH) + (size_t)((b * 16 + h) * 64 + c) * 8192;
#pragma unroll
      for (int i = 0; i < 8; ++i) { const int k = tq + 8 * i; const float pl = PL[k];
        GH[k * 64 + ch] = (bf16)f2bf(pl * ((k == ch ? 1.f : 0.f) - g[i])); GH[4096 + k * 64 + ch] = (bf16)f2bf(pl * hh[i]);
        const size_t rg = (size_t)(row0 + k);
        Rb[rg * 1024 + hc] = (bf16)f2bf(TL(5)[k * TS + ch]); Kb[rg * 1024 + hc] = (bf16)f2bf(TL(3)[k * TS + ch]); } }
    __syncthreads();
}

__device__ __forceinline__ void rwkv_scan_simple(const Args& args, Frame& F, int unit) {
    LAS float* Tb = (LAS float*)F.lds;
    const int tid = F.tid, ch = tid & 63, tq = tid >> 6;
    const int h = unit & 15, b = unit >> 4, hc = h * 64 + ch;
    const bf16* Rb = (const bf16*)(F.ws + WS_RKVG); const bf16* Kb = Rb + (size_t)M * 1024; const bf16* Vb = Kb + (size_t)M * 1024; bf16* Gb = (bf16*)(Vb + (size_t)M * 1024);
    const bf16* HALO = (const bf16*)(F.ws + WS_HALO); const float* SB = (const float*)(F.ws + WS_SB);
    const float* mu = args.in[10]; const float gng = args.in[18][hc], gnb = args.in[19][hc]; const float muv = mu[2048 + hc], mug = mu[3072 + hc];
#pragma unroll
    for (int i = 0; i < 8; ++i) TL(0)[(tq + 8 * i) * TS + ch] = 0.f;
    __syncthreads();
    for (int c = 0; c < NCHUNK; ++c) {
        const int row0 = b * SEQ + c * 64;
        const bf16* GH = (const bf16*)(F.ws + WS_GH) + (size_t)((b * 16 + h) * 64 + c) * 8192;
        float gsh[8], vsh[8];
#pragma unroll
        for (int i = 0; i < 8; ++i) { const int t = tq + 8 * i; const size_t rg = (size_t)(row0 + t);
            TL(1)[t * TS + ch] = bf2f(GH[t * 64 + ch]); TL(2)[t * TS + ch] = bf2f(GH[4096 + t * 64 + ch]);
            TL(3)[t * TS + ch] = bf2f(Rb[rg * 1024 + hc]); TL(4)[t * TS + ch] = bf2f(Kb[rg * 1024 + hc]);
            const float cg = bf2f(Gb[rg * 1024 + hc]), cv = bf2f(Vb[rg * 1024 + hc]); float pg = 0.f, pv = 0.f;
            if (t > 0) { pg = bf2f(Gb[(rg - 1) * 1024 + hc]); pv = bf2f(Vb[(rg - 1) * 1024 + hc]); }
            else if (c > 0) { const bf16* hr = HALO + (size_t)((row0 >> 6) - 1) * 4096; pg = bf2f(hr[3072 + hc]); pv = bf2f(hr[2048 + hc]); }
            gsh[i] = cg + mug * (pg - cg); vsh[i] = cv + muv * (pv - cv); }
        __syncthreads();
        float y[8], zn[8];
#pragma unroll
        for (int i = 0; i < 8; ++i) { y[i] = TL(4)[(tq + 8 * i) * TS + ch]; zn[i] = TL(2)[(tq + 8 * i) * TS + ch]; }
#pragma unroll 2
        for (int j = 0; j < 64; ++j) { const float zj = TL(0)[j * TS + ch];
#pragma unroll
            for (int i = 0; i < 8; ++i) { const int t = tq + 8 * i; y[i] += TL(3)[t * TS + j] * zj; zn[i] += TL(1)[t * TS + j] * zj; } }
#pragma unroll
        for (int i = 0; i < 8; ++i) { const int t = tq + 8 * i; const size_t rg = (size_t)(row0 + t);
            const float mean = wave_sum(y[i]) * (1.f / 64.f); const float d = y[i] - mean; const float var = wave_sum(d * d) * (1.f / 64.f);
            float o = d * (1.f / sqrtf(var + GN_EPS)) * gng + gnb + SB[rg * 16 + h] * vsh[i];
            o *= siluf_(gsh[i]);
            Gb[rg * 1024 + hc] = (bf16)f2bf(o); }
        __syncthreads();
#pragma unroll
        for (int i = 0; i < 8; ++i) TL(0)[(tq + 8 * i) * TS + ch] = zn[i];
        __syncthreads();
    }
}

#define TS2 129
__device__ __forceinline__ void ssd_scan_simple(const Args& args, Frame& F, int unit) {
    LAS float* X = (LAS float*)F.lds; LAS float* Bm = X + 64 * TS; LAS float* Cm = Bm + 64 * TS2; LAS float* Gs = Cm + 64 * TS2; LAS float* St = Gs + 64 * TS;
    LAS float* acum = St + 64 * TS2; LAS float* dtv = acum + 64;
    const int tid = F.tid, ch = tid & 63, tq = tid >> 6;
    const int hd = unit & 31, b = unit >> 5, g = hd >> 3;
    const bf16* XBC = (const bf16*)(F.ws + WS_XBC); bf16* Zb = (bf16*)(F.ws + WS_Z); const float* SMALL = (const float*)(F.ws + WS_SMALL); float* SSQ = (float*)(F.ws + WS_SSQ);
    const float* conv_w = args.in[4]; const float* conv_b = args.in[5];
    const float dtb = args.in[6][hd], Aneg = -__expf(args.in[7][hd]), Dsk = args.in[8][hd];
    for (int i = tid; i < 64 * TS2; i += 512) St[i] = 0.f;
    __syncthreads();
    for (int c = 0; c < NCHUNK; ++c) {
        const int row0 = b * SEQ + c * 64;
        { const int chan = hd * 64 + ch; const float w0_ = conv_w[chan], w1_ = conv_w[3072 + chan], w2_ = conv_w[2 * 3072 + chan], w3_ = conv_w[3 * 3072 + chan], cb = conv_b[chan];
#pragma unroll
          for (int i = 0; i < 8; ++i) { const int l = tq + 8 * i; const int tp = c * 64 + l; const size_t rg = (size_t)(row0 + l);
            float a = cb + w3_ * bf2f(XBC[rg * 3072 + chan]);
            if (tp >= 1) a += w2_ * bf2f(XBC[(rg - 1) * 3072 + chan]);
            if (tp >= 2) a += w1_ * bf2f(XBC[(rg - 2) * 3072 + chan]);
            if (tp >= 3) a += w0_ * bf2f(XBC[(rg - 3) * 3072 + chan]);
            X[l * TS + ch] = siluf_(a); } }
        { const int n = tid & 127, lq = tid >> 7;
#pragma unroll
          for (int which = 0; which < 2; ++which) { const int chan = 2048 + which * 512 + g * 128 + n; LAS float* dst = which ? Cm : Bm;
            const float w0_ = conv_w[chan], w1_ = conv_w[3072 + chan], w2_ = conv_w[2 * 3072 + chan], w3_ = conv_w[3 * 3072 + chan], cb = conv_b[chan];
            for (int i = 0; i < 16; ++i) { const int l = lq + 4 * i; const int tp = c * 64 + l; const size_t rg = (size_t)(row0 + l);
                float a = cb + w3_ * bf2f(XBC[rg * 3072 + chan]);
                if (tp >= 1) a += w2_ * bf2f(XBC[(rg - 1) * 3072 + chan]);
                if (tp >= 2) a += w1_ * bf2f(XBC[(rg - 2) * 3072 + chan]);
                if (tp >= 3) a += w0_ * bf2f(XBC[(rg - 3) * 3072 + chan]);
                dst[l * TS2 + n] = siluf_(a); } } }
        if (tid < 64) { const float dt = softplusf_(SMALL[(size_t)(row0 + tid) * 256 + hd] + dtb); dtv[tid] = dt; acum[tid] = dt * Aneg; }
        __syncthreads();
        if (tid == 0) { float s = 0.f; for (int l = 0; l < 64; ++l) { s += acum[l]; acum[l] = s; } }
        __syncthreads();
        { float o[8];
#pragma unroll
          for (int i = 0; i < 8; ++i) o[i] = 0.f;
#pragma unroll 2
          for (int n = 0; n < 128; ++n) { const float bs = Bm[ch * TS2 + n];
#pragma unroll
            for (int i = 0; i < 8; ++i) o[i] += Cm[(tq + 8 * i) * TS2 + n] * bs; }
#pragma unroll
          for (int i = 0; i < 8; ++i) { const int l = tq + 8 * i; Gs[l * TS + ch] = (ch <= l) ? o[i] * __expf(acum[l] - acum[ch]) * dtv[ch] : 0.f; } }
        __syncthreads();
        { float yd[8], yo[8];
#pragma unroll
          for (int i = 0; i < 8; ++i) { yd[i] = 0.f; yo[i] = 0.f; }
#pragma unroll 2
          for (int s = 0; s < 64; ++s) { const float xs = X[s * TS + ch];
#pragma unroll
            for (int i = 0; i < 8; ++i) yd[i] += Gs[(tq + 8 * i) * TS + s] * xs; }
#pragma unroll 2
          for (int n = 0; n < 128; ++n) { const float sp = St[ch * TS2 + n];
#pragma unroll
            for (int i = 0; i < 8; ++i) yo[i] += Cm[(tq + 8 * i) * TS2 + n] * sp; }
#pragma unroll
          for (int i = 0; i < 8; ++i) { const int l = tq + 8 * i; const size_t rg = (size_t)(row0 + l);
            const float yv = yd[i] + __expf(acum[l]) * yo[i] + Dsk * X[l * TS + ch];
            const float z = bf2f(Zb[rg * 2048 + hd * 64 + ch]); const float yz = yv * siluf_(z);
            Zb[rg * 2048 + hd * 64 + ch] = (bf16)f2bf(yz);
            const float ss = wave_sum(yz * yz); if (ch == 0) SSQ[rg * 32 + hd] = ss; } }
        __syncthreads();
        { const int p = tid >> 3, n0 = tid & 7; float o[16]; const float a63 = acum[63]; const float dec = __expf(a63);
#pragma unroll
          for (int i = 0; i < 16; ++i) o[i] = dec * St[p * TS2 + n0 + 8 * i];
#pragma unroll 2
          for (int l = 0; l < 64; ++l) { const float xs = X[l * TS + p] * dtv[l] * __expf(a63 - acum[l]);
#pragma unroll
            for (int i = 0; i < 16; ++i) o[i] += xs * Bm[l * TS2 + n0 + 8 * i]; }
#pragma unroll
          for (int i = 0; i < 16; ++i) St[p * TS2 + n0 + 8 * i] = o[i]; }
        __syncthreads();
    }
}

__device__ __forceinline__ void ssd_norm_rows(const Args& args, Frame& F) {
    const int gw = F.vcu * NWAVES + F.wave, NGW = F.G * NWAVES;
    bf16* Zb = (bf16*)(F.ws + WS_Z); const float* SSQ = (const float*)(F.ws + WS_SSQ); const float* gain = args.in[9];
    for (int m = gw; m < M; m += NGW) {
        const int grp = F.lane >> 4; float ss = 0.f;
#pragma unroll
        for (int j = 0; j < 8; ++j) ss += SSQ[(size_t)m * 32 + grp * 8 + j];
        const float rstd = 1.f / sqrtf(ss * (1.f / 512.f) + EPS);
        GAS v4u* p = (GAS v4u*)(Zb + (size_t)m * 2048 + F.lane * 32);
#pragma unroll
        for (int q = 0; q < 4; ++q) { v4u w = p[q]; const float* gp = gain + F.lane * 32 + q * 8; unsigned o[4];
#pragma unroll
            for (int e = 0; e < 4; ++e) { const unsigned ww = w[e]; const float lo = __builtin_bit_cast(float, ww << 16) * rstd * gp[2 * e], hi = __builtin_bit_cast(float, ww & 0xffff0000u) * rstd * gp[2 * e + 1]; o[e] = pk2(lo, hi); }
            v4u ov; ov.x = o[0]; ov.y = o[1]; ov.z = o[2]; ov.w = o[3]; p[q] = ov; }
    }
}
__device__ __forceinline__ void final_norm_rows(const Args& args, Frame& F) {
    const int gw = F.vcu * NWAVES + F.wave, NGW = F.G * NWAVES;
    const float* x = args.in[0]; const float* pg = args.in[23];
    f32x4 gv[4];
#pragma unroll
    for (int j = 0; j < 4; ++j) gv[j] = ((const GAS f32x4*)pg)[F.lane + 64 * j];
    for (int m = gw; m < M; m += NGW) {
        GAS f32x4* orow = (GAS f32x4*)(F.out + (size_t)m * D) + F.lane; const GAS f32x4* xr = (const GAS f32x4*)(x + (size_t)m * D) + F.lane;
        f32x4 v[4]; float s = 0.f;
#pragma unroll
        for (int j = 0; j < 4; ++j) { v[j] = orow[64 * j]; s += (v[j].x * v[j].x + v[j].y * v[j].y) + (v[j].z * v[j].z + v[j].w * v[j].w); }
        const float rstd = 1.f / sqrtf(wave_sum(s) * (1.f / D) + EPS);
#pragma unroll
        for (int j = 0; j < 4; ++j) orow[64 * j] = xr[64 * j] + v[j] * rstd * gv[j];
    }
}

__global__ void __launch_bounds__(NWAVES * 64, 2) hybrid_fwd(Args args) {
    extern __shared__ __attribute__((aligned(16))) unsigned char lds[];
    Frame F;
    F.lds = (LAS unsigned char*)lds;
    F.MISC = (volatile LAS unsigned*)(F.lds + MISC_OFF);
    F.tid = threadIdx.x; F.lane = F.tid & 63; F.wave = __builtin_amdgcn_readfirstlane(F.tid >> 6);
    F.G = gridDim.x; { const int bx = blockIdx.x; F.vcu = (F.G % 8 == 0) ? (bx % 8) * (F.G / 8) + bx / 8 : bx; }
    F.out = args.out; F.ws = args.ws;
    F.ctl = (gu32*)(F.ws + WS_CTL);
    for (int u = F.tid; u < (LDS_BYTES - LDSCTL_OFF) / 4; u += NWAVES * 64) ((LAS unsigned*)(F.lds + LDSCTL_OFF))[u] = 0u;
    __syncthreads();
    XcdBarrier bar; bar.bar = (unsigned*)(F.ctl + CW_BAR); bar.x = 0; bar.st = nullptr;
    if (N_LAUNCHES == 1) bar = xcd_barrier_post((unsigned*)(F.ctl + CW_BAR), F.MISC + 8);
#define GRID_BAR() do { if (N_LAUNCHES == 1) xcd_barrier(bar); } while (0)
    const int lo = args.ph_lo, hi = args.ph_hi;
#ifndef PH_MASK
#define PH_MASK 0xFFF
#endif
#define IN(k) ((((PH_MASK) >> (k)) & 1) && lo <= (k) && (k) < hi)
#define BOTH(k) (IN(k) && IN((k) + 1))
    bf16* Win_t = (bf16*)(F.ws + WS_WIN);
    bf16* Hb = (bf16*)F.out;

    if (IN(0)) { p0_prologue(args, F); if (BOTH(0)) GRID_BAR(); }
    if (IN(1)) {
        pg8::Gemm g{Hb, Win_t, M, NT_RW * 256, D}; pg8::StaticOrder S; S.init(M, NT_RW * 256, F.G, (int)blockIdx.x);
        pg8::EpiRW E{(bf16*)(F.ws + WS_RKVG), (bf16*)(F.ws + WS_HALO), (float*)(F.ws + WS_SMALL), M};
        pg8::gemm_phase<pg8::EpiRW, pg8::StaticOrder, PG8_ALIGN, PG8_SP2>(F.lds + RING_OFF, g, S, E);
        if (BOTH(1)) GRID_BAR();
    }
    if (IN(2)) { for (int u = F.vcu; u < NB * NCHUNK * 16; u += F.G) rwkv_local_simple(args, F, u); if (BOTH(2)) GRID_BAR(); }
    if (IN(3)) { for (int u = F.vcu; u < NB * 16; u += F.G) rwkv_scan_simple(args, F, u); if (BOTH(3)) GRID_BAR(); }
    if (IN(4)) {
        pg8::Gemm g{Hb, Win_t + (size_t)NT_RW * 256 * D, M, NT_SSD * 256, D}; pg8::StaticOrder S; S.init(M, NT_SSD * 256, F.G, (int)blockIdx.x);
        pg8::EpiSSD E{(bf16*)(F.ws + WS_Z), (bf16*)(F.ws + WS_XBC)};
        pg8::gemm_phase<pg8::EpiSSD, pg8::StaticOrder, PG8_ALIGN, PG8_SP2>(F.lds + RING_OFF, g, S, E);
        if (BOTH(4)) GRID_BAR();
    }
    if (IN(5)) { for (int u = F.vcu; u < NB * 32; u += F.G) ssd_scan_simple(args, F, u); if (BOTH(5)) GRID_BAR(); }
    if (IN(6)) { ssd_norm_rows(args, F); if (BOTH(6)) GRID_BAR(); }
    if (IN(7)) {
        pg8::Gemm g{Hb, Win_t + (size_t)(NT_RW + NT_SSD) * 256 * D, M, NT_GATE * 256, D}; pg8::StaticOrder S; S.init(M, NT_GATE * 256, F.G, (int)blockIdx.x);
        pg8::EpiGate E{(bf16*)(F.ws + WS_GATES), args.in[3]};
        pg8::gemm_phase<pg8::EpiGate, pg8::StaticOrder, PG8_ALIGN, PG8_SP2>(F.lds + RING_OFF, g, S, E);
        if (BOTH(7)) GRID_BAR();
    }
    if (IN(8)) {
        pg8::Gemm g{(const bf16*)(F.ws + WS_Z), (const bf16*)(F.ws + WS_WSSM), M, D, 2048}; pg8::StaticOrder S; S.init(M, D, F.G, (int)blockIdx.x);
        pg8::EpiT1 E{F.out, (const bf16*)(F.ws + WS_GATES)};
        pg8::gemm_phase<pg8::EpiT1, pg8::StaticOrder, PG8_ALIGN, PG8_SP2>(F.lds + RING_OFF, g, S, E);
        if (BOTH(8)) GRID_BAR();
    }
    if (IN(9)) {
        pg8::Gemm g{(const bf16*)(F.ws + WS_YRWKV), (const bf16*)(F.ws + WS_WRWKV), M, D, D}; pg8::StaticOrder S; S.init(M, D, F.G, (int)blockIdx.x);
        pg8::EpiMerge E{(bf16*)(F.ws + WS_MERGED), F.out, (const bf16*)(F.ws + WS_GATES)};
        pg8::gemm_phase<pg8::EpiMerge, pg8::StaticOrder, PG8_ALIGN, PG8_SP2>(F.lds + RING_OFF, g, S, E);
        if (BOTH(9)) GRID_BAR();
    }
    if (IN(10)) {
        pg8::Gemm g{(const bf16*)(F.ws + WS_MERGED), (const bf16*)(F.ws + WS_WOUT), M, D, D}; pg8::StaticOrder S; S.init(M, D, F.G, (int)blockIdx.x);
        pg8::EpiF32 E{F.out, D};
        pg8::gemm_phase<pg8::EpiF32, pg8::StaticOrder, PG8_ALIGN, PG8_SP2>(F.lds + RING_OFF, g, S, E);
        if (BOTH(10)) GRID_BAR();
    }
    if (IN(11)) { final_norm_rows(args, F); }
#undef IN
#undef BOTH
}

extern "C" void kernel_launch(void* const* d_in, const int* in_sizes, int n_in, void* d_out, int out_size, void* d_ws, size_t ws_size, hipStream_t stream) {
    static int grid = 0;
    if (grid == 0) {
        if (n_in != 24 || in_sizes[0] != M * D || out_size != M * D || ws_size < WS_END) { fprintf(stderr, "kernel_launch: unexpected shapes (n_in %d, in0 %d, out %d, ws %zu)\n", n_in, n_in > 0 ? in_sizes[0] : -1, out_size, ws_size); grid = -1; return; }
        int dev = 0, cus = 0;
        if (hipGetDevice(&dev) != hipSuccess || hipDeviceGetAttribute(&cus, hipDeviceAttributeMultiprocessorCount, dev) != hipSuccess) { grid = -1; return; }
        if (hipFuncSetAttribute((const void*)hybrid_fwd, hipFuncAttributeMaxDynamicSharedMemorySize, LDS_BYTES) != hipSuccess) { fprintf(stderr, "kernel_launch: hipFuncSetAttribute failed\n"); grid = -1; return; }
        (void)hipGetLastError();
        grid = cus;
    }
    if (grid < 0) return;
    if (hipMemsetAsync((char*)d_ws + WS_CTL, 0, CTL_ZERO_BYTES, stream) != hipSuccess) return;
    Args a{};
    for (int i = 0; i < 24; ++i) a.in[i] = (const float*)d_in[i];
    a.out = (float*)d_out; a.ws = (unsigned char*)d_ws;
    for (int li = 0; li < N_LAUNCHES; ++li) {
        if (N_LAUNCHES == 1) { a.ph_lo = 0; a.ph_hi = N_PHASES; } else { a.ph_lo = li; a.ph_hi = li + 1; }
        a.li = li;
        hipLaunchKernelGGL(hybrid_fwd, dim3(grid), dim3(NWAVES * 64), LDS_BYTES, stream, a);
    }
}
```

```cpp
#include <hip/hip_runtime.h>
#include <cstdio>
#include <cstdint>
#define MK_N_LAUNCHES 1
#define REP_MASK 0
namespace pg8 {
#define PG8_LAS __attribute__((address_space(3)))
typedef unsigned short bf16_t;
typedef short bf16x8 __attribute__((ext_vector_type(8)));
typedef float f32x4 __attribute__((ext_vector_type(4)));
typedef unsigned u32x4 __attribute__((ext_vector_type(4)));
constexpr int BM = 256, BK = 64, HALF = 128, HTB = HALF * BK * 2  , STAGE_BYTES = 8 * HTB, NXCD = 8, WGM = 8;

__host__ __device__ __forceinline__ int lds_byte(int r, int c) { const int st = (r >> 4) * 2 + (c >> 5), rr = r & 15, cc = c & 31, ob = rr * 64 + cc * 2; return st * 1024 + (ob ^ (((ob >> 9) & 1) << 5)); }
__host__ __device__ __forceinline__ void stage_rc(int b, int& R, int& C) { const int st = b / 1024, sb = b % 1024, swz = sb ^ (((sb >> 9) & 1) << 5); R = (st >> 1) * 16 + swz / 64; C = (st & 1) * 32 + (swz % 64) / 2; }
__host__ __device__ __forceinline__ int perm32(int rho) { const int n = rho >> 4, i = rho & 15; return 8 * (i >> 2) + 4 * n + (i & 3); }

struct Unit { int pm, pn; };
struct Gemm { const bf16_t* A; const bf16_t* Bt; int M, N, K; };

struct StaticOrder {
    int nM, nN, nwg, G, c;
    __host__ __device__ void init(int M, int N, int G_, int c_) { nM = M / BM; nN = N / BM; nwg = nM * nN; G = G_; c = c_; }
    __host__ __device__ bool next(int i, Unit& u) const {
        const long L = (long)i * G + c; if (L >= nwg) return false;
        int wgid = (int)L; { const int q = nwg / NXCD, r = nwg % NXCD, xcd = wgid % NXCD, off = wgid / NXCD; wgid = (xcd < r ? xcd * (q + 1) : r * (q + 1) + (xcd - r) * q) + off; }
        const int nig = WGM * nN, gid = wgid / nig, fm = gid * WGM, gsz = (nM - fm) < WGM ? (nM - fm) : WGM;
        u.pm = fm + ((wgid % nig) % gsz); u.pn = (wgid % nig) / gsz; return true;
    }
    __device__ __forceinline__ void a_ready(const Unit&) const {}
    __device__ __forceinline__ void done(const Unit&) const {}
};

__device__ __forceinline__ unsigned cvt_pk_bf16(float lo, float hi) { unsigned r; asm volatile("v_cvt_pk_bf16_f32 %0, %1, %2" : "=v"(r) : "v"(lo), "v"(hi)); return r; }
__device__ __forceinline__ float bf_lo(unsigned w) { return __builtin_bit_cast(float, w << 16); }
__device__ __forceinline__ float bf_hi(unsigned w) { return __builtin_bit_cast(float, w & 0xffff0000u); }
__device__ __forceinline__ float sigmoidf_(float x) { return 1.0f / (1.0f + __expf(-x)); }
typedef unsigned u32x2 __attribute__((ext_vector_type(2)));

struct EpiRW {
    static constexpr bool PERM = true, AFTER_DRAIN = false;
    bf16_t* RKVG; bf16_t* HALO; float* SMALL; int Mrows;
    __device__ __forceinline__ void operator()(const f32x4 (&acc)[2][2][4][2], const Unit& u, int wr, int wc, int fr, int fq) const {
        const int row0 = u.pm * BM + wr * 64 + fr;
        if (u.pn < 16) {
            bf16_t* base = RKVG + (size_t)(u.pn >> 2) * ((size_t)Mrows * 1024);
            const int col0 = (u.pn & 3) * 256 + wc * 32 + 8 * fq;
#pragma unroll
            for (int ai = 0; ai < 2; ++ai)
#pragma unroll
                for (int m = 0; m < 4; ++m) { const int row = row0 + ai * HALF + m * 16; bf16_t* rowp = base + (size_t)row * 1024 + col0;
#pragma unroll
                    for (int bj = 0; bj < 2; ++bj) { const f32x4 v0 = acc[ai][bj][m][0], v1 = acc[ai][bj][m][1];
                        u32x4 w; w.x = cvt_pk_bf16(v0[0], v0[1]); w.y = cvt_pk_bf16(v0[2], v0[3]); w.z = cvt_pk_bf16(v1[0], v1[1]); w.w = cvt_pk_bf16(v1[2], v1[3]);
                        *(u32x4*)(rowp + bj * HALF) = w;
                        if (m == 3 && fr == 15) *(u32x4*)(HALO + (size_t)(row >> 6) * 4096 + u.pn * 256 + wc * 32 + 8 * fq + bj * HALF) = w; } }
        } else {
            const int col0 = wc * 32 + 8 * fq;
#pragma unroll
            for (int ai = 0; ai < 2; ++ai)
#pragma unroll
                for (int m = 0; m < 4; ++m) { float* rowp = SMALL + (size_t)(row0 + ai * HALF + m * 16) * 256 + col0;
#pragma unroll
                    for (int bj = 0; bj < 2; ++bj) { *(f32x4*)(rowp + bj * HALF) = acc[ai][bj][m][0]; *(f32x4*)(rowp + bj * HALF + 4) = acc[ai][bj][m][1]; } }
        }
    }
};
struct EpiSSD {
    static constexpr bool PERM = true, AFTER_DRAIN = false;
    bf16_t* Z; bf16_t* XBC; bf16_t* HALOX;
    __device__ __forceinline__ void operator()(const f32x4 (&acc)[2][2][4][2], const Unit& u, int wr, int wc, int fr, int fq) const {
        const int row0 = u.pm * BM + wr * 64 + fr;
        bf16_t* base; int ldc, colt;
        if (u.pn < 8) { base = Z; ldc = 2048; colt = u.pn * 256; } else { base = XBC; ldc = 3072; colt = (u.pn - 8) * 256; }
        const int col0 = colt + wc * 32 + 8 * fq;
#pragma unroll
        for (int ai = 0; ai < 2; ++ai)
#pragma unroll
            for (int m = 0; m < 4; ++m) { bf16_t* rowp = base + (size_t)(row0 + ai * HALF + m * 16) * ldc + col0;
#pragma unroll
                for (int bj = 0; bj < 2; ++bj) { const f32x4 v0 = acc[ai][bj][m][0], v1 = acc[ai][bj][m][1];
                    u32x4 w; w.x = cvt_pk_bf16(v0[0], v0[1]); w.y = cvt_pk_bf16(v0[2], v0[3]); w.z = cvt_pk_bf16(v1[0], v1[1]); w.w = cvt_pk_bf16(v1[2], v1[3]);
                    *(u32x4*)(rowp + bj * HALF) = w;
                    if (m == 3 && fr >= 13 && u.pn >= 8) { const int row = row0 + ai * HALF + m * 16; *(u32x4*)(HALOX + ((size_t)(row >> 6) * 3 + (fr - 13)) * 3072 + col0 + bj * HALF) = w; } } }
    }
};
struct EpiGate {
    static constexpr bool PERM = true, AFTER_DRAIN = false;
    bf16_t* O; const float* bias;
    __device__ __forceinline__ void operator()(const f32x4 (&acc)[2][2][4][2], const Unit& u, int wr, int wc, int fr, int fq) const {
        const int row0 = u.pm * BM + wr * 64 + fr; const int col0 = u.pn * BM + wc * 32 + 8 * fq;
        f32x4 bv[2][2];
#pragma unroll
        for (int bj = 0; bj < 2; ++bj)
#pragma unroll
            for (int n = 0; n < 2; ++n) bv[bj][n] = *(const f32x4*)(bias + col0 + bj * HALF + 4 * n);
#pragma unroll
        for (int ai = 0; ai < 2; ++ai)
#pragma unroll
            for (int m = 0; m < 4; ++m) { bf16_t* rowp = O + (size_t)(row0 + ai * HALF + m * 16) * 2048 + col0;
#pragma unroll
                for (int bj = 0; bj < 2; ++bj) { f32x4 v0 = acc[ai][bj][m][0] + bv[bj][0], v1 = acc[ai][bj][m][1] + bv[bj][1];
#pragma unroll
                    for (int j = 0; j < 4; ++j) { v0[j] = sigmoidf_(v0[j]); v1[j] = sigmoidf_(v1[j]); }
                    u32x4 w; w.x = cvt_pk_bf16(v0[0], v0[1]); w.y = cvt_pk_bf16(v0[2], v0[3]); w.z = cvt_pk_bf16(v1[0], v1[1]); w.w = cvt_pk_bf16(v1[2], v1[3]);
                    *(u32x4*)(rowp + bj * HALF) = w; } }
    }
};
struct EpiT1 {
    static constexpr bool PERM = false, AFTER_DRAIN = false;
    float* T1; const bf16_t* GATES;
    __device__ __forceinline__ void operator()(const f32x4 (&acc)[2][2][4][2], const Unit& u, int wr, int wc, int fr, int fq) const {
        const int row0 = u.pm * BM + wr * 64 + fr, col0 = u.pn * BM + wc * 32 + 4 * fq;
#pragma unroll
        for (int ai = 0; ai < 2; ++ai)
#pragma unroll
            for (int m = 0; m < 4; ++m) { const size_t row = (size_t)(row0 + ai * HALF + m * 16);
#pragma unroll
                for (int bj = 0; bj < 2; ++bj)
#pragma unroll
                    for (int n = 0; n < 2; ++n) { const int c = col0 + bj * HALF + n * 16; const u32x2 g = *(const u32x2*)(GATES + row * 2048 + c);
                        f32x4 v = acc[ai][bj][m][n]; v[0] *= bf_lo(g.x); v[1] *= bf_hi(g.x); v[2] *= bf_lo(g.y); v[3] *= bf_hi(g.y);
                        *(f32x4*)(T1 + row * 1024 + c) = v; } }
    }
};
struct EpiMerge {
    static constexpr bool PERM = true, AFTER_DRAIN = false;
    bf16_t* O; const float* T1; const bf16_t* GATES;
    __device__ __forceinline__ void operator()(const f32x4 (&acc)[2][2][4][2], const Unit& u, int wr, int wc, int fr, int fq) const {
        const int row0 = u.pm * BM + wr * 64 + fr; const int col0 = u.pn * BM + wc * 32 + 8 * fq;
#pragma unroll
        for (int ai = 0; ai < 2; ++ai)
#pragma unroll
            for (int m = 0; m < 4; ++m) { const size_t row = (size_t)(row0 + ai * HALF + m * 16);
#pragma unroll
                for (int bj = 0; bj < 2; ++bj) { const int c = col0 + bj * HALF;
                    const u32x4 g = *(const u32x4*)(GATES + row * 2048 + 1024 + c);
                    const f32x4 t0 = *(const f32x4*)(T1 + row * 1024 + c), t1 = *(const f32x4*)(T1 + row * 1024 + c + 4);
                    f32x4 v0 = acc[ai][bj][m][0], v1 = acc[ai][bj][m][1];
                    v0[0] = t0[0] + bf_lo(g.x) * v0[0]; v0[1] = t0[1] + bf_hi(g.x) * v0[1]; v0[2] = t0[2] + bf_lo(g.y) * v0[2]; v0[3] = t0[3] + bf_hi(g.y) * v0[3];
                    v1[0] = t1[0] + bf_lo(g.z) * v1[0]; v1[1] = t1[1] + bf_hi(g.z) * v1[1]; v1[2] = t1[2] + bf_lo(g.w) * v1[2]; v1[3] = t1[3] + bf_hi(g.w) * v1[3];
                    u32x4 w; w.x = cvt_pk_bf16(v0[0], v0[1]); w.y = cvt_pk_bf16(v0[2], v0[3]); w.z = cvt_pk_bf16(v1[0], v1[1]); w.w = cvt_pk_bf16(v1[2], v1[3]);
                    *(u32x4*)(O + row * 1024 + c) = w; } }
    }
};
struct EpiF32 {
    static constexpr bool PERM = false, AFTER_DRAIN = false;
    float* C; int ldc;
    __device__ __forceinline__ void operator()(const f32x4 (&acc)[2][2][4][2], const Unit& u, int wr, int wc, int fr, int fq) const {
        const int row0 = u.pm * BM + wr * 64 + fr, col0 = u.pn * BM + wc * 32 + 4 * fq;
#pragma unroll
        for (int ai = 0; ai < 2; ++ai)
#pragma unroll
            for (int m = 0; m < 4; ++m) { float* rowp = C + (size_t)(row0 + ai * HALF + m * 16) * ldc + col0;
#pragma unroll
                for (int bj = 0; bj < 2; ++bj)
#pragma unroll
                    for (int n = 0; n < 2; ++n) *(f32x4*)(rowp + bj * HALF + n * 16) = acc[ai][bj][m][n]; }
    }
};

template <class Epi, class Sched, bool ALIGN_EPI = false, bool SP2 = false>
__device__ __forceinline__ void gemm_phase(PG8_LAS unsigned char* lds, const Gemm g, const Sched& S, const Epi& E) {
    const int tid = threadIdx.x, wid = __builtin_amdgcn_readfirstlane(tid >> 6), lane = tid & 63, wr = wid >> 2, wc = wid & 3, fr = lane & 15, fq = lane >> 4;
    const int K = g.K, nt = K / BK;
    unsigned voffA[2], voffB[2];
#pragma unroll
    for (int i = 0; i < 2; ++i) { int R, C; stage_rc(tid * 16 + i * 8192, R, C); const int Rb = Epi::PERM ? ((R & ~31) + perm32(R & 31)) : R;
        voffA[i] = (unsigned)(R * K + C) * 2u; voffB[i] = (unsigned)(Rb * K + C) * 2u; }
    const size_t kstep = (size_t)(BK * 2);
    const size_t hstep = (size_t)HALF * K * 2;
    const size_t tstep = 2 * hstep;
    const unsigned ldsw = (unsigned)wid * 1024u;
    const int aoff = lds_byte(wr * 64 + fr, fq * 8), boff = lds_byte(wc * 32 + fr, fq * 8);
#define PG8_SA(b, h) (((b) * 2 + (h)) * HTB)
#define PG8_SB(b, h) ((4 + (b) * 2 + (h)) * HTB)
#define PG8_STAGE(bufoff, gbase, voff) do { _Pragma("unroll") for (int _i = 0; _i < 2; ++_i) \
        __builtin_amdgcn_global_load_lds((const unsigned*)((const char*)(gbase) + (voff)[_i]), (PG8_LAS unsigned*)(lds + (bufoff) + ldsw + _i * 8192), 16, 0, 0); } while (0)
#define PG8_LDA(dst, b, h) do { _Pragma("unroll") for (int m = 0; m < 4; ++m) _Pragma("unroll") for (int k = 0; k < 2; ++k) dst[m][k] = *(const PG8_LAS bf16x8*)(lds + PG8_SA(b, h) + aoff + m * 2048 + k * 1024); } while (0)
#define PG8_LDB(dst, b, h) do { _Pragma("unroll") for (int n = 0; n < 2; ++n) _Pragma("unroll") for (int k = 0; k < 2; ++k) dst[n][k] = *(const PG8_LAS bf16x8*)(lds + PG8_SB(b, h) + boff + n * 2048 + k * 1024); } while (0)
#define PG8_MMA(ai, bj, At, Bt) do { __builtin_amdgcn_s_setprio(1); _Pragma("unroll") for (int m = 0; m < 4; ++m) _Pragma("unroll") for (int n = 0; n < 2; ++n) _Pragma("unroll") for (int k = 0; k < 2; ++k) \
        acc[ai][bj][m][n] = __builtin_amdgcn_mfma_f32_16x16x32_bf16(Bt[n][k], At[m][k], acc[ai][bj][m][n], 0, 0, 0); __builtin_amdgcn_s_setprio(0); } while (0)
#define PG8_WAIT_V(n) asm volatile("s_waitcnt vmcnt(" #n ")" ::: "memory")
#define PG8_WAIT_L(n) asm volatile("s_waitcnt lgkmcnt(" #n ")" ::: "memory")
#define PG8_BAR __builtin_amdgcn_s_barrier()
#define PG8_SCHED __builtin_amdgcn_sched_barrier(0)
    Unit cur, nxt; int ui = 0;
    if (!S.next(0, cur)) return;
    f32x4 acc[2][2][4][2];
#pragma unroll
    for (int a = 0; a < 2; ++a)
#pragma unroll
        for (int b = 0; b < 2; ++b)
#pragma unroll
            for (int m = 0; m < 4; ++m)
#pragma unroll
                for (int n = 0; n < 2; ++n) acc[a][b][m][n] = (f32x4){0.f, 0.f, 0.f, 0.f};
    bf16x8 At[4][2], B0[2][2], B1[2][2];
    const char* cA = (const char*)g.A + (size_t)cur.pm * tstep; const char* cB = (const char*)g.Bt + (size_t)cur.pn * tstep;
    S.a_ready(cur);
    if constexpr (SP2) {
        PG8_STAGE(PG8_SB(0, 0), cB, voffB); PG8_STAGE(PG8_SB(0, 1), cB + hstep, voffB); PG8_STAGE(PG8_SA(0, 0), cA, voffA); PG8_STAGE(PG8_SA(0, 1), cA + hstep, voffA);
        if (wr == 1) PG8_BAR;
        PG8_WAIT_V(2); PG8_BAR;
        PG8_STAGE(PG8_SB(1, 0), cB + kstep, voffB); PG8_STAGE(PG8_SA(1, 0), cA + kstep, voffA); PG8_STAGE(PG8_SB(1, 1), cB + hstep + kstep, voffB);
        PG8_WAIT_V(6); PG8_BAR;
    } else {
        PG8_STAGE(PG8_SB(0, 0), cB, voffB); PG8_STAGE(PG8_SA(0, 0), cA, voffA); PG8_STAGE(PG8_SB(0, 1), cB + hstep, voffB); PG8_STAGE(PG8_SA(0, 1), cA + hstep, voffA);
        if (wr == 1) PG8_BAR;
        PG8_WAIT_V(4); PG8_BAR;
        PG8_STAGE(PG8_SB(1, 0), cB + kstep, voffB); PG8_STAGE(PG8_SA(1, 0), cA + kstep, voffA); PG8_STAGE(PG8_SB(1, 1), cB + hstep + kstep, voffB);
        PG8_WAIT_V(6); PG8_BAR;
    }
    for (;;) {
        const bool has_next = S.next(ui + 1, nxt);
        const char* nA = has_next ? (const char*)g.A + (size_t)nxt.pm * tstep : cA; const char* nB = has_next ? (const char*)g.Bt + (size_t)nxt.pn * tstep : cB;
        for (int t = 0; t < nt; t += 2) {
            const bool last = (t == nt - 2);
            const char* a1 = cA + (size_t)(t + 1) * kstep;
            const char* a2 = last ? nA : cA + (size_t)(t + 2) * kstep; const char* b2 = last ? nB : cB + (size_t)(t + 2) * kstep;
            const char* a3 = a2 + kstep; const char* b3 = b2 + kstep;
            if (last && has_next) S.a_ready(nxt);
            if constexpr (SP2) {
            PG8_LDB(B0, 0, 0); PG8_LDB(B1, 0, 1); PG8_SCHED; PG8_LDA(At, 0, 0); PG8_STAGE(PG8_SA(1, 1), a1 + hstep, voffA);
            PG8_WAIT_V(8); PG8_WAIT_L(0); PG8_BAR; PG8_MMA(0, 0, At, B0); PG8_MMA(0, 1, At, B1); PG8_BAR; PG8_SCHED;
            PG8_LDA(At, 0, 1); PG8_STAGE(PG8_SB(0, 0), b2, voffB); PG8_STAGE(PG8_SB(0, 1), b2 + hstep, voffB); PG8_STAGE(PG8_SA(0, 0), a2, voffA);
            PG8_WAIT_V(8); PG8_WAIT_L(0); PG8_BAR; PG8_MMA(1, 0, At, B0); PG8_MMA(1, 1, At, B1); PG8_BAR; PG8_SCHED;
            PG8_LDB(B0, 1, 0); PG8_LDB(B1, 1, 1); PG8_SCHED; PG8_LDA(At, 1, 0); PG8_STAGE(PG8_SA(0, 1), a2 + hstep, voffA);
            PG8_WAIT_V(8); PG8_WAIT_L(0); PG8_BAR; PG8_MMA(0, 0, At, B0); PG8_MMA(0, 1, At, B1); PG8_BAR; PG8_SCHED;
            PG8_LDA(At, 1, 1); PG8_STAGE(PG8_SB(1, 0), b3, voffB); PG8_STAGE(PG8_SB(1, 1), b3 + hstep, voffB); PG8_STAGE(PG8_SA(1, 0), a3, voffA);
            PG8_WAIT_V(8); PG8_WAIT_L(0); PG8_BAR; PG8_MMA(1, 0, At, B0); PG8_MMA(1, 1, At, B1); PG8_BAR; PG8_SCHED;
            } else {
            PG8_LDB(B0, 0, 0); PG8_SCHED; PG8_LDA(At, 0, 0); PG8_STAGE(PG8_SA(1, 1), a1 + hstep, voffA);
            PG8_WAIT_L(8); PG8_BAR; PG8_WAIT_L(0); PG8_MMA(0, 0, At, B0); PG8_BAR; PG8_SCHED;
            PG8_LDB(B1, 0, 1); PG8_STAGE(PG8_SB(0, 0), b2, voffB);
            PG8_BAR; PG8_WAIT_L(0); PG8_MMA(0, 1, At, B1); PG8_BAR;
            PG8_LDA(At, 0, 1); PG8_STAGE(PG8_SA(0, 0), a2, voffA);
            PG8_BAR; PG8_WAIT_L(0); PG8_MMA(1, 0, At, B0); PG8_BAR; PG8_SCHED;
            PG8_STAGE(PG8_SB(0, 1), b2 + hstep, voffB);
            PG8_WAIT_V(6); PG8_BAR; PG8_MMA(1, 1, At, B1); PG8_BAR;
            PG8_LDB(B0, 1, 0); PG8_SCHED; PG8_LDA(At, 1, 0); PG8_STAGE(PG8_SA(0, 1), a2 + hstep, voffA);
            PG8_WAIT_L(8); PG8_BAR; PG8_WAIT_L(0); PG8_MMA(0, 0, At, B0); PG8_BAR; PG8_SCHED;
            PG8_LDB(B1, 1, 1); PG8_STAGE(PG8_SB(1, 0), b3, voffB);
            PG8_BAR; PG8_WAIT_L(0); PG8_MMA(0, 1, At, B1); PG8_BAR;
            PG8_LDA(At, 1, 1); PG8_STAGE(PG8_SA(1, 0), a3, voffA);
            PG8_BAR; PG8_WAIT_L(0); PG8_MMA(1, 0, At, B0); PG8_BAR; PG8_SCHED;
            PG8_STAGE(PG8_SB(1, 1), b3 + hstep, voffB);
            PG8_WAIT_V(6); PG8_BAR; PG8_MMA(1, 1, At, B1); PG8_BAR;
            }
        }
        if constexpr (ALIGN_EPI) { if (wr == 0) PG8_BAR; }
        if constexpr (!Epi::AFTER_DRAIN) { E(acc, cur, wr, wc, fr, fq); S.done(cur); }
        if (!has_next) break;
#pragma unroll
        for (int a = 0; a < 2; ++a)
#pragma unroll
            for (int b = 0; b < 2; ++b)
#pragma unroll
                for (int m = 0; m < 4; ++m)
#pragma unroll
                    for (int n = 0; n < 2; ++n) acc[a][b][m][n] = (f32x4){0.f, 0.f, 0.f, 0.f};
        cur = nxt; cA = nA; cB = nB; ++ui;
        if constexpr (ALIGN_EPI) { if (wr == 1) PG8_BAR; }
    }
    PG8_WAIT_V(0);
    if constexpr (!ALIGN_EPI) { if (wr == 0) PG8_BAR; }
    PG8_BAR;
    if constexpr (Epi::AFTER_DRAIN) { E.fused(acc, cur, wr, wc, fr, fq, lds, wid, lane); S.done(cur); }
#undef PG8_SA
#undef PG8_SB
#undef PG8_STAGE
#undef PG8_LDA
#undef PG8_LDB
#undef PG8_MMA
#undef PG8_WAIT_V
#undef PG8_WAIT_L
#undef PG8_BAR
#undef PG8_SCHED
}
}

#ifndef PG8_SP2
#define PG8_SP2 true
#endif
#ifndef PG8_ALIGN
#define PG8_ALIGN true
#endif
constexpr int NWAVES = 8;
#ifndef MK_N_LAUNCHES
#define MK_N_LAUNCHES 1
#endif
constexpr int N_PHASES = 13;
constexpr int N_LAUNCHES = MK_N_LAUNCHES;

constexpr int NB = 4, SEQ = 4096, D = 1024, M = NB * SEQ;
constexpr int IN_COLS = 11424;
constexpr int C_Z = 0, C_XBC = 2048, C_DT = 5120, C_RW = 5152, C_WD = 9248, C_AD = 9312, C_GATE = 9376;
constexpr int NT_RW = 17, NT_SSD = 20, NT_GATE = 8, NT_IN = NT_RW + NT_SSD + NT_GATE;
constexpr int NCHUNK = SEQ / 64;
constexpr float EPS = 1e-6f, GN_EPS = 64.0f * 1e-5f;

constexpr size_t MiB = 1u << 20;
constexpr size_t WS_CTL = 0, CTL_ZERO_BYTES = 64 * 1024;
constexpr size_t WS_WIN = 1 * MiB;
constexpr size_t WS_WSSM = 24 * MiB, WS_WRWKV = 28 * MiB, WS_WOUT = 30 * MiB;
constexpr size_t WS_RKVG = 32 * MiB;
constexpr size_t WS_GH = 160 * MiB;
constexpr size_t WS_SMALL = 224 * MiB;
constexpr size_t WS_HALO = 240 * MiB;
constexpr size_t WS_SB = 242 * MiB;
constexpr size_t WS_SSQ = 243 * MiB;
constexpr size_t WS_HALOX = 247 * MiB;
constexpr size_t WS_BT = 1 * MiB;
constexpr size_t WS_END = 256 * MiB;
constexpr size_t WS_XBC = 32 * MiB;
constexpr size_t WS_Z = 160 * MiB;
constexpr size_t WS_GATES = 32 * MiB;
constexpr size_t WS_MERGED = 224 * MiB;
constexpr size_t WS_T1 = 96 * MiB;
constexpr size_t WS_YRWKV_OUT = 32 * MiB;
constexpr size_t WS_YRWKV = WS_RKVG + 3 * 32 * MiB;
constexpr int CW_TMO = 0, CW_CODE = 1, CW_BAR = 4096;

constexpr int RING_OFF = 0, RING_BYTES = 131072;
constexpr int LDS_BYTES = 163840;
constexpr int MISC_OFF = LDS_BYTES - 256;
constexpr int LDSCTL_OFF = MISC_OFF;

#define GAS __attribute__((address_space(1)))
#define LAS __attribute__((address_space(3)))
typedef unsigned short bf16;
typedef unsigned v4u __attribute__((ext_vector_type(4)));
typedef float f32x4 __attribute__((ext_vector_type(4)));
typedef short bf16x8 __attribute__((ext_vector_type(8)));
typedef GAS unsigned gu32;
typedef GAS unsigned long long gu64;
#define RLX_AGENT __ATOMIC_RELAXED, __HIP_MEMORY_SCOPE_AGENT
#define LDS_WAIT() asm volatile("s_waitcnt lgkmcnt(0)" ::: "memory")
#define VM_WAIT() asm volatile("s_waitcnt vmcnt(0)" ::: "memory")
__device__ __forceinline__ unsigned long long rt() { return __builtin_amdgcn_s_memrealtime(); }
__device__ __forceinline__ unsigned f2bf(float f) { unsigned u = __builtin_bit_cast(unsigned, f); return (u + 0x7fffu + ((u >> 16) & 1u)) >> 16; }
__device__ __forceinline__ unsigned pk2(float lo, float hi) { return f2bf(lo) | (f2bf(hi) << 16); }

#define XB_TMO      128
#define XB_XCNT(j)  (256  + 64 * (j))
#define XB_XSUB(j)  (1280 + 64 * (j))
#define XB_XGEN(j)  (2304 + 64 * (j))
#define XB_TOP      3328
#define XB_TOPGEN   3392
#define XCD_BAR_WORDS 3456
#define XB_SPIN_CAP (1u << 18)

__device__ __forceinline__ unsigned xb_ld(unsigned* p)              { return __hip_atomic_load(p, __ATOMIC_RELAXED, __HIP_MEMORY_SCOPE_AGENT); }
__device__ __forceinline__ unsigned xb_add(unsigned* p, unsigned v) { return __hip_atomic_fetch_add(p, v, __ATOMIC_RELAXED, __HIP_MEMORY_SCOPE_AGENT); }
__device__ __forceinline__ unsigned xb_xcc_id() { return (unsigned)__builtin_amdgcn_s_getreg((3 << 11) | 20) & 0xFu; }
#define XB_SPIN(cond, bar) do { unsigned _sp = 0; while (cond) { __builtin_amdgcn_s_sleep(1); \
    if ((++_sp & 255u) == 0u) { if (xb_ld(&(bar)[XB_TMO])) break; if (_sp > XB_SPIN_CAP) { atomicAdd(&(bar)[XB_TMO], 1u); break; } } } } while (0)

struct XcdBarrier {
    unsigned* bar; unsigned x;
    volatile LAS unsigned* st;
};

__device__ __forceinline__ XcdBarrier xcd_barrier_post(unsigned* bar, volatile LAS unsigned* st) {
    XcdBarrier b; b.bar = bar; b.x = xb_xcc_id(); b.st = st;
    if (threadIdx.x == 0) (void)xb_add(&bar[XB_XCNT(b.x)], 1u);
    return b;
}
__device__ __forceinline__ void xcd_barrier_complete(unsigned* bar, unsigned x, unsigned& nloc, unsigned& nx) {
    const unsigned G = gridDim.x * gridDim.y * gridDim.z;
    unsigned sum, cnt, mine, sp = 0u;
    for (;;) {
        sum = 0u; cnt = 0u; mine = 0u;
#pragma unroll
        for (unsigned j = 0; j < 16; ++j) { const unsigned c = xb_ld(&bar[XB_XCNT(j)]); sum += c; cnt += (c > 0u) ? 1u : 0u; mine = (j == x) ? c : mine; }
        if (sum == G) break;
        __builtin_amdgcn_s_sleep(1);
        if ((++sp & 255u) == 0u) { if (xb_ld(&bar[XB_TMO])) break; if (sp > XB_SPIN_CAP) { atomicAdd(&bar[XB_TMO], 1u); break; } }
    }
    nloc = mine > 0u ? mine : 1u; nx = cnt > 0u ? cnt : 1u;
}

__device__ __forceinline__ void xcd_barrier(const XcdBarrier& b) {
    asm volatile("s_waitcnt vmcnt(0)" ::: "memory");
    __syncthreads();
    if (threadIdx.x == 0) {
        unsigned* bar = b.bar;
        __builtin_amdgcn_s_waitcnt(0);
        unsigned nloc = b.st[0], nx = b.st[1];
        if (nloc == 0u) { xcd_barrier_complete(bar, b.x, nloc, nx); b.st[0] = nloc; b.st[1] = nx; }
        const unsigned old = xb_add(&bar[XB_XSUB(b.x)], 1u);
        const unsigned gen = old / nloc;
        if (old + 1u == (gen + 1u) * nloc) {
            __builtin_amdgcn_fence(__ATOMIC_RELEASE, "agent");
            asm volatile("s_waitcnt vmcnt(0)" ::: "memory");
            const unsigned og = xb_add(&bar[XB_TOP], 1u);
            const unsigned tg = og / nx;
            if (og + 1u == (tg + 1u) * nx) xb_add(&bar[XB_TOPGEN], 1u);
            else XB_SPIN(xb_ld(&bar[XB_TOPGEN]) == tg, bar);
            __builtin_amdgcn_fence(__ATOMIC_ACQUIRE, "agent");
            xb_add(&bar[XB_XGEN(b.x)], 1u);
            asm volatile("s_waitcnt vmcnt(0)" ::: "memory");
        } else {
            XB_SPIN(xb_ld(&bar[XB_XGEN(b.x)]) == gen, bar);
            __builtin_amdgcn_fence(__ATOMIC_ACQUIRE, "agent");
            asm volatile("s_waitcnt vmcnt(0)" ::: "memory");
        }
    }
    __syncthreads();
}
struct Args { const float* in[24]; float* out; unsigned char* ws; int ph_lo, ph_hi, li, pad; };
struct Frame {
    LAS unsigned char* lds;
    volatile LAS unsigned* MISC;
    gu32* ctl;
    int tid, lane, wave;
    int vcu, G;
    float* out; unsigned char* ws;
};
__device__ __forceinline__ float wave_sum(float v) {
#pragma unroll
    for (int o = 1; o < 64; o <<= 1) v += __shfl_xor(v, o);
    return v;
}
__device__ __forceinline__ float bf2f(bf16 v) { return __builtin_bit_cast(float, (unsigned)v << 16); }
#define LDS_BARRIER() do { asm volatile("s_waitcnt lgkmcnt(0)" ::: "memory"); __builtin_amdgcn_s_barrier(); asm volatile("" ::: "memory"); } while (0)
__device__ __forceinline__ float bf_lo_(unsigned w) { return __builtin_bit_cast(float, w << 16); }
__device__ __forceinline__ float bf_hi_(unsigned w) { return __builtin_bit_cast(float, w & 0xffff0000u); }
typedef unsigned u32x2_t __attribute__((ext_vector_type(2)));
__device__ __forceinline__ float softplusf_(float x) { return x > 20.f ? x : __logf(1.0f + __expf(x)); }
__device__ __forceinline__ float siluf_(float x) { return x / (1.0f + __expf(-x)); }
__device__ __forceinline__ float sigm_(float x) { return 1.0f / (1.0f + __expf(-x)); }

__device__ __forceinline__ void p0_transpose_item(const float* W, int ldw, int sc0, bf16* WT, int Kd, int dr0, int k0, LAS float* scr, int lane) {
    if (sc0 >= 0) {
#pragma unroll 8
        for (int i = 0; i < 32; ++i) { const int kk = 2 * i + (lane >> 5); scr[kk * 33 + (lane & 31)] = W[(size_t)(k0 + kk) * ldw + sc0 + (lane & 31)]; }
    } else {
#pragma unroll 8
        for (int i = 0; i < 32; ++i) { const int kk = 2 * i + (lane >> 5); scr[kk * 33 + (lane & 31)] = 0.f; }
    }
    LDS_WAIT(); asm volatile("" ::: "memory");
    const int c = lane & 7;
#pragma unroll
    for (int j = 0; j < 4; ++j) { const int n = (lane >> 3) + 8 * j; const LAS float* s = scr + (8 * c) * 33 + n;
        v4u o; o.x = pk2(s[0 * 33], s[1 * 33]); o.y = pk2(s[2 * 33], s[3 * 33]); o.z = pk2(s[4 * 33], s[5 * 33]); o.w = pk2(s[6 * 33], s[7 * 33]);
        *(GAS v4u*)(WT + (size_t)(dr0 + n) * Kd + k0 + 8 * c) = o; }
    LDS_WAIT(); asm volatile("" ::: "memory");
}
__device__ __forceinline__ int win_src_col(int db) {
    if (db < 128) return C_RW + 32 * db;
    if (db < 136) { const int b = db - 128; if (b == 0) return C_DT; if (b <= 2) return C_WD + 32 * (b - 1); if (b <= 4) return C_AD + 32 * (b - 3); return -1; }
    if (db < 200) return C_Z + 32 * (db - 136);
    if (db < 296) return C_XBC + 32 * (db - 200);
    return C_GATE + 32 * (db - 296);
}
__device__ __forceinline__ void p0_prologue(const Args& args, Frame& F) {
    LAS float* scr = (LAS float*)(F.lds + RING_OFF + F.wave * 16384);
    const int gw = F.vcu * NWAVES + F.wave, NGW = F.G * NWAVES;
    bf16* Win_t = (bf16*)(F.ws + WS_WIN); bf16* Wssm_t = (bf16*)(F.ws + WS_WSSM); bf16* Wrwkv_t = (bf16*)(F.ws + WS_WRWKV); bf16* Wout_t = (bf16*)(F.ws + WS_WOUT);
    constexpr int I_IN = 16 * (NT_IN * 8), I_SSM = 32 * 32, I_RW = 16 * 32, I_OUT = 16 * 32;
    constexpr int NITEMS = I_IN + I_SSM + I_RW + I_OUT;
    for (int it = gw; it < NITEMS; it += NGW) {
        int r = it;
        if (r < I_IN) { const int kb = r / (NT_IN * 8), db = r % (NT_IN * 8); p0_transpose_item(args.in[2], IN_COLS, win_src_col(db), Win_t, D, 32 * db, 64 * kb, scr, F.lane); continue; } r -= I_IN;
        if (r < I_SSM) { const int kb = r / 32, nb = r % 32; p0_transpose_item(args.in[20], D, 32 * nb, Wssm_t, 2048, 32 * nb, 64 * kb, scr, F.lane); continue; } r -= I_SSM;
        if (r < I_RW) { const int kb = r / 32, nb = r % 32; p0_transpose_item(args.in[21], D, 32 * nb, Wrwkv_t, D, 32 * nb, 64 * kb, scr, F.lane); continue; } r -= I_RW;
        { const int kb = r / 32, nb = r % 32; p0_transpose_item(args.in[22], D, 32 * nb, Wout_t, D, 32 * nb, 64 * kb, scr, F.lane); }
    }
    bf16* H = (bf16*)F.out; const float* x = args.in[0]; const float* pg = args.in[1];
    f32x4 gv[4];
#pragma unroll
    for (int j = 0; j < 4; ++j) gv[j] = ((const GAS f32x4*)pg)[F.lane + 64 * j];
    for (int m = gw; m < M; m += NGW) {
        const GAS f32x4* xr = (const GAS f32x4*)(x + (size_t)m * D) + F.lane;
        f32x4 v[4]; float s = 0.f;
#pragma unroll
        for (int j = 0; j < 4; ++j) { v[j] = xr[64 * j]; s += (v[j].x * v[j].x + v[j].y * v[j].y) + (v[j].z * v[j].z + v[j].w * v[j].w); }
        const float rstd = 1.f / sqrtf(wave_sum(s) * (1.f / D) + EPS);
        GAS unsigned long long* o8 = (GAS unsigned long long*)(H + (size_t)m * D) + F.lane;
#pragma unroll
        for (int j = 0; j < 4; ++j) { const f32x4 w = v[j] * rstd * gv[j]; o8[64 * j] = (unsigned long long)pk2(w.x, w.y) | ((unsigned long long)pk2(w.z, w.w) << 32); }
    }
}

__device__ __forceinline__ int kidx(int pr, int g, int j) { return 16 * (2 * pr + (j >> 2)) + 4 * g + (j & 3); }
__device__ __forceinline__ size_t fp_off(int row0, int h, int x) { return (size_t)(row0 + (x >> 6)) * 1024 + h * 64 + (x & 63); }
__device__ __forceinline__ bf16x8 pack_tiles(const f32x4& a, const f32x4& b) {
    v4u w; w.x = pk2(a[0], a[1]); w.y = pk2(a[2], a[3]); w.z = pk2(b[0], b[1]); w.w = pk2(b[2], b[3]); return __builtin_bit_cast(bf16x8, w); }

constexpr int RS_ZBUF = 0, RS_GV = 16384, RS_SB = 53824, RS_YB = 54336, RS_PAR = 72768, RS_ROWB = 144;
__device__ __forceinline__ void rwkv_scan_mfma(const Args& args, Frame& F, int unit) {
    LAS unsigned char* lds = F.lds;
    const int tid = F.tid, lane = F.lane, w = F.wave, q = lane >> 4, r16 = lane & 15;
    const int h = unit & 15, b = unit >> 4; const bool zw = w < 4; const int wb = w & 3;
    const bf16* Rb = (const bf16*)(F.ws + WS_RKVG); const bf16* Kb = Rb + (size_t)M * 1024; const bf16* Vb = Kb + (size_t)M * 1024;
    bf16* Yo = (bf16*)((unsigned char*)F.out + WS_YRWKV_OUT); const float* SB = (const float*)(F.ws + WS_SB);
    if (tid < 192) { const int k = tid >> 6, cc = tid & 63; const float* src = k == 0 ? args.in[18] + h * 64 : k == 1 ? args.in[19] + h * 64 : args.in[10] + 2048 + h * 64;
        ((LAS float*)(lds + RS_PAR))[tid] = src[cc]; }
    f32x4 Z[4];
#pragma unroll
    for (int i = 0; i < 4; ++i) Z[i] = (f32x4){0.f, 0.f, 0.f, 0.f};
    v4u gf[4][2]; u32x2_t hf[4];
    v4u rf[2]; u32x2_t yf[4];
    v4u sg[3]; float ssb = 0.f;
#define RS_LOAD(cc) do { const bf16* GH_ = (const bf16*)(F.ws + WS_GH) + (size_t)((b * 16 + h) * 64 + (cc)) * 8192; const int row0_ = b * SEQ + (cc) * 64; \
        if (zw) { _Pragma("unroll") for (int i = 0; i < 4; ++i) { gf[i][0] = *(const GAS v4u*)(GH_ + ((i * 2 + 0) * 64 + lane) * 8); gf[i][1] = *(const GAS v4u*)(GH_ + ((i * 2 + 1) * 64 + lane) * 8); \
                hf[i] = *(const GAS u32x2_t*)(GH_ + 4096 + ((i * 4 + wb) * 64 + lane) * 4); } } \
        else { rf[0] = *(const GAS v4u*)(Rb + fp_off(row0_, h, ((wb * 2 + 0) * 64 + lane) * 8)); rf[1] = *(const GAS v4u*)(Rb + fp_off(row0_, h, ((wb * 2 + 1) * 64 + lane) * 8)); \
            _Pragma("unroll") for (int i = 0; i < 4; ++i) yf[i] = *(const GAS u32x2_t*)(Kb + fp_off(row0_, h, ((wb * 4 + i) * 64 + lane) * 4)); } } while (0)
#define RS_GVLOAD(cc) do { const int row0_ = b * SEQ + (cc) * 64; \
        _Pragma("unroll") for (int k = 0; k < 3; ++k) { const int p = tid + 256 * k; sg[k] = (v4u){0u, 0u, 0u, 0u}; \
            if (p < 520) { const int rr = p >> 3, ch = p & 7; \
                if (rr > 0 || (cc) > 0) sg[k] = *(const GAS v4u*)(Vb + (size_t)(row0_ + rr - 1) * 1024 + h * 64 + ch * 8); } } \
        if (tid < 64) ssb = SB[(size_t)(row0_ + tid) * 16 + h]; } while (0)
#define RS_GVSTORE(par) do { \
        _Pragma("unroll") for (int k = 0; k < 3; ++k) { const int p = tid + 256 * k; \
            if (p < 520) { const int rr = p >> 3, ch = p & 7; *(LAS v4u*)(lds + RS_GV + ((par) * 65 + rr) * RS_ROWB + ch * 16) = sg[k]; } } \
        if (tid < 64) ((LAS float*)(lds + RS_SB))[(par) * 64 + tid] = ssb; } while (0)
    RS_LOAD(0);
    if (zw) {
        RS_GVLOAD(0); RS_GVSTORE(0); RS_GVLOAD(1);
        { const bf16x8 z0 = pack_tiles(Z[0], Z[1]);
          *(LAS bf16x8*)(lds + RS_ZBUF + (((0 * 4 + wb) * 2 + 0) * 64 + lane) * 16) = z0; *(LAS bf16x8*)(lds + RS_ZBUF + (((0 * 4 + wb) * 2 + 1) * 64 + lane) * 16) = z0; }
        LDS_BARRIER();
        for (int c = 0; c < NCHUNK; ++c) {
            const int par = c & 1;
            const bf16x8 zp0 = pack_tiles(Z[0], Z[1]), zp1 = pack_tiles(Z[2], Z[3]);
#pragma unroll
            for (int i = 0; i < 4; ++i) {
                f32x4 zn; zn[0] = bf_lo_(hf[i].x); zn[1] = bf_hi_(hf[i].x); zn[2] = bf_lo_(hf[i].y); zn[3] = bf_hi_(hf[i].y);
                zn = __builtin_amdgcn_mfma_f32_16x16x32_bf16(__builtin_bit_cast(bf16x8, gf[i][0]), zp0, zn, 0, 0, 0);
                zn = __builtin_amdgcn_mfma_f32_16x16x32_bf16(__builtin_bit_cast(bf16x8, gf[i][1]), zp1, zn, 0, 0, 0);
                Z[i] = zn; }
            if (c + 1 < NCHUNK) { RS_LOAD(c + 1);
                *(LAS bf16x8*)(lds + RS_ZBUF + ((((par ^ 1) * 4 + wb) * 2 + 0) * 64 + lane) * 16) = pack_tiles(Z[0], Z[1]);
                *(LAS bf16x8*)(lds + RS_ZBUF + ((((par ^ 1) * 4 + wb) * 2 + 1) * 64 + lane) * 16) = pack_tiles(Z[2], Z[3]);
                RS_GVSTORE(par ^ 1); if (c + 2 < NCHUNK) RS_GVLOAD(c + 2); }
            if (c > 0) { const int rowp = b * SEQ + (c - 1) * 64;
#pragma unroll
                for (int k = 0; k < 2; ++k) { const int p = tid + 256 * k, t = p >> 3, ch = p & 7;
                    *(GAS v4u*)(Yo + (size_t)(rowp + t) * 1024 + h * 64 + ch * 8) = *(const LAS v4u*)(lds + RS_YB + ((par ^ 1) * 64 + t) * RS_ROWB + ch * 16); } }
            LDS_BARRIER();
        }
        { const int rowp = b * SEQ + (NCHUNK - 1) * 64;
#pragma unroll
          for (int k = 0; k < 2; ++k) { const int p = tid + 256 * k, t = p >> 3, ch = p & 7;
            *(GAS v4u*)(Yo + (size_t)(rowp + t) * 1024 + h * 64 + ch * 8) = *(const LAS v4u*)(lds + RS_YB + (((NCHUNK - 1) & 1) * 64 + t) * RS_ROWB + ch * 16); } }
        LDS_BARRIER();
    } else {
        LDS_BARRIER();
        for (int c = 0; c < NCHUNK; ++c) {
            const int par = c & 1;
            f32x4 Y[4];
#pragma unroll
            for (int i = 0; i < 4; ++i) {
                const bf16x8 zp0 = *(const LAS bf16x8*)(lds + RS_ZBUF + (((par * 4 + i) * 2 + 0) * 64 + lane) * 16), zp1 = *(const LAS bf16x8*)(lds + RS_ZBUF + (((par * 4 + i) * 2 + 1) * 64 + lane) * 16);
                f32x4 yy; yy[0] = bf_lo_(yf[i].x); yy[1] = bf_hi_(yf[i].x); yy[2] = bf_lo_(yf[i].y); yy[3] = bf_hi_(yf[i].y);
                yy = __builtin_amdgcn_mfma_f32_16x16x32_bf16(zp0, __builtin_bit_cast(bf16x8, rf[0]), yy, 0, 0, 0);
                yy = __builtin_amdgcn_mfma_f32_16x16x32_bf16(zp1, __builtin_bit_cast(bf16x8, rf[1]), yy, 0, 0, 0);
                Y[i] = yy; }
            if (c + 1 < NCHUNK) RS_LOAD(c + 1);
            float s1 = 0.f, s2 = 0.f;
#pragma unroll
            for (int i = 0; i < 4; ++i) { s1 += (Y[i][0] + Y[i][1]) + (Y[i][2] + Y[i][3]); s2 += (Y[i][0] * Y[i][0] + Y[i][1] * Y[i][1]) + (Y[i][2] * Y[i][2] + Y[i][3] * Y[i][3]); }
            s1 += __shfl_xor(s1, 16); s1 += __shfl_xor(s1, 32); s2 += __shfl_xor(s2, 16); s2 += __shfl_xor(s2, 32);
            const float mean = s1 * (1.f / 64.f); const float rstd = 1.f / sqrtf(fmaxf(s2 * (1.f / 64.f) - mean * mean, 0.f) + GN_EPS);
            const int t = 16 * wb + r16; const float sbv = ((const LAS float*)(lds + RS_SB))[par * 64 + t];
            const LAS float* PAR = (const LAS float*)(lds + RS_PAR);
#pragma unroll
            for (int i = 0; i < 4; ++i) { const int v0 = 16 * i + 4 * q;
                const f32x4 gng = *(const LAS f32x4*)(PAR + v0), gnb = *(const LAS f32x4*)(PAR + 64 + v0), muv = *(const LAS f32x4*)(PAR + 128 + v0);
                const LAS unsigned char* vp = lds + RS_GV + (par * 65 + t) * RS_ROWB + v0 * 2;
                const u32x2_t pv = *(const LAS u32x2_t*)vp, cv = *(const LAS u32x2_t*)(vp + RS_ROWB);
                float o[4];
#pragma unroll
                for (int e = 0; e < 4; ++e) { const unsigned cvw = cv[e >> 1], pvw = pv[e >> 1];
                    const float cvf = (e & 1) ? bf_hi_(cvw) : bf_lo_(cvw), pvf = (e & 1) ? bf_hi_(pvw) : bf_lo_(pvw);
                    const float vs = cvf + muv[e] * (pvf - cvf);
                    o[e] = (Y[i][e] - mean) * rstd * gng[e] + gnb[e] + sbv * vs; }
                u32x2_t pk; pk.x = pk2(o[0], o[1]); pk.y = pk2(o[2], o[3]); *(LAS u32x2_t*)(lds + RS_YB + (par * 64 + t) * RS_ROWB + v0 * 2) = pk; }
            LDS_BARRIER();
        }
        LDS_BARRIER();
    }
#undef RS_LOAD
#undef RS_GVLOAD
#undef RS_GVSTORE
}

#define TS 65
#define TL(i) (Tb + (i) * (64 * TS))
constexpr int RL_KB = 16640, RL_QR = 33280, RL_KTT = 49920, RL_BTT = 58112, RL_VT = 133120;
constexpr int RL_NN = 99840, RL_AQK = 108032, RL_ARK = 116480, RL_ARB = 124672, RL_DD = 0;
#define C256(base, row, ch) ((base) + (row) * 256 + ((((ch) ^ ((row) & 15))) << 4))
#define C128(base, row, ch) ((base) + (row) * 128 + ((((ch) ^ ((row) & 7))) << 4))
__device__ __forceinline__ bf16x8 pack_tile_lo(const f32x4& a) { v4u w; w.x = pk2(a[0], a[1]); w.y = pk2(a[2], a[3]); w.z = 0u; w.w = 0u; return __builtin_bit_cast(bf16x8, w); }
__device__ __forceinline__ bf16x8 neg_bf16x8(const bf16x8& a) { v4u w = __builtin_bit_cast(v4u, a); w.x ^= 0x80008000u; w.y ^= 0x80008000u; w.z ^= 0x80008000u; w.w ^= 0x80008000u; return __builtin_bit_cast(bf16x8, w); }
__device__ __forceinline__ bf16x8 ld_frag2(LAS unsigned char* lds, int a0, int a1) {
    const u32x2_t lo = *(const LAS u32x2_t*)(lds + a0), hi = *(const LAS u32x2_t*)(lds + a1); v4u w; w.x = lo.x; w.y = lo.y; w.z = hi.x; w.w = hi.y; return __builtin_bit_cast(bf16x8, w); }
#define MFMA16(a, b, c) __builtin_amdgcn_mfma_f32_16x16x32_bf16((a), (b), (c), 0, 0, 0)

__device__ __forceinline__ void rwkv_local_mfma_part(const Args& args, Frame& F, int row0, int b, int h, int c, bool dry) {
    LAS unsigned char* lds = F.lds; LAS float* Tb = (LAS float*)F.lds; LAS float* PL = Tb + 9 * 64 * TS;
    const int tid = F.tid, lane = F.lane, w = F.wave, q = lane >> 4, r16 = lane & 15;
    { const int t = tid >> 3, c8 = (tid & 7) * 8, ch = tid & 7; float v[8]; v4u o;
#define CVT_ROW(TI, IMG, CH) do { _Pragma("unroll") for (int e = 0; e < 8; ++e) v[e] = TL(TI)[t * TS + c8 + e]; o.x = pk2(v[0], v[1]); o.y = pk2(v[2], v[3]); o.z = pk2(v[4], v[5]); o.w = pk2(v[6], v[7]); \
        *(LAS v4u*)(lds + C256(IMG, t, CH)) = o; } while (0)
      CVT_ROW(6, RL_KB, ch); CVT_ROW(0, RL_KB, 8 + ch); CVT_ROW(4, RL_QR, ch); CVT_ROW(5, RL_QR, 8 + ch);
#undef CVT_ROW
      const int cc = tid >> 3, t8 = (tid & 7) * 8;
#define CVT_COL(TI, IMG) do { _Pragma("unroll") for (int e = 0; e < 8; ++e) v[e] = TL(TI)[(t8 + e) * TS + cc]; o.x = pk2(v[0], v[1]); o.y = pk2(v[2], v[3]); o.z = pk2(v[4], v[5]); o.w = pk2(v[6], v[7]); \
        *(LAS v4u*)(lds + C128(IMG, cc, ch)) = o; } while (0)
      CVT_COL(6, RL_KTT); CVT_COL(0, RL_BTT); CVT_COL(7, RL_VT);
#undef CVT_COL
    }
    __syncthreads();
    { const int tb = w >> 1, side = w & 1, t = 16 * tb + r16;
      bf16x8 bq[2];
#pragma unroll
      for (int ks = 0; ks < 2; ++ks) bq[ks] = *(const LAS bf16x8*)(lds + C256(RL_QR, t, 8 * side + 4 * ks + q));
#pragma unroll 1
      for (int ib = 0; ib < 4; ++ib) { f32x4 a0 = (f32x4){0.f, 0.f, 0.f, 0.f}, a1 = (f32x4){0.f, 0.f, 0.f, 0.f};
        if (ib <= tb) {
#pragma unroll
            for (int ks = 0; ks < 2; ++ks) { const bf16x8 fb = *(const LAS bf16x8*)(lds + C256(RL_KB, 16 * ib + r16, 8 + 4 * ks + q)), fk = *(const LAS bf16x8*)(lds + C256(RL_KB, 16 * ib + r16, 4 * ks + q));
                a0 = MFMA16(fb, bq[ks], a0); a1 = MFMA16(fk, bq[ks], a1); } }
        float vb_[4], vk_[4];
#pragma unroll
        for (int e = 0; e < 4; ++e) { const int i = 16 * ib + 4 * q + e; const bool keep = side ? (i <= t) : (i < t); vb_[e] = keep ? (side ? a0[e] : -a0[e]) : 0.f; vk_[e] = keep ? a1[e] : 0.f; }
        u32x2_t pb, pk_; pb.x = pk2(vb_[0], vb_[1]); pb.y = pk2(vb_[2], vb_[3]); pk_.x = pk2(vk_[0], vk_[1]); pk_.y = pk2(vk_[2], vk_[3]);
        const int off = C128(0, t, 2 * ib + (q >> 1)) + (q & 1) * 8;
        *(LAS u32x2_t*)(lds + (side ? RL_ARB : RL_NN) + off) = pb; *(LAS u32x2_t*)(lds + (side ? RL_ARK : RL_AQK) + off) = pk_; } }
    __syncthreads();
    if (w < 4) { const int j = w; f32x4 Pa, Pt, Ta, Tt;
#pragma unroll
        for (int e = 0; e < 4; ++e) { const int rr = 16 * j + 4 * q + e, cc = 16 * j + r16; Pa[e] = bf2f(*(const LAS bf16*)(lds + C128(RL_NN, rr, cc >> 3) + (cc & 7) * 2)); }
        { const u32x2_t x = *(const LAS u32x2_t*)(lds + C128(RL_NN, 16 * j + r16, 2 * j + (q >> 1)) + (q & 1) * 8); Pt[0] = bf_lo_(x.x); Pt[1] = bf_hi_(x.x); Pt[2] = bf_lo_(x.y); Pt[3] = bf_hi_(x.y); }
#pragma unroll
        for (int e = 0; e < 4; ++e) { const float id = (4 * q + e == r16) ? 1.f : 0.f; Ta[e] = Pa[e] + id; Tt[e] = Pt[e] + id; }
#pragma unroll
        for (int rnd = 0; rnd < 3; ++rnd) { const bf16x8 pa = pack_tile_lo(Pa), pt = pack_tile_lo(Pt); const f32x4 z4 = (f32x4){0.f, 0.f, 0.f, 0.f};
            const f32x4 nPa = MFMA16(pt, pa, z4), nPt = MFMA16(pa, pt, z4);
            const bf16x8 npa = pack_tile_lo(nPa), tt = pack_tile_lo(Tt);
            Ta = MFMA16(tt, npa, Ta);
            Tt = MFMA16(npa, tt, Tt);
            Pa = nPa; Pt = nPt; }
        u32x2_t pk_; pk_.x = pk2(Tt[0], Tt[1]); pk_.y = pk2(Tt[2], Tt[3]);
        *(LAS u32x2_t*)(lds + RL_DD + j * 512 + r16 * 32 + q * 8) = pk_; }
    __syncthreads();
    { const int cb = w & 3, side = w >> 2, col = 16 * cb + r16; f32x4 S[4];
      if (side == 0) {
#pragma unroll
        for (int j = 0; j < 4; ++j)
#pragma unroll
            for (int e = 0; e < 4; ++e) S[j][e] = TL(4)[(16 * j + 4 * q + e) * TS + col];
      } else {
        bf16x8 bv[2];
#pragma unroll
        for (int ks = 0; ks < 2; ++ks) bv[ks] = *(const LAS bf16x8*)(lds + C128(RL_VT, col, 4 * ks + q));
#pragma unroll
        for (int j = 0; j < 4; ++j) { f32x4 a = (f32x4){0.f, 0.f, 0.f, 0.f};
#pragma unroll
            for (int ks = 0; ks < 2; ++ks) a = MFMA16(*(const LAS bf16x8*)(lds + C128(RL_AQK, 16 * j + r16, 4 * ks + q)), bv[ks], a);
            S[j] = a; } }
#pragma unroll
      for (int j = 0; j < 4; ++j) { const int t = 16 * j + r16; f32x4 a = S[j];
        if (j == 1) a = MFMA16(ld_frag2(lds, RL_NN + C128(0, t, 0 + (q >> 1)) + (q & 1) * 8, RL_NN + C128(0, t, 0 + (q >> 1)) + (q & 1) * 8), pack_tile_lo(S[0]), a);
        if (j >= 2) a = MFMA16(ld_frag2(lds, RL_NN + C128(0, t, 0 + (q >> 1)) + (q & 1) * 8, RL_NN + C128(0, t, 2 + (q >> 1)) + (q & 1) * 8), pack_tiles(S[0], S[1]), a);
        if (j == 3) a = MFMA16(ld_frag2(lds, RL_NN + C128(0, t, 4 + (q >> 1)) + (q & 1) * 8, RL_NN + C128(0, t, 4 + (q >> 1)) + (q & 1) * 8), pack_tile_lo(S[2]), a);
        const int dd = RL_DD + j * 512 + r16 * 32 + q * 8;
        const f32x4 z4 = (f32x4){0.f, 0.f, 0.f, 0.f}; S[j] = MFMA16(ld_frag2(lds, dd, dd), pack_tile_lo(a), z4); }
      const bf16x8 sp0 = pack_tiles(S[0], S[1]), sp1 = pack_tiles(S[2], S[3]);
      bf16* GH = (bf16*)(F.ws + WS_GH) + (size_t)((b * 16 + h) * 64 + c) * 8192;
      bf16* Rb = (bf16*)(F.ws + WS_RKVG); bf16* Kb = Rb + (size_t)M * 1024;
      if (side == 0) {
#pragma unroll 1
        for (int tb = 0; tb < 4; ++tb) { const int t = 16 * tb + r16; f32x4 a = (f32x4){0.f, 0.f, 0.f, 0.f};
            a = MFMA16(sp0, ld_frag2(lds, RL_ARB + C128(0, t, 0 + (q >> 1)) + (q & 1) * 8, RL_ARB + C128(0, t, 2 + (q >> 1)) + (q & 1) * 8), a);
            a = MFMA16(sp1, ld_frag2(lds, RL_ARB + C128(0, t, 4 + (q >> 1)) + (q & 1) * 8, RL_ARB + C128(0, t, 6 + (q >> 1)) + (q & 1) * 8), a);
            float o[4];
#pragma unroll
            for (int e = 0; e < 4; ++e) o[e] = TL(5)[t * TS + 16 * cb + 4 * q + e] - a[e];
            u32x2_t pk_; pk_.x = pk2(o[0], o[1]); pk_.y = pk2(o[2], o[3]);
            if (!dry) *(GAS u32x2_t*)(Rb + fp_off(row0, h, ((tb * 2 + (cb >> 1)) * 64 + lane) * 8 + 4 * (cb & 1))) = pk_; }
#pragma unroll 1
        for (int kb = 0; kb < 4; ++kb) { const int k = 16 * kb + r16; f32x4 a = (f32x4){0.f, 0.f, 0.f, 0.f};
            a = MFMA16(sp0, ld_frag2(lds, RL_BTT + C128(0, k, 0 + (q >> 1)) + (q & 1) * 8, RL_BTT + C128(0, k, 2 + (q >> 1)) + (q & 1) * 8), a);
            a = MFMA16(sp1, ld_frag2(lds, RL_BTT + C128(0, k, 4 + (q >> 1)) + (q & 1) * 8, RL_BTT + C128(0, k, 6 + (q >> 1)) + (q & 1) * 8), a);
            const float pl = PL[k]; float o[4];
#pragma unroll
            for (int e = 0; e < 4; ++e) o[e] = pl * (((16 * cb + 4 * q + e) == k ? 1.f : 0.f) - a[e]);
            u32x2_t pk_; pk_.x = pk2(o[0], o[1]); pk_.y = pk2(o[2], o[3]);
            if (!dry) *(GAS u32x2_t*)(GH + ((kb * 2 + (cb >> 1)) * 64 + lane) * 8 + 4 * (cb & 1)) = pk_; }
      } else {
        const bf16x8 nsp0 = neg_bf16x8(sp0), nsp1 = neg_bf16x8(sp1);
        bf16x8 av[2];
#pragma unroll
        for (int ks = 0; ks < 2; ++ks) av[ks] = *(const LAS bf16x8*)(lds + C128(RL_VT, col, 4 * ks + q));
#pragma unroll 1
        for (int tb = 0; tb < 4; ++tb) { const int t = 16 * tb + r16; f32x4 a = (f32x4){0.f, 0.f, 0.f, 0.f};
#pragma unroll
            for (int ks = 0; ks < 2; ++ks) a = MFMA16(av[ks], *(const LAS bf16x8*)(lds + C128(RL_ARK, t, 4 * ks + q)), a);
            a = MFMA16(nsp0, ld_frag2(lds, RL_ARB + C128(0, t, 0 + (q >> 1)) + (q & 1) * 8, RL_ARB + C128(0, t, 2 + (q >> 1)) + (q & 1) * 8), a);
            a = MFMA16(nsp1, ld_frag2(lds, RL_ARB + C128(0, t, 4 + (q >> 1)) + (q & 1) * 8, RL_ARB + C128(0, t, 6 + (q >> 1)) + (q & 1) * 8), a);
            u32x2_t pk_; pk_.x = pk2(a[0], a[1]); pk_.y = pk2(a[2], a[3]);
            if (!dry) *(GAS u32x2_t*)(Kb + fp_off(row0, h, ((tb * 4 + cb) * 64 + lane) * 4)) = pk_; }
#pragma unroll 1
        for (int kb = 0; kb < 4; ++kb) { const int k = 16 * kb + r16; f32x4 a = (f32x4){0.f, 0.f, 0.f, 0.f};
#pragma unroll
            for (int ks = 0; ks < 2; ++ks) a = MFMA16(*(const LAS bf16x8*)(lds + C128(RL_KTT, k, 4 * ks + q)), av[ks], a);
            a = MFMA16(ld_frag2(lds, RL_BTT + C128(0, k, 0 + (q >> 1)) + (q & 1) * 8, RL_BTT + C128(0, k, 2 + (q >> 1)) + (q & 1) * 8), nsp0, a);
            a = MFMA16(ld_frag2(lds, RL_BTT + C128(0, k, 4 + (q >> 1)) + (q & 1) * 8, RL_BTT + C128(0, k, 6 + (q >> 1)) + (q & 1) * 8), nsp1, a);
            float o[4];
#pragma unroll
            for (int e = 0; e < 4; ++e) o[e] = PL[16 * kb + 4 * q + e] * a[e];
            u32x2_t pk_; pk_.x = pk2(o[0], o[1]); pk_.y = pk2(o[2], o[3]);
            if (!dry) *(GAS u32x2_t*)(GH + 4096 + ((kb * 4 + cb) * 64 + lane) * 4) = pk_; }
      } }
    __syncthreads();
}

#ifndef RWKV_LOCAL_FAST
#define RWKV_LOCAL_FAST 1
#endif
__device__ __forceinline__ void rwkv_local_simple(const Args& args, Frame& F, int unit, bool dry = false) {
    LAS float* Tb = (LAS float*)F.lds; LAS float* PL = Tb + 9 * 64 * TS;
    const int tid = F.tid, ch = tid & 63, tq = tid >> 6;
    const int h = unit & 15, c = (unit >> 4) & 63, b = unit >> 10;
    const int row0 = b * SEQ + c * 64, hc = h * 64 + ch;
    bf16* Rb = (bf16*)(F.ws + WS_RKVG); bf16* Kb = Rb + (size_t)M * 1024; bf16* Vb = Kb + (size_t)M * 1024;
    const bf16* HALO = (const bf16*)(F.ws + WS_HALO); const float* SMALL = (const float*)(F.ws + WS_SMALL);
    const float* mu = args.in[10]; const float* w0 = args.in[11]; const float* w2 = args.in[12]; const float* a0 = args.in[13]; const float* a2 = args.in[14];
    const float* k_k = args.in[15]; const float* k_a = args.in[16]; const float* r_k = args.in[17];
    { const int t8 = tid >> 3, c8 = (tid & 7) * 8; const size_t rg = (size_t)(row0 + t8); const bool hasp = (c * 64 + t8) > 0;
      const f32x4 z4 = (f32x4){0.f, 0.f, 0.f, 0.f}; const v4u zu = (v4u){0u, 0u, 0u, 0u};
      { const GAS f32x4* sw = (const GAS f32x4*)(SMALL + rg * 256 + 32 + c8); const GAS f32x4* sa = (const GAS f32x4*)(SMALL + rg * 256 + 96 + c8);
        f32x4 cw0 = sw[0], cw1 = sw[1], ca0 = sa[0], ca1 = sa[1], pw0 = z4, pw1 = z4, pa0 = z4, pa1 = z4;
        if (hasp) { pw0 = sw[-64]; pw1 = sw[-63]; pa0 = sa[-64]; pa1 = sa[-63]; }
        const GAS f32x4* w2p = (const GAS f32x4*)(w2 + t8 * 1024 + h * 64 + c8); const GAS f32x4* a2p = (const GAS f32x4*)(a2 + t8 * 1024 + h * 64 + c8);
        const f32x4 w20 = w2p[0], w21 = w2p[1], a20 = a2p[0], a21 = a2p[1];
        const f32x4 mw0 = *(const GAS f32x4*)(mu + 4096 + c8), mw1 = *(const GAS f32x4*)(mu + 4100 + c8), ma0 = *(const GAS f32x4*)(mu + 4160 + c8), ma1 = *(const GAS f32x4*)(mu + 4164 + c8);
#pragma unroll
        for (int e = 0; e < 8; ++e) { const int o = t8 * TS + c8 + e;
          const float cwv = e < 4 ? cw0[e & 3] : cw1[e & 3], pwv = e < 4 ? pw0[e & 3] : pw1[e & 3], cav = e < 4 ? ca0[e & 3] : ca1[e & 3], pav = e < 4 ? pa0[e & 3] : pa1[e & 3];
          const float muw = e < 4 ? mw0[e & 3] : mw1[e & 3], mua = e < 4 ? ma0[e & 3] : ma1[e & 3];
          const float xw = cwv + muw * (pwv - cwv);
          TL(0)[o] = 1.f - 2.f / (1.f + __expf(2.f * xw)); TL(1)[o] = cav + mua * (pav - cav);
          TL(2)[o] = e < 4 ? w20[e & 3] : w21[e & 3]; TL(3)[o] = e < 4 ? a20[e & 3] : a21[e & 3]; } }
      asm volatile("" ::: "memory");
      { const v4u cr = *(const GAS v4u*)(Rb + rg * 1024 + h * 64 + c8), ck = *(const GAS v4u*)(Kb + rg * 1024 + h * 64 + c8), cv = *(const GAS v4u*)(Vb + rg * 1024 + h * 64 + c8);
        v4u pr = zu, pk = zu, pv = zu;
        if (t8 > 0) { pr = *(const GAS v4u*)(Rb + (rg - 1) * 1024 + h * 64 + c8); pk = *(const GAS v4u*)(Kb + (rg - 1) * 1024 + h * 64 + c8); pv = *(const GAS v4u*)(Vb + (rg - 1) * 1024 + h * 64 + c8); }
        else if (c > 0) { const bf16* hr = HALO + (size_t)((row0 >> 6) - 1) * 4096 + h * 64 + c8; pr = *(const GAS v4u*)(hr); pk = *(const GAS v4u*)(hr + 1024); pv = *(const GAS v4u*)(hr + 2048); }
        const GAS f32x4* mup = (const GAS f32x4*)(mu + h * 64 + c8);
        const f32x4 mr0 = mup[0], mr1 = mup[1], mk0 = mup[256], mk1 = mup[257], mv0 = mup[512], mv1 = mup[513];
#pragma unroll
        for (int e = 0; e < 8; ++e) { const int o = t8 * TS + c8 + e;
          const unsigned crw = cr[e >> 1], ckw = ck[e >> 1], cvw = cv[e >> 1], prw = pr[e >> 1], pkw = pk[e >> 1], pvw = pv[e >> 1];
          const float crf = (e & 1) ? bf_hi_(crw) : bf_lo_(crw), ckf = (e & 1) ? bf_hi_(ckw) : bf_lo_(ckw), cvf = (e & 1) ? bf_hi_(cvw) : bf_lo_(cvw);
          const float prf = (e & 1) ? bf_hi_(prw) : bf_lo_(prw), pkf = (e & 1) ? bf_hi_(pkw) : bf_lo_(pkw), pvf = (e & 1) ? bf_hi_(pvw) : bf_lo_(pvw);
          const float mur = e < 4 ? mr0[e & 3] : mr1[e & 3], muk = e < 4 ? mk0[e & 3] : mk1[e & 3], muv = e < 4 ? mv0[e & 3] : mv1[e & 3];
          TL(5)[o] = crf + mur * (prf - crf); TL(4)[o] = ckf + muk * (pkf - ckf); TL(7)[o] = cvf + muv * (pvf - cvf); } } }
    __syncthreads();
    { float wl[8], al[8]; const float w0c = w0[hc], a0c = a0[hc];
#pragma unroll
      for (int i = 0; i < 8; ++i) { wl[i] = w0c; al[i] = a0c; }
#pragma unroll 4
      for (int j = 0; j < 64; ++j) { const float wv = TL(2)[j * TS + ch], av = TL(3)[j * TS + ch];
#pragma unroll
        for (int i = 0; i < 8; ++i) { const int t = tq + 8 * i; wl[i] += TL(0)[t * TS + j] * wv; al[i] += TL(1)[t * TS + j] * av; } }
      __syncthreads();
#pragma unroll
      for (int i = 0; i < 8; ++i) { const int t = tq + 8 * i; const float wlog = -softplusf_(-wl[i]) - 0.5f; TL(2)[t * TS + ch] = -__expf(wlog); TL(3)[t * TS + ch] = sigm_(al[i]); } }
    __syncthreads();
    { const float kkc = k_k[hc], kac = k_a[hc], rkc = r_k[h * 64 + ch];
#pragma unroll
      for (int i = 0; i < 8; ++i) { const int t = tq + 8 * i; const size_t rg = (size_t)(row0 + t);
        const float rr = TL(5)[t * TS + ch], kx = TL(4)[t * TS + ch];
        const float a = TL(3)[t * TS + ch]; const float kkr = kx * kkc, k2 = kx * (1.f + (a - 1.f) * kac);
        const float nrm = wave_sum(kkr * kkr), sbs = wave_sum(rr * k2 * rkc);
        const float kk = kkr / fmaxf(sqrtf(nrm), 1e-12f);
        TL(4)[t * TS + ch] = kk; TL(6)[t * TS + ch] = k2; TL(0)[t * TS + ch] = kk * a;
        if (ch == 0 && !dry) ((float*)(F.ws + WS_SB))[rg * 16 + h] = sbs; } }
    __syncthreads();
    {
#pragma unroll
      for (int i = 0; i < 8; ++i) { const int cc = 8 * tq + i; float v = TL(2)[ch * TS + cc];
#pragma unroll
        for (int off = 1; off < 64; off <<= 1) { const float t_ = __shfl_up(v, off); if (ch >= off) v += t_; }
        TL(1)[ch * TS + cc] = v; } }
    __syncthreads();
#pragma unroll
    for (int i = 0; i < 8; ++i) { const int t = tq + 8 * i; const float cl = TL(1)[t * TS + ch], ld = TL(2)[t * TS + ch]; const float en = __expf(-cl);
        TL(6)[t * TS + ch] *= en; TL(0)[t * TS + ch] *= en; TL(4)[t * TS + ch] *= __expf(cl - ld); TL(5)[t * TS + ch] *= __expf(cl); if (t == 63) PL[ch] = __expf(cl); }
    __syncthreads();
#if RWKV_LOCAL_FAST
    rwkv_local_mfma_part(args, F, row0, b, h, c, dry); return;
#endif
    { float qb[8], qk[8], rk[8], rb[8];
#pragma unroll
      for (int i = 0; i < 8; ++i) { qb[i] = 0.f; qk[i] = 0.f; rk[i] = 0.f; rb[i] = 0.f; }
#pragma unroll 2
      for (int j = 0; j < 64; ++j) { const float bi = TL(0)[ch * TS + j], ki = TL(6)[ch * TS + j];
#pragma unroll
        for (int i = 0; i < 8; ++i) { const int t = tq + 8 * i; const float q = TL(4)[t * TS + j], r = TL(5)[t * TS + j]; qb[i] += q * bi; qk[i] += q * ki; rk[i] += r * ki; rb[i] += r * bi; } }
      __syncthreads();
#pragma unroll
      for (int i = 0; i < 8; ++i) { const int t = tq + 8 * i; const bool st = ch < t, in = ch <= t;
        TL(1)[t * TS + ch] = st ? qb[i] : 0.f; TL(2)[t * TS + ch] = st ? qk[i] : 0.f; TL(3)[t * TS + ch] = in ? rk[i] : 0.f; TL(8)[t * TS + ch] = in ? rb[i] : 0.f; } }
    __syncthreads();
    { float o[8];
#pragma unroll
      for (int i = 0; i < 8; ++i) o[i] = 0.f;
#pragma unroll 2
      for (int j = 0; j < 64; ++j) { const float vj = TL(7)[j * TS + ch];
#pragma unroll
        for (int i = 0; i < 8; ++i) o[i] += TL(2)[(tq + 8 * i) * TS + j] * vj; }
      __syncthreads();
#pragma unroll
      for (int i = 0; i < 8; ++i) TL(2)[(tq + 8 * i) * TS + ch] = o[i]; }
    __syncthreads();
    if (tid < 128) { LAS float* tile = (tid < 64) ? TL(4) : TL(2); const int col = tid & 63;
#pragma unroll 1
        for (int t = 1; t < 64; ++t) { float s = tile[t * TS + col];
#pragma unroll 4
            for (int i = 0; i < t; ++i) s -= TL(1)[t * TS + i] * tile[i * TS + col];
            tile[t * TS + col] = s; } }
    __syncthreads();
    { float o1[8], o2[8];
#pragma unroll
      for (int i = 0; i < 8; ++i) { o1[i] = TL(5)[(tq + 8 * i) * TS + ch]; o2[i] = 0.f; }
#pragma unroll 2
      for (int j = 0; j < 64; ++j) { const float qj = TL(4)[j * TS + ch], vj = TL(7)[j * TS + ch], xj = TL(2)[j * TS + ch];
#pragma unroll
        for (int i = 0; i < 8; ++i) { const int t = tq + 8 * i; const float arb = TL(8)[t * TS + j], ark = TL(3)[t * TS + j]; o1[i] -= arb * qj; o2[i] += ark * vj - arb * xj; } }
      __syncthreads();
#pragma unroll
      for (int i = 0; i < 8; ++i) { TL(5)[(tq + 8 * i) * TS + ch] = o1[i]; TL(3)[(tq + 8 * i) * TS + ch] = o2[i]; } }
    __syncthreads();
    { bf16* GH = (bf16*)(F.ws + WS_GH) + (size_t)((b * 16 + h) * 64 + c) * 8192;
      const int blk = ch >> 4, gg = (ch & 15) >> 2, jj = ch & 3;
      { float g[8];
#pragma unroll
        for (int i = 0; i < 8; ++i) g[i] = 0.f;
#pragma unroll 2
        for (int t = 0; t < 64; ++t) { const float qh = TL(4)[t * TS + ch];
#pragma unroll
          for (int i = 0; i < 8; ++i) g[i] += TL(0)[t * TS + tq + 8 * i] * qh; }
#pragma unroll
        for (int i = 0; i < 8; ++i) { const int k = tq + 8 * i; const float pl = PL[k];
          const int xfrag = (((k >> 4) * 2 + (blk >> 1)) * 64 + gg * 16 + (k & 15)) * 8 + (blk & 1) * 4 + jj;
          GH[xfrag] = (bf16)f2bf(pl * ((k == ch ? 1.f : 0.f) - g[i]));
          Rb[fp_off(row0, h, xfrag)] = (bf16)f2bf(TL(5)[k * TS + ch]); } }
      { float hh[8];
#pragma unroll
        for (int i = 0; i < 8; ++i) hh[i] = 0.f;
#pragma unroll 2
        for (int t = 0; t < 64; ++t) { const float vm = TL(7)[t * TS + ch], xx = TL(2)[t * TS + ch];
#pragma unroll
          for (int i = 0; i < 8; ++i) { const int k = tq + 8 * i; hh[i] += TL(6)[t * TS + k] * vm - TL(0)[t * TS + k] * xx; } }
#pragma unroll
        for (int i = 0; i < 8; ++i) { const int k = tq + 8 * i; const float pl = PL[k];
          GH[4096 + (((k >> 4) * 4 + (ch >> 4)) * 64 + ((k & 15) >> 2) * 16 + (ch & 15)) * 4 + (k & 3)] = (bf16)f2bf(pl * hh[i]);
          Kb[fp_off(row0, h, (((k >> 4) * 4 + (ch >> 4)) * 64 + ((ch & 15) >> 2) * 16 + (k & 15)) * 4 + (ch & 3))] = (bf16)f2bf(TL(3)[k * TS + ch]); } } }
    __syncthreads();
}

__device__ __forceinline__ void rwkv_scan_simple(const Args& args, Frame& F, int unit) {
    LAS float* Tb = (LAS float*)F.lds;
    const int tid = F.tid, ch = tid & 63, tq = tid >> 6;
    const int h = unit & 15, b = unit >> 4, hc = h * 64 + ch;
    const bf16* Rb = (const bf16*)(F.ws + WS_RKVG); const bf16* Kb = Rb + (size_t)M * 1024; const bf16* Vb = Kb + (size_t)M * 1024; bf16* Gb = (bf16*)(Vb + (size_t)M * 1024);
    const bf16* HALO = (const bf16*)(F.ws + WS_HALO); const float* SB = (const float*)(F.ws + WS_SB);
    const float* mu = args.in[10]; const float gng = args.in[18][hc], gnb = args.in[19][hc]; const float muv = mu[2048 + hc], mug = mu[3072 + hc];
#pragma unroll
    for (int i = 0; i < 8; ++i) TL(0)[(tq + 8 * i) * TS + ch] = 0.f;
    __syncthreads();
    for (int c = 0; c < NCHUNK; ++c) {
        const int row0 = b * SEQ + c * 64;
        const bf16* GH = (const bf16*)(F.ws + WS_GH) + (size_t)((b * 16 + h) * 64 + c) * 8192;
        float gsh[8], vsh[8];
#pragma unroll
        for (int i = 0; i < 8; ++i) { const int t = tq + 8 * i; const size_t rg = (size_t)(row0 + t);
            TL(1)[t * TS + ch] = bf2f(GH[t * 64 + ch]); TL(2)[t * TS + ch] = bf2f(GH[4096 + t * 64 + ch]);
            TL(3)[t * TS + ch] = bf2f(Rb[rg * 1024 + hc]); TL(4)[t * TS + ch] = bf2f(Kb[rg * 1024 + hc]);
            const float cg = bf2f(Gb[rg * 1024 + hc]), cv = bf2f(Vb[rg * 1024 + hc]); float pg = 0.f, pv = 0.f;
            if (t > 0) { pg = bf2f(Gb[(rg - 1) * 1024 + hc]); pv = bf2f(Vb[(rg - 1) * 1024 + hc]); }
            else if (c > 0) { const bf16* hr = HALO + (size_t)((row0 >> 6) - 1) * 4096; pg = bf2f(hr[3072 + hc]); pv = bf2f(hr[2048 + hc]); }
            gsh[i] = cg + mug * (pg - cg); vsh[i] = cv + muv * (pv - cv); }
        __syncthreads();
        float y[8], zn[8];
#pragma unroll
        for (int i = 0; i < 8; ++i) { y[i] = TL(4)[(tq + 8 * i) * TS + ch]; zn[i] = TL(2)[(tq + 8 * i) * TS + ch]; }
#pragma unroll 2
        for (int j = 0; j < 64; ++j) { const float zj = TL(0)[j * TS + ch];
#pragma unroll
            for (int i = 0; i < 8; ++i) { const int t = tq + 8 * i; y[i] += TL(3)[t * TS + j] * zj; zn[i] += TL(1)[t * TS + j] * zj; } }
#pragma unroll
        for (int i = 0; i < 8; ++i) { const int t = tq + 8 * i; const size_t rg = (size_t)(row0 + t);
            const float mean = wave_sum(y[i]) * (1.f / 64.f); const float d = y[i] - mean; const float var = wave_sum(d * d) * (1.f / 64.f);
            float o = d * (1.f / sqrtf(var + GN_EPS)) * gng + gnb + SB[rg * 16 + h] * vsh[i];
            o *= siluf_(gsh[i]);
            Gb[rg * 1024 + hc] = (bf16)f2bf(o); }
        __syncthreads();
#pragma unroll
        for (int i = 0; i < 8; ++i) TL(0)[(tq + 8 * i) * TS + ch] = zn[i];
        __syncthreads();
    }
}

#define TS2 129
__device__ __forceinline__ void ssd_scan_simple(const Args& args, Frame& F, int unit) {
    LAS float* X = (LAS float*)F.lds; LAS float* Bm = X + 64 * TS; LAS float* Cm = Bm + 64 * TS2; LAS float* Gs = Cm + 64 * TS2; LAS float* St = Gs + 64 * TS;
    LAS float* acum = St + 64 * TS2; LAS float* dtv = acum + 64;
    const int tid = F.tid, ch = tid & 63, tq = tid >> 6;
    const int hd = unit & 31, b = unit >> 5, g = hd >> 3;
    const bf16* XBC = (const bf16*)(F.ws + WS_XBC); bf16* Zb = (bf16*)(F.ws + WS_Z); const float* SMALL = (const float*)(F.ws + WS_SMALL); float* SSQ = (float*)(F.ws + WS_SSQ);
    const float* conv_w = args.in[4]; const float* conv_b = args.in[5];
    const float dtb = args.in[6][hd], Aneg = -__expf(args.in[7][hd]), Dsk = args.in[8][hd];
    for (int i = tid; i < 64 * TS2; i += 512) St[i] = 0.f;
    __syncthreads();
    for (int c = 0; c < NCHUNK; ++c) {
        const int row0 = b * SEQ + c * 64;
        { const int chan = hd * 64 + ch; const float w0_ = conv_w[chan], w1_ = conv_w[3072 + chan], w2_ = conv_w[2 * 3072 + chan], w3_ = conv_w[3 * 3072 + chan], cb = conv_b[chan];
#pragma unroll
          for (int i = 0; i < 8; ++i) { const int l = tq + 8 * i; const int tp = c * 64 + l; const size_t rg = (size_t)(row0 + l);
            float a = cb + w3_ * bf2f(XBC[rg * 3072 + chan]);
            if (tp >= 1) a += w2_ * bf2f(XBC[(rg - 1) * 3072 + chan]);
            if (tp >= 2) a += w1_ * bf2f(XBC[(rg - 2) * 3072 + chan]);
            if (tp >= 3) a += w0_ * bf2f(XBC[(rg - 3) * 3072 + chan]);
            X[l * TS + ch] = siluf_(a); } }
        { const int n = tid & 127, lq = tid >> 7;
#pragma unroll
          for (int which = 0; which < 2; ++which) { const int chan = 2048 + which * 512 + g * 128 + n; LAS float* dst = which ? Cm : Bm;
            const float w0_ = conv_w[chan], w1_ = conv_w[3072 + chan], w2_ = conv_w[2 * 3072 + chan], w3_ = conv_w[3 * 3072 + chan], cb = conv_b[chan];
            for (int i = 0; i < 16; ++i) { const int l = lq + 4 * i; const int tp = c * 64 + l; const size_t rg = (size_t)(row0 + l);
                float a = cb + w3_ * bf2f(XBC[rg * 3072 + chan]);
                if (tp >= 1) a += w2_ * bf2f(XBC[(rg - 1) * 3072 + chan]);
                if (tp >= 2) a += w1_ * bf2f(XBC[(rg - 2) * 3072 + chan]);
                if (tp >= 3) a += w0_ * bf2f(XBC[(rg - 3) * 3072 + chan]);
                dst[l * TS2 + n] = siluf_(a); } } }
        if (tid < 64) { const float dt = softplusf_(SMALL[(size_t)(row0 + tid) * 256 + hd] + dtb); dtv[tid] = dt; acum[tid] = dt * Aneg; }
        __syncthreads();
        if (tid == 0) { float s = 0.f; for (int l = 0; l < 64; ++l) { s += acum[l]; acum[l] = s; } }
        __syncthreads();
        { float o[8];
#pragma unroll
          for (int i = 0; i < 8; ++i) o[i] = 0.f;
#pragma unroll 2
          for (int n = 0; n < 128; ++n) { const float bs = Bm[ch * TS2 + n];
#pragma unroll
            for (int i = 0; i < 8; ++i) o[i] += Cm[(tq + 8 * i) * TS2 + n] * bs; }
#pragma unroll
          for (int i = 0; i < 8; ++i) { const int l = tq + 8 * i; Gs[l * TS + ch] = (ch <= l) ? o[i] * __expf(acum[l] - acum[ch]) * dtv[ch] : 0.f; } }
        __syncthreads();
        { float yd[8], yo[8];
#pragma unroll
          for (int i = 0; i < 8; ++i) { yd[i] = 0.f; yo[i] = 0.f; }
#pragma unroll 2
          for (int s = 0; s < 64; ++s) { const float xs = X[s * TS + ch];
#pragma unroll
            for (int i = 0; i < 8; ++i) yd[i] += Gs[(tq + 8 * i) * TS + s] * xs; }
#pragma unroll 2
          for (int n = 0; n < 128; ++n) { const float sp = St[ch * TS2 + n];
#pragma unroll
            for (int i = 0; i < 8; ++i) yo[i] += Cm[(tq + 8 * i) * TS2 + n] * sp; }
#pragma unroll
          for (int i = 0; i < 8; ++i) { const int l = tq + 8 * i; const size_t rg = (size_t)(row0 + l);
            const float yv = yd[i] + __expf(acum[l]) * yo[i] + Dsk * X[l * TS + ch];
            const float z = bf2f(Zb[rg * 2048 + hd * 64 + ch]); const float yz = yv * siluf_(z);
            Zb[rg * 2048 + hd * 64 + ch] = (bf16)f2bf(yz);
            const float ss = wave_sum(yz * yz); if (ch == 0) { SSQ[rg * 64 + hd * 2] = ss; SSQ[rg * 64 + hd * 2 + 1] = 0.f; } } }
        __syncthreads();
        { const int p = tid >> 3, n0 = tid & 7; float o[16]; const float a63 = acum[63]; const float dec = __expf(a63);
#pragma unroll
          for (int i = 0; i < 16; ++i) o[i] = dec * St[p * TS2 + n0 + 8 * i];
#pragma unroll 2
          for (int l = 0; l < 64; ++l) { const float xs = X[l * TS + p] * dtv[l] * __expf(a63 - acum[l]);
#pragma unroll
            for (int i = 0; i < 16; ++i) o[i] += xs * Bm[l * TS2 + n0 + 8 * i]; }
#pragma unroll
          for (int i = 0; i < 16; ++i) St[p * TS2 + n0 + 8 * i] = o[i]; }
        __syncthreads();
    }
}

__device__ __forceinline__ void rwkv_gate_rows(const Args& args, Frame& F) {
    const int gw = F.vcu * NWAVES + F.wave, NGW = F.G * NWAVES, lane = F.lane;
    bf16* Yo = (bf16*)((unsigned char*)F.out + WS_YRWKV_OUT); const bf16* Gb = (const bf16*)(F.ws + WS_RKVG) + (size_t)3 * M * 1024;
    f32x4 mg[4];
#pragma unroll
    for (int j = 0; j < 4; ++j) mg[j] = *(const GAS f32x4*)(args.in[10] + 3072 + lane * 16 + 4 * j);
    for (int m = gw; m < M; m += NGW) {
        GAS v4u* up = (GAS v4u*)(Yo + (size_t)m * 1024 + lane * 16); const GAS v4u* gp = (const GAS v4u*)(Gb + (size_t)m * 1024 + lane * 16);
#define LD16_SC1(p) ({ const unsigned long long a_ = __hip_atomic_load((const GAS unsigned long long*)(p), __ATOMIC_RELAXED, __HIP_MEMORY_SCOPE_AGENT), b_ = __hip_atomic_load((const GAS unsigned long long*)(p) + 1, __ATOMIC_RELAXED, __HIP_MEMORY_SCOPE_AGENT); \
        v4u r_; r_.x = (unsigned)a_; r_.y = (unsigned)(a_ >> 32); r_.z = (unsigned)b_; r_.w = (unsigned)(b_ >> 32); r_; })
        const v4u u0 = LD16_SC1(up), u1 = LD16_SC1(up + 1), g0 = LD16_SC1(gp), g1 = LD16_SC1(gp + 1); v4u p0 = (v4u){0u, 0u, 0u, 0u}, p1 = p0;
        if ((m & (SEQ - 1)) != 0) { p0 = LD16_SC1(gp - 128); p1 = LD16_SC1(gp - 127); }
        v4u o0, o1;
#pragma unroll
        for (int e = 0; e < 4; ++e) {
            { const float gl = bf_lo_(g0[e]), gh = bf_hi_(g0[e]), pl = bf_lo_(p0[e]), ph = bf_hi_(p0[e]); const float ml = mg[e >> 1][(2 * e) & 3], mh = mg[e >> 1][(2 * e + 1) & 3];
              o0[e] = pk2(bf_lo_(u0[e]) * siluf_(gl + ml * (pl - gl)), bf_hi_(u0[e]) * siluf_(gh + mh * (ph - gh))); }
            { const float gl = bf_lo_(g1[e]), gh = bf_hi_(g1[e]), pl = bf_lo_(p1[e]), ph = bf_hi_(p1[e]); const float ml = mg[2 + (e >> 1)][(2 * e) & 3], mh = mg[2 + (e >> 1)][(2 * e + 1) & 3];
              o1[e] = pk2(bf_lo_(u1[e]) * siluf_(gl + ml * (pl - gl)), bf_hi_(u1[e]) * siluf_(gh + mh * (ph - gh))); } }
        up[0] = o0; up[1] = o1;
    }
}
__device__ __forceinline__ void ssd_conv_unit(const Args& args, Frame& F, int wu, bool dry = false) {
    const int lane = F.lane, q = lane & 7, rgp = lane >> 3;
    const int bc = wu / 48, slab = wu - bc * 48, c = bc & 63;
    const int row0 = bc * 64, ch0 = slab * 64 + q * 8;
    bf16* XBC = (bf16*)(F.ws + WS_XBC); const bf16* HALOX = (const bf16*)(F.ws + WS_HALOX);
    const float* conv_w = args.in[4]; const float* conv_b = args.in[5];
    v4u raw[11];
#pragma unroll
    for (int i = 0; i < 11; ++i) { const int l = rgp * 8 - 3 + i;
        if (l >= 0) raw[i] = *(const GAS v4u*)(XBC + (size_t)(row0 + l) * 3072 + ch0);
        else if (c > 0) raw[i] = *(const GAS v4u*)(HALOX + ((size_t)(bc - 1) * 3 + (3 + l)) * 3072 + ch0);
        else raw[i] = (v4u){0u, 0u, 0u, 0u}; }
    float wt[4][8], bs[8];
#pragma unroll
    for (int j = 0; j < 4; ++j) { const f32x4 a = *(const GAS f32x4*)(conv_w + j * 3072 + ch0), b = *(const GAS f32x4*)(conv_w + j * 3072 + ch0 + 4);
        wt[j][0] = a.x; wt[j][1] = a.y; wt[j][2] = a.z; wt[j][3] = a.w; wt[j][4] = b.x; wt[j][5] = b.y; wt[j][6] = b.z; wt[j][7] = b.w; }
    { const f32x4 a = *(const GAS f32x4*)(conv_b + ch0), b = *(const GAS f32x4*)(conv_b + ch0 + 4); bs[0] = a.x; bs[1] = a.y; bs[2] = a.z; bs[3] = a.w; bs[4] = b.x; bs[5] = b.y; bs[6] = b.z; bs[7] = b.w; }
    asm volatile("s_waitcnt vmcnt(0)" ::: "memory");
    float o[8][8];
#pragma unroll
    for (int r = 0; r < 8; ++r)
#pragma unroll
        for (int e = 0; e < 8; ++e) { float a = bs[e];
#pragma unroll
            for (int j = 0; j < 4; ++j) { const unsigned w = raw[r + j][e >> 1]; const float v = (e & 1) ? __builtin_bit_cast(float, w & 0xffff0000u) : __builtin_bit_cast(float, w << 16); a += wt[j][e] * v; }
            o[r][e] = siluf_(a); }
    if (dry) { asm volatile("" :: "v"(o[0][0]), "v"(o[7][7]), "v"(o[3][4])); return; }
    if (slab < 32) {
#pragma unroll
        for (int e = 0; e < 8; ++e) { v4u w; w.x = pk2(o[0][e], o[1][e]); w.y = pk2(o[2][e], o[3][e]); w.z = pk2(o[4][e], o[5][e]); w.w = pk2(o[6][e], o[7][e]);
            *(GAS v4u*)(XBC + (size_t)(row0 + q * 8 + e) * 3072 + slab * 64 + rgp * 8) = w; }
    } else {
#pragma unroll
        for (int r = 0; r < 8; ++r) { v4u w; w.x = pk2(o[r][0], o[r][1]); w.y = pk2(o[r][2], o[r][3]); w.z = pk2(o[r][4], o[r][5]); w.w = pk2(o[r][6], o[r][7]);
            *(GAS v4u*)(XBC + (size_t)(row0 + rgp * 8 + r) * 3072 + ch0) = w; }
        if (slab < 40) { bf16* BT = (bf16*)(F.ws + WS_BT); const int g = (slab - 32) >> 1, n0 = ((slab - 32) & 1) * 64 + q * 8;
#pragma unroll
            for (int e = 0; e < 8; ++e) { v4u w; w.x = pk2(o[0][e], o[1][e]); w.y = pk2(o[2][e], o[3][e]); w.z = pk2(o[4][e], o[5][e]); w.w = pk2(o[6][e], o[7][e]);
                *(GAS v4u*)(BT + ((size_t)(bc * 4 + g) * 128 + n0 + e) * 64 + rgp * 8) = w; } }
    }
}

#define L256(base, row, ch) ((base) + (row) * 256 + ((((ch) ^ ((row) & 15))) << 4))
#define L128(base, row, ch) ((base) + (row) * 128 + ((((ch) ^ ((row) & 7))) << 4))
constexpr int SS_CM = 0, SS_BM = 16384, SS_BT = 32768, SS_XT = 49152, SS_XW = 57344, SS_MM = 65536, SS_STB = 73728, SS_SC = 90112;
struct SsdStage { v4u rC[2], rB[2], rT[2], rX; float rdt; };
struct SsdCtx { const bf16* XBC; const bf16* BT; bf16* Zb; const float* SMALL; float* SSQ; float dtb, Aneg, Dsk; int hd, b, g; int cmrow0, cmrow1, cmch, btrow0, btrow1, btch, xtrow, xtch; };
__device__ __forceinline__ void ssd_stage_load(const SsdCtx& X, SsdStage& S, int cc, int tid) {
    const int row0_ = X.b * SEQ + cc * 64;
    S.rC[0] = *(const GAS v4u*)(X.XBC + (size_t)(row0_ + X.cmrow0) * 3072 + 2560 + X.g * 128 + X.cmch * 8); S.rC[1] = *(const GAS v4u*)(X.XBC + (size_t)(row0_ + X.cmrow1) * 3072 + 2560 + X.g * 128 + X.cmch * 8);
    S.rB[0] = *(const GAS v4u*)(X.XBC + (size_t)(row0_ + X.cmrow0) * 3072 + 2048 + X.g * 128 + X.cmch * 8); S.rB[1] = *(const GAS v4u*)(X.XBC + (size_t)(row0_ + X.cmrow1) * 3072 + 2048 + X.g * 128 + X.cmch * 8);
    S.rT[0] = *(const GAS v4u*)(X.BT + ((size_t)((row0_ >> 6) * 4 + X.g) * 128 + X.btrow0) * 64 + X.btch * 8); S.rT[1] = *(const GAS v4u*)(X.BT + ((size_t)((row0_ >> 6) * 4 + X.g) * 128 + X.btrow1) * 64 + X.btch * 8);
    S.rX = *(const GAS v4u*)(X.XBC + (size_t)(row0_ + X.xtrow) * 3072 + X.hd * 64 + X.xtch * 8);
    if (tid < 64) S.rdt = X.SMALL[(size_t)(row0_ + tid) * 256 + X.hd];
}
__device__ __forceinline__ void ssd_chunk(const SsdCtx& X, SsdStage& S, int c, LAS unsigned char* lds, f32x4 (&accS)[4], int tid, int lane, int w, bool dry) {
    LAS float* dtv = (LAS float*)(lds + SS_SC); LAS float* acum = dtv + 64; LAS float* scl = acum + 64;
    const int q = lane >> 4, r16 = lane & 15; const int hd = X.hd; const int row0 = X.b * SEQ + c * 64;
    *(LAS v4u*)(lds + L256(SS_CM, X.cmrow0, X.cmch)) = S.rC[0]; *(LAS v4u*)(lds + L256(SS_CM, X.cmrow1, X.cmch)) = S.rC[1];
    *(LAS v4u*)(lds + L256(SS_BM, X.cmrow0, X.cmch)) = S.rB[0]; *(LAS v4u*)(lds + L256(SS_BM, X.cmrow1, X.cmch)) = S.rB[1];
    *(LAS v4u*)(lds + L128(SS_BT, X.btrow0, X.btch)) = S.rT[0]; *(LAS v4u*)(lds + L128(SS_BT, X.btrow1, X.btch)) = S.rT[1];
    *(LAS v4u*)(lds + L128(SS_XT, X.xtrow, X.xtch)) = S.rX;
    if (w == 0) { const float dt = softplusf_(S.rdt + X.dtb); float a = dt * X.Aneg;
#pragma unroll
        for (int off = 1; off < 64; off <<= 1) { const float t = __shfl_up(a, off); if (lane >= off) a += t; }
        const float a63 = __shfl(a, 63); dtv[lane] = dt; acum[lane] = a; scl[lane] = dt * __expf(a63 - a); }
    LDS_BARRIER();
    if (c + 2 < NCHUNK) ssd_stage_load(X, S, c + 2, tid);
    { const int sb = w >> 1, s0 = 16 * sb;
#pragma unroll
      for (int t = 0; t < 2; ++t) { const int lb = 2 * (w & 1) + t, l0 = 16 * lb; f32x4 acc = (f32x4){0.f, 0.f, 0.f, 0.f};
        if (sb <= lb) {
#pragma unroll
            for (int ks = 0; ks < 4; ++ks) { const bf16x8 a = *(const LAS bf16x8*)(lds + L256(SS_BM, s0 + r16, 4 * ks + q)); const bf16x8 bb = *(const LAS bf16x8*)(lds + L256(SS_CM, l0 + r16, 4 * ks + q));
                acc = __builtin_amdgcn_mfma_f32_16x16x32_bf16(a, bb, acc, 0, 0, 0); } }
        const int l = l0 + r16; const float al = acum[l]; float v[4];
#pragma unroll
        for (int e = 0; e < 4; ++e) { const int s = s0 + 4 * q + e; v[e] = (s <= l) ? acc[e] * __expf(fminf(al - acum[s], 0.f)) * dtv[s] : 0.f; }
        u32x2_t pk; pk.x = pk2(v[0], v[1]); pk.y = pk2(v[2], v[3]);
        *(LAS u32x2_t*)(lds + L128(SS_MM, l, 2 * sb + (q >> 1)) + (q & 1) * 8) = pk; } }
    { const v4u xv = *(const LAS v4u*)(lds + L128(SS_XT, X.xtrow, X.xtch)); v4u o;
#pragma unroll
      for (int e = 0; e < 4; ++e) { const unsigned ww = xv[e]; const float lo = __builtin_bit_cast(float, ww << 16) * scl[X.xtch * 8 + 2 * e], hi = __builtin_bit_cast(float, ww & 0xffff0000u) * scl[X.xtch * 8 + 2 * e + 1]; o[e] = pk2(lo, hi); }
      *(LAS v4u*)(lds + L128(SS_XW, X.xtrow, X.xtch)) = o; }
    LDS_BARRIER();
    { const int lb = w >> 1, l0 = 16 * lb, l = l0 + r16; const float el = __expf(acum[l]); float ss = 0.f;
#pragma unroll
      for (int t = 0; t < 2; ++t) { const int pb = 2 * (w & 1) + t, p0 = 16 * pb; f32x4 a1 = (f32x4){0.f, 0.f, 0.f, 0.f}, a2 = (f32x4){0.f, 0.f, 0.f, 0.f};
#pragma unroll
        for (int ks = 0; ks < 2; ++ks) { const bf16x8 a = *(const LAS bf16x8*)(lds + L128(SS_XT, p0 + r16, 4 * ks + q)); const bf16x8 bb = *(const LAS bf16x8*)(lds + L128(SS_MM, l0 + r16, 4 * ks + q));
            a1 = __builtin_amdgcn_mfma_f32_16x16x32_bf16(a, bb, a1, 0, 0, 0); }
#pragma unroll
        for (int ks = 0; ks < 4; ++ks) { const bf16x8 a = *(const LAS bf16x8*)(lds + L256(SS_STB, p0 + r16, 4 * ks + q)); const bf16x8 bb = *(const LAS bf16x8*)(lds + L256(SS_CM, l0 + r16, 4 * ks + q));
            a2 = __builtin_amdgcn_mfma_f32_16x16x32_bf16(a, bb, a2, 0, 0, 0); }
        bf16* zp = X.Zb + (size_t)(row0 + l) * 2048 + hd * 64 + p0 + 4 * q; const u32x2_t zz = *(const GAS u32x2_t*)zp; float yv[4];
#pragma unroll
        for (int e = 0; e < 4; ++e) { const int p = p0 + 4 * q + e; const float xlp = bf2f(*(const LAS bf16*)(lds + L128(SS_XT, p, l >> 3) + (l & 7) * 2));
            const unsigned zw = zz[e >> 1]; const float z = (e & 1) ? __builtin_bit_cast(float, zw & 0xffff0000u) : __builtin_bit_cast(float, zw << 16);
            const float y = (a1[e] + el * a2[e] + X.Dsk * xlp) * siluf_(z); yv[e] = y; ss += y * y; }
        u32x2_t pk; pk.x = pk2(yv[0], yv[1]); pk.y = pk2(yv[2], yv[3]); if (!dry) *(GAS u32x2_t*)zp = pk; }
      ss += __shfl_xor(ss, 16); ss += __shfl_xor(ss, 32);
      if (q == 0 && !dry) X.SSQ[(size_t)(row0 + l) * 64 + hd * 2 + (w & 1)] = ss; }
    { const float dec = __expf(acum[63]); const int n0 = 16 * w;
#pragma unroll
      for (int pb = 0; pb < 4; ++pb) { accS[pb] = accS[pb] * dec;
#pragma unroll
        for (int ks = 0; ks < 2; ++ks) { const bf16x8 a = *(const LAS bf16x8*)(lds + L128(SS_BT, n0 + r16, 4 * ks + q)); const bf16x8 bb = *(const LAS bf16x8*)(lds + L128(SS_XW, 16 * pb + r16, 4 * ks + q));
            accS[pb] = __builtin_amdgcn_mfma_f32_16x16x32_bf16(a, bb, accS[pb], 0, 0, 0); } } }
    LDS_BARRIER();
#pragma unroll
    for (int pb = 0; pb < 4; ++pb) { u32x2_t pk; pk.x = pk2(accS[pb][0], accS[pb][1]); pk.y = pk2(accS[pb][2], accS[pb][3]);
        *(LAS u32x2_t*)(lds + L256(SS_STB, 16 * pb + r16, 2 * w + (q >> 1)) + (q & 1) * 8) = pk; }
}
__device__ __forceinline__ void ssd_scan_mfma(const Args& args, Frame& F, int unit, bool dry = false) {
    LAS unsigned char* lds = F.lds;
    const int tid = F.tid, lane = F.lane, w = F.wave;
    SsdCtx X;
    X.hd = unit & 31; X.b = unit >> 5; X.g = X.hd >> 3;
    X.XBC = (const bf16*)(F.ws + WS_XBC); X.BT = (const bf16*)(F.ws + WS_BT); X.Zb = (bf16*)(F.ws + WS_Z); X.SMALL = (const float*)(F.ws + WS_SMALL); X.SSQ = (float*)(F.ws + WS_SSQ);
    X.dtb = args.in[6][X.hd]; X.Aneg = -__expf(args.in[7][X.hd]); X.Dsk = args.in[8][X.hd];
    X.cmrow0 = tid >> 4; X.cmrow1 = (tid + 512) >> 4; X.cmch = tid & 15; X.btrow0 = tid >> 3; X.btrow1 = (tid + 512) >> 3; X.btch = tid & 7; X.xtrow = tid >> 3; X.xtch = tid & 7;
    for (int i = tid; i < 16384 / 16; i += 512) *(LAS v4u*)(lds + SS_STB + i * 16) = (v4u){0u, 0u, 0u, 0u};
    f32x4 accS[4];
#pragma unroll
    for (int i = 0; i < 4; ++i) accS[i] = (f32x4){0.f, 0.f, 0.f, 0.f};
    SsdStage SA, SB_; SA.rdt = 0.f; SB_.rdt = 0.f;
    ssd_stage_load(X, SA, 0, tid); ssd_stage_load(X, SB_, 1, tid);
    for (int c = 0; c < NCHUNK; c += 2) { ssd_chunk(X, SA, c, lds, accS, tid, lane, w, dry); ssd_chunk(X, SB_, c + 1, lds, accS, tid, lane, w, dry); }
    LDS_BARRIER();
}

__device__ __forceinline__ void ssd_norm_rows(const Args& args, Frame& F) {
    const int gw = F.vcu * NWAVES + F.wave, NGW = F.G * NWAVES;
    bf16* Zb = (bf16*)(F.ws + WS_Z); const float* SSQ = (const float*)(F.ws + WS_SSQ); const float* gain = args.in[9];
    for (int m = gw; m < M; m += NGW) {
        const int grp = F.lane >> 4; float ss = 0.f;
#pragma unroll
        for (int j = 0; j < 16; ++j) ss += SSQ[(size_t)m * 64 + grp * 16 + j];
        const float rstd = 1.f / sqrtf(ss * (1.f / 512.f) + EPS);
        GAS v4u* p = (GAS v4u*)(Zb + (size_t)m * 2048 + F.lane * 32);
#pragma unroll
        for (int q = 0; q < 4; ++q) { v4u w = p[q]; const float* gp = gain + F.lane * 32 + q * 8; unsigned o[4];
#pragma unroll
            for (int e = 0; e < 4; ++e) { const unsigned ww = w[e]; const float lo = __builtin_bit_cast(float, ww << 16) * rstd * gp[2 * e], hi = __builtin_bit_cast(float, ww & 0xffff0000u) * rstd * gp[2 * e + 1]; o[e] = pk2(lo, hi); }
            v4u ov; ov.x = o[0]; ov.y = o[1]; ov.z = o[2]; ov.w = o[3]; p[q] = ov; }
    }
}
__device__ __forceinline__ void final_norm_rows(const Args& args, Frame& F) {
    const int gw = F.vcu * NWAVES + F.wave, NGW = F.G * NWAVES;
    const float* x = args.in[0]; const float* pg = args.in[23];
    f32x4 gv[4];
#pragma unroll
    for (int j = 0; j < 4; ++j) gv[j] = ((const GAS f32x4*)pg)[F.lane + 64 * j];
    for (int m = gw; m < M; m += NGW) {
        GAS f32x4* orow = (GAS f32x4*)(F.out + (size_t)m * D) + F.lane; const GAS f32x4* xr = (const GAS f32x4*)(x + (size_t)m * D) + F.lane;
        f32x4 v[4]; float s = 0.f;
#pragma unroll
        for (int j = 0; j < 4; ++j) { v[j] = orow[64 * j]; s += (v[j].x * v[j].x + v[j].y * v[j].y) + (v[j].z * v[j].z + v[j].w * v[j].w); }
        const float rstd = 1.f / sqrtf(wave_sum(s) * (1.f / D) + EPS);
#pragma unroll
        for (int j = 0; j < 4; ++j) orow[64 * j] = xr[64 * j] + v[j] * rstd * gv[j];
    }
}

#ifndef SSD_SIMPLE
#define SSD_SIMPLE 0
#endif
__global__ void __launch_bounds__(NWAVES * 64, 2) hybrid_fwd(Args args) {
    extern __shared__ __attribute__((aligned(16))) unsigned char lds[];
    Frame F;
    F.lds = (LAS unsigned char*)lds;
    F.MISC = (volatile LAS unsigned*)(F.lds + MISC_OFF);
    F.tid = threadIdx.x; F.lane = F.tid & 63; F.wave = __builtin_amdgcn_readfirstlane(F.tid >> 6);
    F.G = gridDim.x; { const int bx = blockIdx.x; F.vcu = (F.G % 8 == 0) ? (bx % 8) * (F.G / 8) + bx / 8 : bx; }
    F.out = args.out; F.ws = args.ws;
    F.ctl = (gu32*)(F.ws + WS_CTL);
    for (int u = F.tid; u < (LDS_BYTES - LDSCTL_OFF) / 4; u += NWAVES * 64) ((LAS unsigned*)(F.lds + LDSCTL_OFF))[u] = 0u;
    __syncthreads();
    XcdBarrier bar; bar.bar = (unsigned*)(F.ctl + CW_BAR); bar.x = 0; bar.st = nullptr;
    if (N_LAUNCHES == 1) bar = xcd_barrier_post((unsigned*)(F.ctl + CW_BAR), F.MISC + 8);
#define GRID_BAR() do { if (N_LAUNCHES == 1) xcd_barrier(bar); } while (0)
    const int lo = args.ph_lo, hi = args.ph_hi;
#ifndef PH_MASK
#define PH_MASK 0x1FFF
#endif
#define IN(k) ((((PH_MASK) >> (k)) & 1) && lo <= (k) && (k) < hi)
#define BOTH(k) (IN(k) && IN((k) + 1))
#ifndef REP_MASK
#define REP_MASK 0
#endif
#define REP(k) (((REP_MASK) >> (k)) & 1)
    bf16* Win_t = (bf16*)(F.ws + WS_WIN);
    bf16* Hb = (bf16*)F.out;

    if (IN(0)) { p0_prologue(args, F); if (REP(0)) { GRID_BAR(); p0_prologue(args, F); } if (BOTH(0)) GRID_BAR(); }
    if (IN(1)) {
      for (int rep = 0; rep < (REP(1) ? 2 : 1); ++rep) {
        pg8::Gemm g{Hb, Win_t, M, NT_RW * 256, D}; pg8::StaticOrder S; S.init(M, NT_RW * 256, F.G, (int)blockIdx.x);
        pg8::EpiRW E{(bf16*)(F.ws + WS_RKVG), (bf16*)(F.ws + WS_HALO), (float*)(F.ws + WS_SMALL), M};
        pg8::gemm_phase<pg8::EpiRW, pg8::StaticOrder, PG8_ALIGN, PG8_SP2>(F.lds + RING_OFF, g, S, E);
        if (rep == 0 && REP(1)) GRID_BAR(); }
        if (BOTH(1)) GRID_BAR();
    }
    if (IN(2)) { if (REP(2)) { for (int u = F.vcu; u < NB * NCHUNK * 16; u += F.G) rwkv_local_simple(args, F, u, true); GRID_BAR(); }
                 for (int u = F.vcu; u < NB * NCHUNK * 16; u += F.G) rwkv_local_simple(args, F, u, false); if (BOTH(2)) GRID_BAR(); }
    if (IN(3)) { for (int rep = 0; rep < (REP(3) ? 2 : 1); ++rep) { for (int u = F.vcu; u < NB * 16; u += F.G) rwkv_scan_mfma(args, F, u); if (rep == 0 && REP(3)) GRID_BAR(); } if (BOTH(3)) GRID_BAR(); }
    if (IN(4)) {
      for (int rep = 0; rep < (REP(4) ? 2 : 1); ++rep) {
        pg8::Gemm g{Hb, Win_t + (size_t)NT_RW * 256 * D, M, NT_SSD * 256, D}; pg8::StaticOrder S; S.init(M, NT_SSD * 256, F.G, (int)blockIdx.x);
        pg8::EpiSSD E{(bf16*)(F.ws + WS_Z), (bf16*)(F.ws + WS_XBC), (bf16*)(F.ws + WS_HALOX)};
        pg8::gemm_phase<pg8::EpiSSD, pg8::StaticOrder, PG8_ALIGN, PG8_SP2>(F.lds + RING_OFF, g, S, E);
        if (rep == 0 && REP(4)) GRID_BAR(); }
        if (BOTH(4)) GRID_BAR();
    }
#if SSD_SIMPLE
    if (IN(5)) { if (BOTH(5)) GRID_BAR(); }
    if (IN(6)) { for (int u = F.vcu; u < NB * 32; u += F.G) ssd_scan_simple(args, F, u); if (BOTH(6)) GRID_BAR(); }
#else
    if (IN(5)) { if (REP(5)) { for (int wu = F.vcu * NWAVES + F.wave; wu < NB * NCHUNK * 48; wu += F.G * NWAVES) ssd_conv_unit(args, F, wu, true); GRID_BAR(); }
                 for (int wu = F.vcu * NWAVES + F.wave; wu < NB * NCHUNK * 48; wu += F.G * NWAVES) ssd_conv_unit(args, F, wu, false);
                 rwkv_gate_rows(args, F); if (BOTH(5)) GRID_BAR(); }
    if (IN(6)) { if (REP(6)) { for (int u = F.vcu; u < NB * 32; u += F.G) ssd_scan_mfma(args, F, u, true); GRID_BAR(); }
                 for (int u = F.vcu; u < NB * 32; u += F.G) ssd_scan_mfma(args, F, u, false); if (BOTH(6)) GRID_BAR(); }
#endif
    if (IN(7)) { ssd_norm_rows(args, F); if (BOTH(7)) GRID_BAR(); }
    if (IN(8)) {
      for (int rep = 0; rep < (REP(8) ? 2 : 1); ++rep) {
        pg8::Gemm g{Hb, Win_t + (size_t)(NT_RW + NT_SSD) * 256 * D, M, NT_GATE * 256, D}; pg8::StaticOrder S; S.init(M, NT_GATE * 256, F.G, (int)blockIdx.x);
        pg8::EpiGate E{(bf16*)(F.ws + WS_GATES), args.in[3]};
        pg8::gemm_phase<pg8::EpiGate, pg8::StaticOrder, PG8_ALIGN, PG8_SP2>(F.lds + RING_OFF, g, S, E);
        if (rep == 0 && REP(8)) GRID_BAR(); }
        if (BOTH(8)) GRID_BAR();
    }
    if (IN(9)) {
      for (int rep = 0; rep < (REP(9) ? 2 : 1); ++rep) {
        pg8::Gemm g{(const bf16*)(F.ws + WS_Z), (const bf16*)(F.ws + WS_WSSM), M, D, 2048}; pg8::StaticOrder S; S.init(M, D, F.G, (int)blockIdx.x);
        pg8::EpiT1 E{(float*)(F.ws + WS_T1), (const bf16*)(F.ws + WS_GATES)};
        pg8::gemm_phase<pg8::EpiT1, pg8::StaticOrder, PG8_ALIGN, PG8_SP2>(F.lds + RING_OFF, g, S, E);
        if (rep == 0 && REP(9)) GRID_BAR(); }
        if (BOTH(9)) GRID_BAR();
    }
    if (IN(10)) {
      for (int rep = 0; rep < (REP(10) ? 2 : 1); ++rep) {
        pg8::Gemm g{(const bf16*)((const unsigned char*)F.out + WS_YRWKV_OUT), (const bf16*)(F.ws + WS_WRWKV), M, D, D}; pg8::StaticOrder S; S.init(M, D, F.G, (int)blockIdx.x);
        pg8::EpiMerge E{(bf16*)(F.ws + WS_MERGED), (const float*)(F.ws + WS_T1), (const bf16*)(F.ws + WS_GATES)};
        pg8::gemm_phase<pg8::EpiMerge, pg8::StaticOrder, PG8_ALIGN, PG8_SP2>(F.lds + RING_OFF, g, S, E);
        if (rep == 0 && REP(10)) GRID_BAR(); }
        if (BOTH(10)) GRID_BAR();
    }
    if (IN(11)) {
      for (int rep = 0; rep < (REP(11) ? 2 : 1); ++rep) {
        pg8::Gemm g{(const bf16*)(F.ws + WS_MERGED), (const bf16*)(F.ws + WS_WOUT), M, D, D}; pg8::StaticOrder S; S.init(M, D, F.G, (int)blockIdx.x);
        pg8::EpiF32 E{F.out, D};
        pg8::gemm_phase<pg8::EpiF32, pg8::StaticOrder, PG8_ALIGN, PG8_SP2>(F.lds + RING_OFF, g, S, E);
        if (rep == 0 && REP(11)) GRID_BAR(); }
        if (BOTH(11)) GRID_BAR();
    }
    if (IN(12)) { final_norm_rows(args, F); }
#undef IN
#undef BOTH
}

extern "C" void kernel_launch(void* const* d_in, const int* in_sizes, int n_in, void* d_out, int out_size, void* d_ws, size_t ws_size, hipStream_t stream) {
    static int grid = 0;
    if (grid == 0) {
        if (n_in != 24 || in_sizes[0] != M * D || out_size != M * D || ws_size < WS_END) { fprintf(stderr, "kernel_launch: unexpected shapes (n_in %d, in0 %d, out %d, ws %zu)\n", n_in, n_in > 0 ? in_sizes[0] : -1, out_size, ws_size); grid = -1; return; }
        int dev = 0, cus = 0;
        if (hipGetDevice(&dev) != hipSuccess || hipDeviceGetAttribute(&cus, hipDeviceAttributeMultiprocessorCount, dev) != hipSuccess) { grid = -1; return; }
        if (hipFuncSetAttribute((const void*)hybrid_fwd, hipFuncAttributeMaxDynamicSharedMemorySize, LDS_BYTES) != hipSuccess) { fprintf(stderr, "kernel_launch: hipFuncSetAttribute failed\n"); grid = -1; return; }
        (void)hipGetLastError();
        grid = cus;
    }
    if (grid < 0) return;
    if (hipMemsetAsync((char*)d_ws + WS_CTL, 0, CTL_ZERO_BYTES, stream) != hipSuccess) return;
    Args a{};
    for (int i = 0; i < 24; ++i) a.in[i] = (const float*)d_in[i];
    a.out = (float*)d_out; a.ws = (unsigned char*)d_ws;
    for (int li = 0; li < N_LAUNCHES; ++li) {
        if (N_LAUNCHES == 1) { a.ph_lo = 0; a.ph_hi = N_PHASES; } else { a.ph_lo = li; a.ph_hi = li + 1; }
        a.li = li;
        hipLaunchKernelGGL(hybrid_fwd, dim3(grid), dim3(NWAVES * 64), LDS_BYTES, stream, a);
    }
}
```

```cpp
#include <hip/hip_runtime.h>
#include <cstdio>
#include <cstdint>
#define MK_N_LAUNCHES 1
#define REP_MASK 0
namespace pg8 {
#define PG8_LAS __attribute__((address_space(3)))
typedef unsigned short bf16_t;
typedef short bf16x8 __attribute__((ext_vector_type(8)));
typedef float f32x4 __attribute__((ext_vector_type(4)));
typedef unsigned u32x4 __attribute__((ext_vector_type(4)));
constexpr int BM = 256, BK = 64, HALF = 128, HTB = HALF * BK * 2  , STAGE_BYTES = 8 * HTB, NXCD = 8, WGM = 8;

__host__ __device__ __forceinline__ int lds_byte(int r, int c) { const int st = (r >> 4) * 2 + (c >> 5), rr = r & 15, cc = c & 31, ob = rr * 64 + cc * 2; return st * 1024 + (ob ^ (((ob >> 9) & 1) << 5)); }
__host__ __device__ __forceinline__ void stage_rc(int b, int& R, int& C) { const int st = b / 1024, sb = b % 1024, swz = sb ^ (((sb >> 9) & 1) << 5); R = (st >> 1) * 16 + swz / 64; C = (st & 1) * 32 + (swz % 64) / 2; }
__host__ __device__ __forceinline__ int perm32(int rho) { const int n = rho >> 4, i = rho & 15; return 8 * (i >> 2) + 4 * n + (i & 3); }

struct Unit { int pm, pn; };
struct Gemm { const bf16_t* A; const bf16_t* Bt; int M, N, K; };

struct StaticOrder {
    int nM, nN, nwg, G, c;
    __host__ __device__ void init(int M, int N, int G_, int c_) { nM = M / BM; nN = N / BM; nwg = nM * nN; G = G_; c = c_; }
    __host__ __device__ bool next(int i, Unit& u) const {
        const long L = (long)i * G + c; if (L >= nwg) return false;
        int wgid = (int)L; { const int q = nwg / NXCD, r = nwg % NXCD, xcd = wgid % NXCD, off = wgid / NXCD; wgid = (xcd < r ? xcd * (q + 1) : r * (q + 1) + (xcd - r) * q) + off; }
        const int nig = WGM * nN, gid = wgid / nig, fm = gid * WGM, gsz = (nM - fm) < WGM ? (nM - fm) : WGM;
        u.pm = fm + ((wgid % nig) % gsz); u.pn = (wgid % nig) / gsz; return true;
    }
    __device__ __forceinline__ void a_ready(const Unit&) const {}
    __device__ __forceinline__ void done(const Unit&) const {}
};

__device__ __forceinline__ unsigned cvt_pk_bf16(float lo, float hi) { unsigned r; asm volatile("v_cvt_pk_bf16_f32 %0, %1, %2" : "=v"(r) : "v"(lo), "v"(hi)); return r; }
__device__ __forceinline__ float bf_lo(unsigned w) { return __builtin_bit_cast(float, w << 16); }
__device__ __forceinline__ float bf_hi(unsigned w) { return __builtin_bit_cast(float, w & 0xffff0000u); }
__device__ __forceinline__ float sigmoidf_(float x) { return 1.0f / (1.0f + __expf(-x)); }
typedef unsigned u32x2 __attribute__((ext_vector_type(2)));

struct EpiRW {
    static constexpr bool PERM = true, AFTER_DRAIN = false;
    bf16_t* RKVG; bf16_t* HALO; float* SMALL; int Mrows;
    __device__ __forceinline__ void operator()(const f32x4 (&acc)[2][2][4][2], const Unit& u, int wr, int wc, int fr, int fq) const {
        const int row0 = u.pm * BM + wr * 64 + fr;
        if (u.pn < 16) {
            bf16_t* base = RKVG + (size_t)(u.pn >> 2) * ((size_t)Mrows * 1024);
            const int col0 = (u.pn & 3) * 256 + wc * 32 + 8 * fq;
#pragma unroll
            for (int ai = 0; ai < 2; ++ai)
#pragma unroll
                for (int m = 0; m < 4; ++m) { const int row = row0 + ai * HALF + m * 16; bf16_t* rowp = base + (size_t)row * 1024 + col0;
#pragma unroll
                    for (int bj = 0; bj < 2; ++bj) { const f32x4 v0 = acc[ai][bj][m][0], v1 = acc[ai][bj][m][1];
                        u32x4 w; w.x = cvt_pk_bf16(v0[0], v0[1]); w.y = cvt_pk_bf16(v0[2], v0[3]); w.z = cvt_pk_bf16(v1[0], v1[1]); w.w = cvt_pk_bf16(v1[2], v1[3]);
                        *(u32x4*)(rowp + bj * HALF) = w;
                        if (m == 3 && fr == 15) *(u32x4*)(HALO + (size_t)(row >> 6) * 4096 + u.pn * 256 + wc * 32 + 8 * fq + bj * HALF) = w; } }
        } else {
            const int col0 = wc * 32 + 8 * fq;
#pragma unroll
            for (int ai = 0; ai < 2; ++ai)
#pragma unroll
                for (int m = 0; m < 4; ++m) { float* rowp = SMALL + (size_t)(row0 + ai * HALF + m * 16) * 256 + col0;
#pragma unroll
                    for (int bj = 0; bj < 2; ++bj) { *(f32x4*)(rowp + bj * HALF) = acc[ai][bj][m][0]; *(f32x4*)(rowp + bj * HALF + 4) = acc[ai][bj][m][1]; } }
        }
    }
};
struct EpiSSD {
    static constexpr bool PERM = true, AFTER_DRAIN = false;
    bf16_t* Z; bf16_t* XBC; bf16_t* HALOX;
    __device__ __forceinline__ void operator()(const f32x4 (&acc)[2][2][4][2], const Unit& u, int wr, int wc, int fr, int fq) const {
        const int row0 = u.pm * BM + wr * 64 + fr;
        bf16_t* base; int ldc, colt;
        if (u.pn < 8) { base = Z; ldc = 2048; colt = u.pn * 256; } else { base = XBC; ldc = 3072; colt = (u.pn - 8) * 256; }
        const int col0 = colt + wc * 32 + 8 * fq;
#pragma unroll
        for (int ai = 0; ai < 2; ++ai)
#pragma unroll
            for (int m = 0; m < 4; ++m) { bf16_t* rowp = base + (size_t)(row0 + ai * HALF + m * 16) * ldc + col0;
#pragma unroll
                for (int bj = 0; bj < 2; ++bj) { const f32x4 v0 = acc[ai][bj][m][0], v1 = acc[ai][bj][m][1];
                    u32x4 w; w.x = cvt_pk_bf16(v0[0], v0[1]); w.y = cvt_pk_bf16(v0[2], v0[3]); w.z = cvt_pk_bf16(v1[0], v1[1]); w.w = cvt_pk_bf16(v1[2], v1[3]);
                    *(u32x4*)(rowp + bj * HALF) = w;
                    if (m == 3 && fr >= 13 && u.pn >= 8) { const int row = row0 + ai * HALF + m * 16; *(u32x4*)(HALOX + ((size_t)(row >> 6) * 3 + (fr - 13)) * 3072 + col0 + bj * HALF) = w; } } }
    }
};
struct EpiGate {
    static constexpr bool PERM = true, AFTER_DRAIN = false;
    bf16_t* O; const float* bias;
    __device__ __forceinline__ void operator()(const f32x4 (&acc)[2][2][4][2], const Unit& u, int wr, int wc, int fr, int fq) const {
        const int row0 = u.pm * BM + wr * 64 + fr; const int col0 = u.pn * BM + wc * 32 + 8 * fq;
        f32x4 bv[2][2];
#pragma unroll
        for (int bj = 0; bj < 2; ++bj)
#pragma unroll
            for (int n = 0; n < 2; ++n) bv[bj][n] = *(const f32x4*)(bias + col0 + bj * HALF + 4 * n);
#pragma unroll
        for (int ai = 0; ai < 2; ++ai)
#pragma unroll
            for (int m = 0; m < 4; ++m) { bf16_t* rowp = O + (size_t)(row0 + ai * HALF + m * 16) * 2048 + col0;
#pragma unroll
                for (int bj = 0; bj < 2; ++bj) { f32x4 v0 = acc[ai][bj][m][0] + bv[bj][0], v1 = acc[ai][bj][m][1] + bv[bj][1];
#pragma unroll
                    for (int j = 0; j < 4; ++j) { v0[j] = sigmoidf_(v0[j]); v1[j] = sigmoidf_(v1[j]); }
                    u32x4 w; w.x = cvt_pk_bf16(v0[0], v0[1]); w.y = cvt_pk_bf16(v0[2], v0[3]); w.z = cvt_pk_bf16(v1[0], v1[1]); w.w = cvt_pk_bf16(v1[2], v1[3]);
                    *(u32x4*)(rowp + bj * HALF) = w; } }
    }
};
struct EpiT1 {
    static constexpr bool PERM = false, AFTER_DRAIN = false;
    float* T1; const bf16_t* GATES;
    __device__ __forceinline__ void operator()(const f32x4 (&acc)[2][2][4][2], const Unit& u, int wr, int wc, int fr, int fq) const {
        const int row0 = u.pm * BM + wr * 64 + fr, col0 = u.pn * BM + wc * 32 + 4 * fq;
#pragma unroll
        for (int ai = 0; ai < 2; ++ai)
#pragma unroll
            for (int m = 0; m < 4; ++m) { const size_t row = (size_t)(row0 + ai * HALF + m * 16);
#pragma unroll
                for (int bj = 0; bj < 2; ++bj)
#pragma unroll
                    for (int n = 0; n < 2; ++n) { const int c = col0 + bj * HALF + n * 16; const u32x2 g = *(const u32x2*)(GATES + row * 2048 + c);
                        f32x4 v = acc[ai][bj][m][n]; v[0] *= bf_lo(g.x); v[1] *= bf_hi(g.x); v[2] *= bf_lo(g.y); v[3] *= bf_hi(g.y);
                        *(f32x4*)(T1 + row * 1024 + c) = v; } }
    }
};
struct EpiMerge {
    static constexpr bool PERM = true, AFTER_DRAIN = false;
    bf16_t* O; const float* T1; const bf16_t* GATES;
    __device__ __forceinline__ void operator()(const f32x4 (&acc)[2][2][4][2], const Unit& u, int wr, int wc, int fr, int fq) const {
        const int row0 = u.pm * BM + wr * 64 + fr; const int col0 = u.pn * BM + wc * 32 + 8 * fq;
#pragma unroll
        for (int ai = 0; ai < 2; ++ai)
#pragma unroll
            for (int m = 0; m < 4; ++m) { const size_t row = (size_t)(row0 + ai * HALF + m * 16);
#pragma unroll
                for (int bj = 0; bj < 2; ++bj) { const int c = col0 + bj * HALF;
                    const u32x4 g = *(const u32x4*)(GATES + row * 2048 + 1024 + c);
                    const f32x4 t0 = *(const f32x4*)(T1 + row * 1024 + c), t1 = *(const f32x4*)(T1 + row * 1024 + c + 4);
                    f32x4 v0 = acc[ai][bj][m][0], v1 = acc[ai][bj][m][1];
                    v0[0] = t0[0] + bf_lo(g.x) * v0[0]; v0[1] = t0[1] + bf_hi(g.x) * v0[1]; v0[2] = t0[2] + bf_lo(g.y) * v0[2]; v0[3] = t0[3] + bf_hi(g.y) * v0[3];
                    v1[0] = t1[0] + bf_lo(g.z) * v1[0]; v1[1] = t1[1] + bf_hi(g.z) * v1[1]; v1[2] = t1[2] + bf_lo(g.w) * v1[2]; v1[3] = t1[3] + bf_hi(g.w) * v1[3];
                    u32x4 w; w.x = cvt_pk_bf16(v0[0], v0[1]); w.y = cvt_pk_bf16(v0[2], v0[3]); w.z = cvt_pk_bf16(v1[0], v1[1]); w.w = cvt_pk_bf16(v1[2], v1[3]);
                    *(u32x4*)(O + row * 1024 + c) = w; } }
    }
};
struct EpiF32 {
    static constexpr bool PERM = false, AFTER_DRAIN = false;
    float* C; int ldc;
    __device__ __forceinline__ void operator()(const f32x4 (&acc)[2][2][4][2], const Unit& u, int wr, int wc, int fr, int fq) const {
        const int row0 = u.pm * BM + wr * 64 + fr, col0 = u.pn * BM + wc * 32 + 4 * fq;
#pragma unroll
        for (int ai = 0; ai < 2; ++ai)
#pragma unroll
            for (int m = 0; m < 4; ++m) { float* rowp = C + (size_t)(row0 + ai * HALF + m * 16) * ldc + col0;
#pragma unroll
                for (int bj = 0; bj < 2; ++bj)
#pragma unroll
                    for (int n = 0; n < 2; ++n) *(f32x4*)(rowp + bj * HALF + n * 16) = acc[ai][bj][m][n]; }
    }
};

template <class Epi, class Sched, bool ALIGN_EPI = false, bool SP2 = false>
__device__ __forceinline__ void gemm_phase(PG8_LAS unsigned char* lds, const Gemm g, const Sched& S, const Epi& E) {
    const int tid = threadIdx.x, wid = __builtin_amdgcn_readfirstlane(tid >> 6), lane = tid & 63, wr = wid >> 2, wc = wid & 3, fr = lane & 15, fq = lane >> 4;
    const int K = g.K, nt = K / BK;
    unsigned voffA[2], voffB[2];
#pragma unroll
    for (int i = 0; i < 2; ++i) { int R, C; stage_rc(tid * 16 + i * 8192, R, C); const int Rb = Epi::PERM ? ((R & ~31) + perm32(R & 31)) : R;
        voffA[i] = (unsigned)(R * K + C) * 2u; voffB[i] = (unsigned)(Rb * K + C) * 2u; }
    const size_t kstep = (size_t)(BK * 2);
    const size_t hstep = (size_t)HALF * K * 2;
    const size_t tstep = 2 * hstep;
    const unsigned ldsw = (unsigned)wid * 1024u;
    const int aoff = lds_byte(wr * 64 + fr, fq * 8), boff = lds_byte(wc * 32 + fr, fq * 8);
#define PG8_SA(b, h) (((b) * 2 + (h)) * HTB)
#define PG8_SB(b, h) ((4 + (b) * 2 + (h)) * HTB)
#define PG8_STAGE(bufoff, gbase, voff) do { _Pragma("unroll") for (int _i = 0; _i < 2; ++_i) \
        __builtin_amdgcn_global_load_lds((const unsigned*)((const char*)(gbase) + (voff)[_i]), (PG8_LAS unsigned*)(lds + (bufoff) + ldsw + _i * 8192), 16, 0, 0); } while (0)
#define PG8_LDA(dst, b, h) do { _Pragma("unroll") for (int m = 0; m < 4; ++m) _Pragma("unroll") for (int k = 0; k < 2; ++k) dst[m][k] = *(const PG8_LAS bf16x8*)(lds + PG8_SA(b, h) + aoff + m * 2048 + k * 1024); } while (0)
#define PG8_LDB(dst, b, h) do { _Pragma("unroll") for (int n = 0; n < 2; ++n) _Pragma("unroll") for (int k = 0; k < 2; ++k) dst[n][k] = *(const PG8_LAS bf16x8*)(lds + PG8_SB(b, h) + boff + n * 2048 + k * 1024); } while (0)
#define PG8_MMA(ai, bj, At, Bt) do { __builtin_amdgcn_s_setprio(1); _Pragma("unroll") for (int m = 0; m < 4; ++m) _Pragma("unroll") for (int n = 0; n < 2; ++n) _Pragma("unroll") for (int k = 0; k < 2; ++k) \
        acc[ai][bj][m][n] = __builtin_amdgcn_mfma_f32_16x16x32_bf16(Bt[n][k], At[m][k], acc[ai][bj][m][n], 0, 0, 0); __builtin_amdgcn_s_setprio(0); } while (0)
#define PG8_WAIT_V(n) asm volatile("s_waitcnt vmcnt(" #n ")" ::: "memory")
#define PG8_WAIT_L(n) asm volatile("s_waitcnt lgkmcnt(" #n ")" ::: "memory")
#define PG8_BAR __builtin_amdgcn_s_barrier()
#define PG8_SCHED __builtin_amdgcn_sched_barrier(0)
    Unit cur, nxt; int ui = 0;
    if (!S.next(0, cur)) return;
    f32x4 acc[2][2][4][2];
#pragma unroll
    for (int a = 0; a < 2; ++a)
#pragma unroll
        for (int b = 0; b < 2; ++b)
#pragma unroll
            for (int m = 0; m < 4; ++m)
#pragma unroll
                for (int n = 0; n < 2; ++n) acc[a][b][m][n] = (f32x4){0.f, 0.f, 0.f, 0.f};
    bf16x8 At[4][2], B0[2][2], B1[2][2];
    const char* cA = (const char*)g.A + (size_t)cur.pm * tstep; const char* cB = (const char*)g.Bt + (size_t)cur.pn * tstep;
    S.a_ready(cur);
    if constexpr (SP2) {
        PG8_STAGE(PG8_SB(0, 0), cB, voffB); PG8_STAGE(PG8_SB(0, 1), cB + hstep, voffB); PG8_STAGE(PG8_SA(0, 0), cA, voffA); PG8_STAGE(PG8_SA(0, 1), cA + hstep, voffA);
        if (wr == 1) PG8_BAR;
        PG8_WAIT_V(2); PG8_BAR;
        PG8_STAGE(PG8_SB(1, 0), cB + kstep, voffB); PG8_STAGE(PG8_SA(1, 0), cA + kstep, voffA); PG8_STAGE(PG8_SB(1, 1), cB + hstep + kstep, voffB);
        PG8_WAIT_V(6); PG8_BAR;
    } else {
        PG8_STAGE(PG8_SB(0, 0), cB, voffB); PG8_STAGE(PG8_SA(0, 0), cA, voffA); PG8_STAGE(PG8_SB(0, 1), cB + hstep, voffB); PG8_STAGE(PG8_SA(0, 1), cA + hstep, voffA);
        if (wr == 1) PG8_BAR;
        PG8_WAIT_V(4); PG8_BAR;
        PG8_STAGE(PG8_SB(1, 0), cB + kstep, voffB); PG8_STAGE(PG8_SA(1, 0), cA + kstep, voffA); PG8_STAGE(PG8_SB(1, 1), cB + hstep + kstep, voffB);
        PG8_WAIT_V(6); PG8_BAR;
    }
    for (;;) {
        const bool has_next = S.next(ui + 1, nxt);
        const char* nA = has_next ? (const char*)g.A + (size_t)nxt.pm * tstep : cA; const char* nB = has_next ? (const char*)g.Bt + (size_t)nxt.pn * tstep : cB;
        for (int t = 0; t < nt; t += 2) {
            const bool last = (t == nt - 2);
            const char* a1 = cA + (size_t)(t + 1) * kstep;
            const char* a2 = last ? nA : cA + (size_t)(t + 2) * kstep; const char* b2 = last ? nB : cB + (size_t)(t + 2) * kstep;
            const char* a3 = a2 + kstep; const char* b3 = b2 + kstep;
            if (last && has_next) S.a_ready(nxt);
            if constexpr (SP2) {
            PG8_LDB(B0, 0, 0); PG8_LDB(B1, 0, 1); PG8_SCHED; PG8_LDA(At, 0, 0); PG8_STAGE(PG8_SA(1, 1), a1 + hstep, voffA);
            PG8_WAIT_V(8); PG8_WAIT_L(0); PG8_BAR; PG8_MMA(0, 0, At, B0); PG8_MMA(0, 1, At, B1); PG8_BAR; PG8_SCHED;
            PG8_LDA(At, 0, 1); PG8_STAGE(PG8_SB(0, 0), b2, voffB); PG8_STAGE(PG8_SB(0, 1), b2 + hstep, voffB); PG8_STAGE(PG8_SA(0, 0), a2, voffA);
            PG8_WAIT_V(8); PG8_WAIT_L(0); PG8_BAR; PG8_MMA(1, 0, At, B0); PG8_MMA(1, 1, At, B1); PG8_BAR; PG8_SCHED;
            PG8_LDB(B0, 1, 0); PG8_LDB(B1, 1, 1); PG8_SCHED; PG8_LDA(At, 1, 0); PG8_STAGE(PG8_SA(0, 1), a2 + hstep, voffA);
            PG8_WAIT_V(8); PG8_WAIT_L(0); PG8_BAR; PG8_MMA(0, 0, At, B0); PG8_MMA(0, 1, At, B1); PG8_BAR; PG8_SCHED;
            PG8_LDA(At, 1, 1); PG8_STAGE(PG8_SB(1, 0), b3, voffB); PG8_STAGE(PG8_SB(1, 1), b3 + hstep, voffB); PG8_STAGE(PG8_SA(1, 0), a3, voffA);
            PG8_WAIT_V(8); PG8_WAIT_L(0); PG8_BAR; PG8_MMA(1, 0, At, B0); PG8_MMA(1, 1, At, B1); PG8_BAR; PG8_SCHED;
            } else {
            PG8_LDB(B0, 0, 0); PG8_SCHED; PG8_LDA(At, 0, 0); PG8_STAGE(PG8_SA(1, 1), a1 + hstep, voffA);
            PG8_WAIT_L(8); PG8_BAR; PG8_WAIT_L(0); PG8_MMA(0, 0, At, B0); PG8_BAR; PG8_SCHED;
            PG8_LDB(B1, 0, 1); PG8_STAGE(PG8_SB(0, 0), b2, voffB);
            PG8_BAR; PG8_WAIT_L(0); PG8_MMA(0, 1, At, B1); PG8_BAR;
            PG8_LDA(At, 0, 1); PG8_STAGE(PG8_SA(0, 0), a2, voffA);
            PG8_BAR; PG8_WAIT_L(0); PG8_MMA(1, 0, At, B0); PG8_BAR; PG8_SCHED;
            PG8_STAGE(PG8_SB(0, 1), b2 + hstep, voffB);
            PG8_WAIT_V(6); PG8_BAR; PG8_MMA(1, 1, At, B1); PG8_BAR;
            PG8_LDB(B0, 1, 0); PG8_SCHED; PG8_LDA(At, 1, 0); PG8_STAGE(PG8_SA(0, 1), a2 + hstep, voffA);
            PG8_WAIT_L(8); PG8_BAR; PG8_WAIT_L(0); PG8_MMA(0, 0, At, B0); PG8_BAR; PG8_SCHED;
            PG8_LDB(B1, 1, 1); PG8_STAGE(PG8_SB(1, 0), b3, voffB);
            PG8_BAR; PG8_WAIT_L(0); PG8_MMA(0, 1, At, B1); PG8_BAR;
            PG8_LDA(At, 1, 1); PG8_STAGE(PG8_SA(1, 0), a3, voffA);
            PG8_BAR; PG8_WAIT_L(0); PG8_MMA(1, 0, At, B0); PG8_BAR; PG8_SCHED;
            PG8_STAGE(PG8_SB(1, 1), b3 + hstep, voffB);
            PG8_WAIT_V(6); PG8_BAR; PG8_MMA(1, 1, At, B1); PG8_BAR;
            }
        }
        if constexpr (ALIGN_EPI) { if (wr == 0) PG8_BAR; }
        if constexpr (!Epi::AFTER_DRAIN) { E(acc, cur, wr, wc, fr, fq); S.done(cur); }
        if (!has_next) break;
#pragma unroll
        for (int a = 0; a < 2; ++a)
#pragma unroll
            for (int b = 0; b < 2; ++b)
#pragma unroll
                for (int m = 0; m < 4; ++m)
#pragma unroll
                    for (int n = 0; n < 2; ++n) acc[a][b][m][n] = (f32x4){0.f, 0.f, 0.f, 0.f};
        cur = nxt; cA = nA; cB = nB; ++ui;
        if constexpr (ALIGN_EPI) { if (wr == 1) PG8_BAR; }
    }
    PG8_WAIT_V(0);
    if constexpr (!ALIGN_EPI) { if (wr == 0) PG8_BAR; }
    PG8_BAR;
    if constexpr (Epi::AFTER_DRAIN) { E.fused(acc, cur, wr, wc, fr, fq, lds, wid, lane); S.done(cur); }
#undef PG8_SA
#undef PG8_SB
#undef PG8_STAGE
#undef PG8_LDA
#undef PG8_LDB
#undef PG8_MMA
#undef PG8_WAIT_V
#undef PG8_WAIT_L
#undef PG8_BAR
#undef PG8_SCHED
}
}

#ifndef PG8_SP2
#define PG8_SP2 true
#endif
#ifndef PG8_ALIGN
#define PG8_ALIGN true
#endif
constexpr int NWAVES = 8;
#ifndef MK_N_LAUNCHES
#define MK_N_LAUNCHES 1
#endif
constexpr int N_PHASES = 13;
constexpr int N_LAUNCHES = MK_N_LAUNCHES;

constexpr int NB = 4, SEQ = 4096, D = 1024, M = NB * SEQ;
constexpr int IN_COLS = 11424;
constexpr int C_Z = 0, C_XBC = 2048, C_DT = 5120, C_RW = 5152, C_WD = 9248, C_AD = 9312, C_GATE = 9376;
constexpr int NT_RW = 17, NT_SSD = 20, NT_GATE = 8, NT_IN = NT_RW + NT_SSD + NT_GATE;
constexpr int NCHUNK = SEQ / 64;
constexpr float EPS = 1e-6f, GN_EPS = 64.0f * 1e-5f;

constexpr size_t MiB = 1u << 20;
constexpr size_t WS_CTL = 0, CTL_ZERO_BYTES = 64 * 1024;
constexpr size_t WS_WIN = 1 * MiB;
constexpr size_t WS_WSSM = 24 * MiB, WS_WRWKV = 28 * MiB, WS_WOUT = 30 * MiB;
constexpr size_t WS_RKVG = 32 * MiB;
constexpr size_t WS_GH = 160 * MiB;
constexpr size_t WS_SMALL = 224 * MiB;
constexpr size_t WS_HALO = 240 * MiB;
constexpr size_t WS_SB = 242 * MiB;
constexpr size_t WS_SSQ = 243 * MiB;
constexpr size_t WS_HALOX = 247 * MiB;
constexpr size_t WS_BT = 1 * MiB;
constexpr size_t WS_END = 256 * MiB;
constexpr size_t WS_XBC = 32 * MiB;
constexpr size_t WS_Z = 160 * MiB;
constexpr size_t WS_GATES = 32 * MiB;
constexpr size_t WS_MERGED = 224 * MiB;
constexpr size_t WS_T1 = 96 * MiB;
constexpr size_t WS_YRWKV_OUT = 32 * MiB;
constexpr size_t WS_YRWKV = WS_RKVG + 3 * 32 * MiB;
constexpr int CW_TMO = 0, CW_CODE = 1, CW_BAR = 4096;

constexpr int RING_OFF = 0, RING_BYTES = 131072;
constexpr int LDS_BYTES = 163840;
constexpr int MISC_OFF = LDS_BYTES - 256;
constexpr int LDSCTL_OFF = MISC_OFF;

#define GAS __attribute__((address_space(1)))
#define LAS __attribute__((address_space(3)))
typedef unsigned short bf16;
typedef unsigned v4u __attribute__((ext_vector_type(4)));
typedef float f32x4 __attribute__((ext_vector_type(4)));
typedef short bf16x8 __attribute__((ext_vector_type(8)));
typedef GAS unsigned gu32;
typedef GAS unsigned long long gu64;
#define RLX_AGENT __ATOMIC_RELAXED, __HIP_MEMORY_SCOPE_AGENT
#define LDS_WAIT() asm volatile("s_waitcnt lgkmcnt(0)" ::: "memory")
#define VM_WAIT() asm volatile("s_waitcnt vmcnt(0)" ::: "memory")
__device__ __forceinline__ unsigned long long rt() { return __builtin_amdgcn_s_memrealtime(); }
__device__ __forceinline__ unsigned f2bf(float f) { unsigned u = __builtin_bit_cast(unsigned, f); return (u + 0x7fffu + ((u >> 16) & 1u)) >> 16; }
__device__ __forceinline__ unsigned pk2(float lo, float hi) { return f2bf(lo) | (f2bf(hi) << 16); }

#define XB_TMO      128
#define XB_XCNT(j)  (256  + 64 * (j))
#define XB_XSUB(j)  (1280 + 64 * (j))
#define XB_XGEN(j)  (2304 + 64 * (j))
#define XB_TOP      3328
#define XB_TOPGEN   3392
#define XCD_BAR_WORDS 3456
#define XB_SPIN_CAP (1u << 18)

__device__ __forceinline__ unsigned xb_ld(unsigned* p)              { return __hip_atomic_load(p, __ATOMIC_RELAXED, __HIP_MEMORY_SCOPE_AGENT); }
__device__ __forceinline__ unsigned xb_add(unsigned* p, unsigned v) { return __hip_atomic_fetch_add(p, v, __ATOMIC_RELAXED, __HIP_MEMORY_SCOPE_AGENT); }
__device__ __forceinline__ unsigned xb_xcc_id() { return (unsigned)__builtin_amdgcn_s_getreg((3 << 11) | 20) & 0xFu; }
#define XB_SPIN(cond, bar) do { unsigned _sp = 0; while (cond) { __builtin_amdgcn_s_sleep(1); \
    if ((++_sp & 255u) == 0u) { if (xb_ld(&(bar)[XB_TMO])) break; if (_sp > XB_SPIN_CAP) { atomicAdd(&(bar)[XB_TMO], 1u); break; } } } } while (0)

struct XcdBarrier {
    unsigned* bar; unsigned x;
    volatile LAS unsigned* st;
};

__device__ __forceinline__ XcdBarrier xcd_barrier_post(unsigned* bar, volatile LAS unsigned* st) {
    XcdBarrier b; b.bar = bar; b.x = xb_xcc_id(); b.st = st;
    if (threadIdx.x == 0) (void)xb_add(&bar[XB_XCNT(b.x)], 1u);
    return b;
}
__device__ __forceinline__ void xcd_barrier_complete(unsigned* bar, unsigned x, unsigned& nloc, unsigned& nx) {
    const unsigned G = gridDim.x * gridDim.y * gridDim.z;
    unsigned sum, cnt, mine, sp = 0u;
    for (;;) {
        sum = 0u; cnt = 0u; mine = 0u;
#pragma unroll
        for (unsigned j = 0; j < 16; ++j) { const unsigned c = xb_ld(&bar[XB_XCNT(j)]); sum += c; cnt += (c > 0u) ? 1u : 0u; mine = (j == x) ? c : mine; }
        if (sum == G) break;
        __builtin_amdgcn_s_sleep(1);
        if ((++sp & 255u) == 0u) { if (xb_ld(&bar[XB_TMO])) break; if (sp > XB_SPIN_CAP) { atomicAdd(&bar[XB_TMO], 1u); break; } }
    }
    nloc = mine > 0u ? mine : 1u; nx = cnt > 0u ? cnt : 1u;
}

__device__ __forceinline__ void xcd_barrier(const XcdBarrier& b) {
    asm volatile("s_waitcnt vmcnt(0)" ::: "memory");
    __syncthreads();
    if (threadIdx.x == 0) {
        unsigned* bar = b.bar;
        __builtin_amdgcn_s_waitcnt(0);
        unsigned nloc = b.st[0], nx = b.st[1];
        if (nloc == 0u) { xcd_barrier_complete(bar, b.x, nloc, nx); b.st[0] = nloc; b.st[1] = nx; }
        const unsigned old = xb_add(&bar[XB_XSUB(b.x)], 1u);
        const unsigned gen = old / nloc;
        if (old + 1u == (gen + 1u) * nloc) {
            __builtin_amdgcn_fence(__ATOMIC_RELEASE, "agent");
            asm volatile("s_waitcnt vmcnt(0)" ::: "memory");
            const unsigned og = xb_add(&bar[XB_TOP], 1u);
            const unsigned tg = og / nx;
            if (og + 1u == (tg + 1u) * nx) xb_add(&bar[XB_TOPGEN], 1u);
            else XB_SPIN(xb_ld(&bar[XB_TOPGEN]) == tg, bar);
            __builtin_amdgcn_fence(__ATOMIC_ACQUIRE, "agent");
            xb_add(&bar[XB_XGEN(b.x)], 1u);
            asm volatile("s_waitcnt vmcnt(0)" ::: "memory");
        } else {
            XB_SPIN(xb_ld(&bar[XB_XGEN(b.x)]) == gen, bar);
            __builtin_amdgcn_fence(__ATOMIC_ACQUIRE, "agent");
            asm volatile("s_waitcnt vmcnt(0)" ::: "memory");
        }
    }
    __syncthreads();
}
struct Args { const float* in[24]; float* out; unsigned char* ws; int ph_lo, ph_hi, li, pad; };
struct Frame {
    LAS unsigned char* lds;
    volatile LAS unsigned* MISC;
    gu32* ctl;
    int tid, lane, wave;
    int vcu, G;
    float* out; unsigned char* ws;
};
__device__ __forceinline__ float wave_sum(float v) {
#pragma unroll
    for (int o = 1; o < 64; o <<= 1) v += __shfl_xor(v, o);
    return v;
}
__device__ __forceinline__ float bf2f(bf16 v) { return __builtin_bit_cast(float, (unsigned)v << 16); }
#define LDS_BARRIER() do { asm volatile("s_waitcnt lgkmcnt(0)" ::: "memory"); __builtin_amdgcn_s_barrier(); asm volatile("" ::: "memory"); } while (0)
__device__ __forceinline__ float bf_lo_(unsigned w) { return __builtin_bit_cast(float, w << 16); }
__device__ __forceinline__ float bf_hi_(unsigned w) { return __builtin_bit_cast(float, w & 0xffff0000u); }
typedef unsigned u32x2_t __attribute__((ext_vector_type(2)));
__device__ __forceinline__ float softplusf_(float x) { return x > 20.f ? x : __logf(1.0f + __expf(x)); }
__device__ __forceinline__ float siluf_(float x) { return x / (1.0f + __expf(-x)); }
__device__ __forceinline__ float sigm_(float x) { return 1.0f / (1.0f + __expf(-x)); }

__device__ __forceinline__ void p0_transpose_item(const float* W, int ldw, int sc0, bf16* WT, int Kd, int dr0, int k0, LAS float* scr, int lane) {
    if (sc0 >= 0) {
#pragma unroll 8
        for (int i = 0; i < 32; ++i) { const int kk = 2 * i + (lane >> 5); scr[kk * 33 + (lane & 31)] = W[(size_t)(k0 + kk) * ldw + sc0 + (lane & 31)]; }
    } else {
#pragma unroll 8
        for (int i = 0; i < 32; ++i) { const int kk = 2 * i + (lane >> 5); scr[kk * 33 + (lane & 31)] = 0.f; }
    }
    LDS_WAIT(); asm volatile("" ::: "memory");
    const int c = lane & 7;
#pragma unroll
    for (int j = 0; j < 4; ++j) { const int n = (lane >> 3) + 8 * j; const LAS float* s = scr + (8 * c) * 33 + n;
        v4u o; o.x = pk2(s[0 * 33], s[1 * 33]); o.y = pk2(s[2 * 33], s[3 * 33]); o.z = pk2(s[4 * 33], s[5 * 33]); o.w = pk2(s[6 * 33], s[7 * 33]);
        *(GAS v4u*)(WT + (size_t)(dr0 + n) * Kd + k0 + 8 * c) = o; }
    LDS_WAIT(); asm volatile("" ::: "memory");
}
__device__ __forceinline__ int win_src_col(int db) {
    if (db < 128) return C_RW + 32 * db;
    if (db < 136) { const int b = db - 128; if (b == 0) return C_DT; if (b <= 2) return C_WD + 32 * (b - 1); if (b <= 4) return C_AD + 32 * (b - 3); return -1; }
    if (db < 200) return C_Z + 32 * (db - 136);
    if (db < 296) return C_XBC + 32 * (db - 200);
    return C_GATE + 32 * (db - 296);
}
__device__ __forceinline__ void p0_prologue(const Args& args, Frame& F) {
    LAS float* scr = (LAS float*)(F.lds + RING_OFF + F.wave * 16384);
    const int gw = F.vcu * NWAVES + F.wave, NGW = F.G * NWAVES;
    bf16* Win_t = (bf16*)(F.ws + WS_WIN); bf16* Wssm_t = (bf16*)(F.ws + WS_WSSM); bf16* Wrwkv_t = (bf16*)(F.ws + WS_WRWKV); bf16* Wout_t = (bf16*)(F.ws + WS_WOUT);
    constexpr int I_IN = 16 * (NT_IN * 8), I_SSM = 32 * 32, I_RW = 16 * 32, I_OUT = 16 * 32;
    constexpr int NITEMS = I_IN + I_SSM + I_RW + I_OUT;
    for (int it = gw; it < NITEMS; it += NGW) {
        int r = it;
        if (r < I_IN) { const int kb = r / (NT_IN * 8), db = r % (NT_IN * 8); p0_transpose_item(args.in[2], IN_COLS, win_src_col(db), Win_t, D, 32 * db, 64 * kb, scr, F.lane); continue; } r -= I_IN;
        if (r < I_SSM) { const int kb = r / 32, nb = r % 32; p0_transpose_item(args.in[20], D, 32 * nb, Wssm_t, 2048, 32 * nb, 64 * kb, scr, F.lane); continue; } r -= I_SSM;
        if (r < I_RW) { const int kb = r / 32, nb = r % 32; p0_transpose_item(args.in[21], D, 32 * nb, Wrwkv_t, D, 32 * nb, 64 * kb, scr, F.lane); continue; } r -= I_RW;
        { const int kb = r / 32, nb = r % 32; p0_transpose_item(args.in[22], D, 32 * nb, Wout_t, D, 32 * nb, 64 * kb, scr, F.lane); }
    }
    bf16* H = (bf16*)F.out; const float* x = args.in[0]; const float* pg = args.in[1];
    f32x4 gv[4];
#pragma unroll
    for (int j = 0; j < 4; ++j) gv[j] = ((const GAS f32x4*)pg)[F.lane + 64 * j];
    for (int m = gw; m < M; m += NGW) {
        const GAS f32x4* xr = (const GAS f32x4*)(x + (size_t)m * D) + F.lane;
        f32x4 v[4]; float s = 0.f;
#pragma unroll
        for (int j = 0; j < 4; ++j) { v[j] = xr[64 * j]; s += (v[j].x * v[j].x + v[j].y * v[j].y) + (v[j].z * v[j].z + v[j].w * v[j].w); }
        const float rstd = 1.f / sqrtf(wave_sum(s) * (1.f / D) + EPS);
        GAS unsigned long long* o8 = (GAS unsigned long long*)(H + (size_t)m * D) + F.lane;
#pragma unroll
        for (int j = 0; j < 4; ++j) { const f32x4 w = v[j] * rstd * gv[j]; o8[64 * j] = (unsigned long long)pk2(w.x, w.y) | ((unsigned long long)pk2(w.z, w.w) << 32); }
    }
}

__device__ __forceinline__ int kidx(int pr, int g, int j) { return 16 * (2 * pr + (j >> 2)) + 4 * g + (j & 3); }
__device__ __forceinline__ size_t fp_off(int row0, int h, int x) { return (size_t)(row0 + (x >> 6)) * 1024 + h * 64 + (x & 63); }
__device__ __forceinline__ bf16x8 pack_tiles(const f32x4& a, const f32x4& b) {
    v4u w; w.x = pk2(a[0], a[1]); w.y = pk2(a[2], a[3]); w.z = pk2(b[0], b[1]); w.w = pk2(b[2], b[3]); return __builtin_bit_cast(bf16x8, w); }

constexpr int RS_ZBUF = 0, RS_GV = 16384, RS_SB = 53824, RS_YB = 54336, RS_PAR = 72768, RS_ROWB = 144;
__device__ __forceinline__ void rwkv_scan_mfma(const Args& args, Frame& F, int unit) {
    LAS unsigned char* lds = F.lds;
    const int tid = F.tid, lane = F.lane, w = F.wave, q = lane >> 4, r16 = lane & 15;
    const int h = unit & 15, b = unit >> 4; const bool zw = w < 4; const int wb = w & 3;
    const bf16* Rb = (const bf16*)(F.ws + WS_RKVG); const bf16* Kb = Rb + (size_t)M * 1024; const bf16* Vb = Kb + (size_t)M * 1024;
    bf16* Yo = (bf16*)((unsigned char*)F.out + WS_YRWKV_OUT); const float* SB = (const float*)(F.ws + WS_SB);
    if (tid < 192) { const int k = tid >> 6, cc = tid & 63; const float* src = k == 0 ? args.in[18] + h * 64 : k == 1 ? args.in[19] + h * 64 : args.in[10] + 2048 + h * 64;
        ((LAS float*)(lds + RS_PAR))[tid] = src[cc]; }
    f32x4 Z[4];
#pragma unroll
    for (int i = 0; i < 4; ++i) Z[i] = (f32x4){0.f, 0.f, 0.f, 0.f};
    v4u gf[4][2]; u32x2_t hf[4];
    v4u rf[2]; u32x2_t yf[4];
    v4u sg[3]; float ssb = 0.f;
#define RS_LOAD(cc) do { const bf16* GH_ = (const bf16*)(F.ws + WS_GH) + (size_t)((b * 16 + h) * 64 + (cc)) * 8192; const int row0_ = b * SEQ + (cc) * 64; \
        if (zw) { _Pragma("unroll") for (int i = 0; i < 4; ++i) { gf[i][0] = *(const GAS v4u*)(GH_ + ((i * 2 + 0) * 64 + lane) * 8); gf[i][1] = *(const GAS v4u*)(GH_ + ((i * 2 + 1) * 64 + lane) * 8); \
                hf[i] = *(const GAS u32x2_t*)(GH_ + 4096 + ((i * 4 + wb) * 64 + lane) * 4); } } \
        else { rf[0] = *(const GAS v4u*)(Rb + fp_off(row0_, h, ((wb * 2 + 0) * 64 + lane) * 8)); rf[1] = *(const GAS v4u*)(Rb + fp_off(row0_, h, ((wb * 2 + 1) * 64 + lane) * 8)); \
            _Pragma("unroll") for (int i = 0; i < 4; ++i) yf[i] = *(const GAS u32x2_t*)(Kb + fp_off(row0_, h, ((wb * 4 + i) * 64 + lane) * 4)); } } while (0)
#define RS_GVLOAD(cc) do { const int row0_ = b * SEQ + (cc) * 64; \
        _Pragma("unroll") for (int k = 0; k < 3; ++k) { const int p = tid + 256 * k; sg[k] = (v4u){0u, 0u, 0u, 0u}; \
            if (p < 520) { const int rr = p >> 3, ch = p & 7; \
                if (rr > 0 || (cc) > 0) sg[k] = *(const GAS v4u*)(Vb + (size_t)(row0_ + rr - 1) * 1024 + h * 64 + ch * 8); } } \
        if (tid < 64) ssb = SB[(size_t)(row0_ + tid) * 16 + h]; } while (0)
#define RS_GVSTORE(par) do { \
        _Pragma("unroll") for (int k = 0; k < 3; ++k) { const int p = tid + 256 * k; \
            if (p < 520) { const int rr = p >> 3, ch = p & 7; *(LAS v4u*)(lds + RS_GV + ((par) * 65 + rr) * RS_ROWB + ch * 16) = sg[k]; } } \
        if (tid < 64) ((LAS float*)(lds + RS_SB))[(par) * 64 + tid] = ssb; } while (0)
    RS_LOAD(0);
    if (zw) {
        RS_GVLOAD(0); RS_GVSTORE(0); RS_GVLOAD(1);
        { const bf16x8 z0 = pack_tiles(Z[0], Z[1]);
          *(LAS bf16x8*)(lds + RS_ZBUF + (((0 * 4 + wb) * 2 + 0) * 64 + lane) * 16) = z0; *(LAS bf16x8*)(lds + RS_ZBUF + (((0 * 4 + wb) * 2 + 1) * 64 + lane) * 16) = z0; }
        LDS_BARRIER();
        for (int c = 0; c < NCHUNK; ++c) {
            const int par = c & 1;
            const bf16x8 zp0 = pack_tiles(Z[0], Z[1]), zp1 = pack_tiles(Z[2], Z[3]);
#pragma unroll
            for (int i = 0; i < 4; ++i) {
                f32x4 zn; zn[0] = bf_lo_(hf[i].x); zn[1] = bf_hi_(hf[i].x); zn[2] = bf_lo_(hf[i].y); zn[3] = bf_hi_(hf[i].y);
                zn = __builtin_amdgcn_mfma_f32_16x16x32_bf16(__builtin_bit_cast(bf16x8, gf[i][0]), zp0, zn, 0, 0, 0);
                zn = __builtin_amdgcn_mfma_f32_16x16x32_bf16(__builtin_bit_cast(bf16x8, gf[i][1]), zp1, zn, 0, 0, 0);
                Z[i] = zn; }
            if (c + 1 < NCHUNK) { RS_LOAD(c + 1);
                *(LAS bf16x8*)(lds + RS_ZBUF + ((((par ^ 1) * 4 + wb) * 2 + 0) * 64 + lane) * 16) = pack_tiles(Z[0], Z[1]);
                *(LAS bf16x8*)(lds + RS_ZBUF + ((((par ^ 1) * 4 + wb) * 2 + 1) * 64 + lane) * 16) = pack_tiles(Z[2], Z[3]);
                RS_GVSTORE(par ^ 1); if (c + 2 < NCHUNK) RS_GVLOAD(c + 2); }
            if (c > 0) { const int rowp = b * SEQ + (c - 1) * 64;
#pragma unroll
                for (int k = 0; k < 2; ++k) { const int p = tid + 256 * k, t = p >> 3, ch = p & 7;
                    *(GAS v4u*)(Yo + (size_t)(rowp + t) * 1024 + h * 64 + ch * 8) = *(const LAS v4u*)(lds + RS_YB + ((par ^ 1) * 64 + t) * RS_ROWB + ch * 16); } }
            LDS_BARRIER();
        }
        { const int rowp = b * SEQ + (NCHUNK - 1) * 64;
#pragma unroll
          for (int k = 0; k < 2; ++k) { const int p = tid + 256 * k, t = p >> 3, ch = p & 7;
            *(GAS v4u*)(Yo + (size_t)(rowp + t) * 1024 + h * 64 + ch * 8) = *(const LAS v4u*)(lds + RS_YB + (((NCHUNK - 1) & 1) * 64 + t) * RS_ROWB + ch * 16); } }
        LDS_BARRIER();
    } else {
        LDS_BARRIER();
        for (int c = 0; c < NCHUNK; ++c) {
            const int par = c & 1;
            f32x4 Y[4];
#pragma unroll
            for (int i = 0; i < 4; ++i) {
                const bf16x8 zp0 = *(const LAS bf16x8*)(lds + RS_ZBUF + (((par * 4 + i) * 2 + 0) * 64 + lane) * 16), zp1 = *(const LAS bf16x8*)(lds + RS_ZBUF + (((par * 4 + i) * 2 + 1) * 64 + lane) * 16);
                f32x4 yy; yy[0] = bf_lo_(yf[i].x); yy[1] = bf_hi_(yf[i].x); yy[2] = bf_lo_(yf[i].y); yy[3] = bf_hi_(yf[i].y);
                yy = __builtin_amdgcn_mfma_f32_16x16x32_bf16(zp0, __builtin_bit_cast(bf16x8, rf[0]), yy, 0, 0, 0);
                yy = __builtin_amdgcn_mfma_f32_16x16x32_bf16(zp1, __builtin_bit_cast(bf16x8, rf[1]), yy, 0, 0, 0);
                Y[i] = yy; }
            if (c + 1 < NCHUNK) RS_LOAD(c + 1);
            float s1 = 0.f, s2 = 0.f;
#pragma unroll
            for (int i = 0; i < 4; ++i) { s1 += (Y[i][0] + Y[i][1]) + (Y[i][2] + Y[i][3]); s2 += (Y[i][0] * Y[i][0] + Y[i][1] * Y[i][1]) + (Y[i][2] * Y[i][2] + Y[i][3] * Y[i][3]); }
            s1 += __shfl_xor(s1, 16); s1 += __shfl_xor(s1, 32); s2 += __shfl_xor(s2, 16); s2 += __shfl_xor(s2, 32);
            const float mean = s1 * (1.f / 64.f); const float rstd = 1.f / sqrtf(fmaxf(s2 * (1.f / 64.f) - mean * mean, 0.f) + GN_EPS);
            const int t = 16 * wb + r16; const float sbv = ((const LAS float*)(lds + RS_SB))[par * 64 + t];
            const LAS float* PAR = (const LAS float*)(lds + RS_PAR);
#pragma unroll
            for (int i = 0; i < 4; ++i) { const int v0 = 16 * i + 4 * q;
                const f32x4 gng = *(const LAS f32x4*)(PAR + v0), gnb = *(const LAS f32x4*)(PAR + 64 + v0), muv = *(const LAS f32x4*)(PAR + 128 + v0);
                const LAS unsigned char* vp = lds + RS_GV + (par * 65 + t) * RS_ROWB + v0 * 2;
                const u32x2_t pv = *(const LAS u32x2_t*)vp, cv = *(const LAS u32x2_t*)(vp + RS_ROWB);
                float o[4];
#pragma unroll
                for (int e = 0; e < 4; ++e) { const unsigned cvw = cv[e >> 1], pvw = pv[e >> 1];
                    const float cvf = (e & 1) ? bf_hi_(cvw) : bf_lo_(cvw), pvf = (e & 1) ? bf_hi_(pvw) : bf_lo_(pvw);
                    const float vs = cvf + muv[e] * (pvf - cvf);
                    o[e] = (Y[i][e] - mean) * rstd * gng[e] + gnb[e] + sbv * vs; }
                u32x2_t pk; pk.x = pk2(o[0], o[1]); pk.y = pk2(o[2], o[3]); *(LAS u32x2_t*)(lds + RS_YB + (par * 64 + t) * RS_ROWB + v0 * 2) = pk; }
            LDS_BARRIER();
        }
        LDS_BARRIER();
    }
#undef RS_LOAD
#undef RS_GVLOAD
#undef RS_GVSTORE
}

#define TS 65
#define TL(i) (Tb + (i) * (64 * TS))
constexpr int RL_KB = 16640, RL_QR = 33280, RL_KTT = 49920, RL_BTT = 58112, RL_VT = 133120;
constexpr int RL_NN = 99840, RL_AQK = 108032, RL_ARK = 116480, RL_ARB = 124672, RL_DD = 0;
#define C256(base, row, ch) ((base) + (row) * 256 + ((((ch) ^ ((row) & 15))) << 4))
#define C128(base, row, ch) ((base) + (row) * 128 + ((((ch) ^ ((row) & 7))) << 4))
__device__ __forceinline__ bf16x8 pack_tile_lo(const f32x4& a) { v4u w; w.x = pk2(a[0], a[1]); w.y = pk2(a[2], a[3]); w.z = 0u; w.w = 0u; return __builtin_bit_cast(bf16x8, w); }
__device__ __forceinline__ bf16x8 neg_bf16x8(const bf16x8& a) { v4u w = __builtin_bit_cast(v4u, a); w.x ^= 0x80008000u; w.y ^= 0x80008000u; w.z ^= 0x80008000u; w.w ^= 0x80008000u; return __builtin_bit_cast(bf16x8, w); }
__device__ __forceinline__ bf16x8 ld_frag2(LAS unsigned char* lds, int a0, int a1) {
    const u32x2_t lo = *(const LAS u32x2_t*)(lds + a0), hi = *(const LAS u32x2_t*)(lds + a1); v4u w; w.x = lo.x; w.y = lo.y; w.z = hi.x; w.w = hi.y; return __builtin_bit_cast(bf16x8, w); }
#define MFMA16(a, b, c) __builtin_amdgcn_mfma_f32_16x16x32_bf16((a), (b), (c), 0, 0, 0)

__device__ __forceinline__ void rwkv_local_mfma_part(const Args& args, Frame& F, int row0, int b, int h, int c, bool dry) {
    LAS unsigned char* lds = F.lds; LAS float* Tb = (LAS float*)F.lds; LAS float* PL = Tb + 9 * 64 * TS;
    const int tid = F.tid, lane = F.lane, w = F.wave, q = lane >> 4, r16 = lane & 15;
    { const int t = tid >> 3, c8 = (tid & 7) * 8, ch = tid & 7; float v[8]; v4u o;
#define CVT_ROW(TI, IMG, CH) do { _Pragma("unroll") for (int e = 0; e < 8; ++e) v[e] = TL(TI)[t * TS + c8 + e]; o.x = pk2(v[0], v[1]); o.y = pk2(v[2], v[3]); o.z = pk2(v[4], v[5]); o.w = pk2(v[6], v[7]); \
        *(LAS v4u*)(lds + C256(IMG, t, CH)) = o; } while (0)
      CVT_ROW(6, RL_KB, ch); CVT_ROW(0, RL_KB, 8 + ch); CVT_ROW(4, RL_QR, ch); CVT_ROW(5, RL_QR, 8 + ch);
#undef CVT_ROW
      const int cc = tid >> 3, t8 = (tid & 7) * 8;
#define CVT_COL(TI, IMG) do { _Pragma("unroll") for (int e = 0; e < 8; ++e) v[e] = TL(TI)[(t8 + e) * TS + cc]; o.x = pk2(v[0], v[1]); o.y = pk2(v[2], v[3]); o.z = pk2(v[4], v[5]); o.w = pk2(v[6], v[7]); \
        *(LAS v4u*)(lds + C128(IMG, cc, ch)) = o; } while (0)
      CVT_COL(6, RL_KTT); CVT_COL(0, RL_BTT); CVT_COL(7, RL_VT);
#undef CVT_COL
    }
    __syncthreads();
    { const int tb = w >> 1, side = w & 1, t = 16 * tb + r16;
      bf16x8 bq[2];
#pragma unroll
      for (int ks = 0; ks < 2; ++ks) bq[ks] = *(const LAS bf16x8*)(lds + C256(RL_QR, t, 8 * side + 4 * ks + q));
#pragma unroll 1
      for (int ib = 0; ib < 4; ++ib) { f32x4 a0 = (f32x4){0.f, 0.f, 0.f, 0.f}, a1 = (f32x4){0.f, 0.f, 0.f, 0.f};
        if (ib <= tb) {
#pragma unroll
            for (int ks = 0; ks < 2; ++ks) { const bf16x8 fb = *(const LAS bf16x8*)(lds + C256(RL_KB, 16 * ib + r16, 8 + 4 * ks + q)), fk = *(const LAS bf16x8*)(lds + C256(RL_KB, 16 * ib + r16, 4 * ks + q));
                a0 = MFMA16(fb, bq[ks], a0); a1 = MFMA16(fk, bq[ks], a1); } }
        float vb_[4], vk_[4];
#pragma unroll
        for (int e = 0; e < 4; ++e) { const int i = 16 * ib + 4 * q + e; const bool keep = side ? (i <= t) : (i < t); vb_[e] = keep ? (side ? a0[e] : -a0[e]) : 0.f; vk_[e] = keep ? a1[e] : 0.f; }
        u32x2_t pb, pk_; pb.x = pk2(vb_[0], vb_[1]); pb.y = pk2(vb_[2], vb_[3]); pk_.x = pk2(vk_[0], vk_[1]); pk_.y = pk2(vk_[2], vk_[3]);
        const int off = C128(0, t, 2 * ib + (q >> 1)) + (q & 1) * 8;
        *(LAS u32x2_t*)(lds + (side ? RL_ARB : RL_NN) + off) = pb; *(LAS u32x2_t*)(lds + (side ? RL_ARK : RL_AQK) + off) = pk_; } }
    __syncthreads();
    if (w < 4) { const int j = w; f32x4 Pa, Pt, Ta, Tt;
#pragma unroll
        for (int e = 0; e < 4; ++e) { const int rr = 16 * j + 4 * q + e, cc = 16 * j + r16; Pa[e] = bf2f(*(const LAS bf16*)(lds + C128(RL_NN, rr, cc >> 3) + (cc & 7) * 2)); }
        { const u32x2_t x = *(const LAS u32x2_t*)(lds + C128(RL_NN, 16 * j + r16, 2 * j + (q >> 1)) + (q & 1) * 8); Pt[0] = bf_lo_(x.x); Pt[1] = bf_hi_(x.x); Pt[2] = bf_lo_(x.y); Pt[3] = bf_hi_(x.y); }
#pragma unroll
        for (int e = 0; e < 4; ++e) { const float id = (4 * q + e == r16) ? 1.f : 0.f; Ta[e] = Pa[e] + id; Tt[e] = Pt[e] + id; }
#pragma unroll
        for (int rnd = 0; rnd < 3; ++rnd) { const bf16x8 pa = pack_tile_lo(Pa), pt = pack_tile_lo(Pt); const f32x4 z4 = (f32x4){0.f, 0.f, 0.f, 0.f};
            const f32x4 nPa = MFMA16(pt, pa, z4), nPt = MFMA16(pa, pt, z4);
            const bf16x8 npa = pack_tile_lo(nPa), tt = pack_tile_lo(Tt);
            Ta = MFMA16(tt, npa, Ta);
            Tt = MFMA16(npa, tt, Tt);
            Pa = nPa; Pt = nPt; }
        u32x2_t pk_; pk_.x = pk2(Tt[0], Tt[1]); pk_.y = pk2(Tt[2], Tt[3]);
        *(LAS u32x2_t*)(lds + RL_DD + j * 512 + r16 * 32 + q * 8) = pk_; }
    __syncthreads();
    { const int cb = w & 3, side = w >> 2, col = 16 * cb + r16; f32x4 S[4];
      if (side == 0) {
#pragma unroll
        for (int j = 0; j < 4; ++j)
#pragma unroll
            for (int e = 0; e < 4; ++e) S[j][e] = TL(4)[(16 * j + 4 * q + e) * TS + col];
      } else {
        bf16x8 bv[2];
#pragma unroll
        for (int ks = 0; ks < 2; ++ks) bv[ks] = *(const LAS bf16x8*)(lds + C128(RL_VT, col, 4 * ks + q));
#pragma unroll
        for (int j = 0; j < 4; ++j) { f32x4 a = (f32x4){0.f, 0.f, 0.f, 0.f};
#pragma unroll
            for (int ks = 0; ks < 2; ++ks) a = MFMA16(*(const LAS bf16x8*)(lds + C128(RL_AQK, 16 * j + r16, 4 * ks + q)), bv[ks], a);
            S[j] = a; } }
#pragma unroll
      for (int j = 0; j < 4; ++j) { const int t = 16 * j + r16; f32x4 a = S[j];
        if (j == 1) a = MFMA16(ld_frag2(lds, RL_NN + C128(0, t, 0 + (q >> 1)) + (q & 1) * 8, RL_NN + C128(0, t, 0 + (q >> 1)) + (q & 1) * 8), pack_tile_lo(S[0]), a);
        if (j >= 2) a = MFMA16(ld_frag2(lds, RL_NN + C128(0, t, 0 + (q >> 1)) + (q & 1) * 8, RL_NN + C128(0, t, 2 + (q >> 1)) + (q & 1) * 8), pack_tiles(S[0], S[1]), a);
        if (j == 3) a = MFMA16(ld_frag2(lds, RL_NN + C128(0, t, 4 + (q >> 1)) + (q & 1) * 8, RL_NN + C128(0, t, 4 + (q >> 1)) + (q & 1) * 8), pack_tile_lo(S[2]), a);
        const int dd = RL_DD + j * 512 + r16 * 32 + q * 8;
        const f32x4 z4 = (f32x4){0.f, 0.f, 0.f, 0.f}; S[j] = MFMA16(ld_frag2(lds, dd, dd), pack_tile_lo(a), z4); }
      const bf16x8 sp0 = pack_tiles(S[0], S[1]), sp1 = pack_tiles(S[2], S[3]);
      bf16* GH = (bf16*)(F.ws + WS_GH) + (size_t)((b * 16 + h) * 64 + c) * 8192;
      bf16* Rb = (bf16*)(F.ws + WS_RKVG); bf16* Kb = Rb + (size_t)M * 1024;
      if (side == 0) {
#pragma unroll 1
        for (int tb = 0; tb < 4; ++tb) { const int t = 16 * tb + r16; f32x4 a = (f32x4){0.f, 0.f, 0.f, 0.f};
            a = MFMA16(sp0, ld_frag2(lds, RL_ARB + C128(0, t, 0 + (q >> 1)) + (q & 1) * 8, RL_ARB + C128(0, t, 2 + (q >> 1)) + (q & 1) * 8), a);
            a = MFMA16(sp1, ld_frag2(lds, RL_ARB + C128(0, t, 4 + (q >> 1)) + (q & 1) * 8, RL_ARB + C128(0, t, 6 + (q >> 1)) + (q & 1) * 8), a);
            float o[4];
#pragma unroll
            for (int e = 0; e < 4; ++e) o[e] = TL(5)[t * TS + 16 * cb + 4 * q + e] - a[e];
            u32x2_t pk_; pk_.x = pk2(o[0], o[1]); pk_.y = pk2(o[2], o[3]);
            if (!dry) *(GAS u32x2_t*)(Rb + fp_off(row0, h, ((tb * 2 + (cb >> 1)) * 64 + lane) * 8 + 4 * (cb & 1))) = pk_; }
#pragma unroll 1
        for (int kb = 0; kb < 4; ++kb) { const int k = 16 * kb + r16; f32x4 a = (f32x4){0.f, 0.f, 0.f, 0.f};
            a = MFMA16(sp0, ld_frag2(lds, RL_BTT + C128(0, k, 0 + (q >> 1)) + (q & 1) * 8, RL_BTT + C128(0, k, 2 + (q >> 1)) + (q & 1) * 8), a);
            a = MFMA16(sp1, ld_frag2(lds, RL_BTT + C128(0, k, 4 + (q >> 1)) + (q & 1) * 8, RL_BTT + C128(0, k, 6 + (q >> 1)) + (q & 1) * 8), a);
            const float pl = PL[k]; float o[4];
#pragma unroll
            for (int e = 0; e < 4; ++e) o[e] = pl * (((16 * cb + 4 * q + e) == k ? 1.f : 0.f) - a[e]);
            u32x2_t pk_; pk_.x = pk2(o[0], o[1]); pk_.y = pk2(o[2], o[3]);
            if (!dry) *(GAS u32x2_t*)(GH + ((kb * 2 + (cb >> 1)) * 64 + lane) * 8 + 4 * (cb & 1)) = pk_; }
      } else {
        const bf16x8 nsp0 = neg_bf16x8(sp0), nsp1 = neg_bf16x8(sp1);
        bf16x8 av[2];
#pragma unroll
        for (int ks = 0; ks < 2; ++ks) av[ks] = *(const LAS bf16x8*)(lds + C128(RL_VT, col, 4 * ks + q));
#pragma unroll 1
        for (int tb = 0; tb < 4; ++tb) { const int t = 16 * tb + r16; f32x4 a = (f32x4){0.f, 0.f, 0.f, 0.f};
#pragma unroll
            for (int ks = 0; ks < 2; ++ks) a = MFMA16(av[ks], *(const LAS bf16x8*)(lds + C128(RL_ARK, t, 4 * ks + q)), a);
            a = MFMA16(nsp0, ld_frag2(lds, RL_ARB + C128(0, t, 0 + (q >> 1)) + (q & 1) * 8, RL_ARB + C128(0, t, 2 + (q >> 1)) + (q & 1) * 8), a);
            a = MFMA16(nsp1, ld_frag2(lds, RL_ARB + C128(0, t, 4 + (q >> 1)) + (q & 1) * 8, RL_ARB + C128(0, t, 6 + (q >> 1)) + (q & 1) * 8), a);
            u32x2_t pk_; pk_.x = pk2(a[0], a[1]); pk_.y = pk2(a[2], a[3]);
            if (!dry) *(GAS u32x2_t*)(Kb + fp_off(row0, h, ((tb * 4 + cb) * 64 + lane) * 4)) = pk_; }
#pragma unroll 1
        for (int kb = 0; kb < 4; ++kb) { const int k = 16 * kb + r16; f32x4 a = (f32x4){0.f, 0.f, 0.f, 0.f};
#pragma unroll
            for (int ks = 0; ks < 2; ++ks) a = MFMA16(*(const LAS bf16x8*)(lds + C128(RL_KTT, k, 4 * ks + q)), av[ks], a);
            a = MFMA16(ld_frag2(lds, RL_BTT + C128(0, k, 0 + (q >> 1)) + (q & 1) * 8, RL_BTT + C128(0, k, 2 + (q >> 1)) + (q & 1) * 8), nsp0, a);
            a = MFMA16(ld_frag2(lds, RL_BTT + C128(0, k, 4 + (q >> 1)) + (q & 1) * 8, RL_BTT + C128(0, k, 6 + (q >> 1)) + (q & 1) * 8), nsp1, a);
            float o[4];
#pragma unroll
            for (int e = 0; e < 4; ++e) o[e] = PL[16 * kb + 4 * q + e] * a[e];
            u32x2_t pk_; pk_.x = pk2(o[0], o[1]); pk_.y = pk2(o[2], o[3]);
            if (!dry) *(GAS u32x2_t*)(GH + 4096 + ((kb * 4 + cb) * 64 + lane) * 4) = pk_; }
      } }
    __syncthreads();
}

#ifndef RWKV_LOCAL_FAST
#define RWKV_LOCAL_FAST 1
#endif
__device__ __forceinline__ void rwkv_local_simple(const Args& args, Frame& F, int unit, bool dry = false) {
    LAS float* Tb = (LAS float*)F.lds; LAS float* PL = Tb + 9 * 64 * TS;
    const int tid = F.tid, ch = tid & 63, tq = tid >> 6;
    const int h = unit & 15, c = (unit >> 4) & 63, b = unit >> 10;
    const int row0 = b * SEQ + c * 64, hc = h * 64 + ch;
    bf16* Rb = (bf16*)(F.ws + WS_RKVG); bf16* Kb = Rb + (size_t)M * 1024; bf16* Vb = Kb + (size_t)M * 1024;
    const bf16* HALO = (const bf16*)(F.ws + WS_HALO); const float* SMALL = (const float*)(F.ws + WS_SMALL);
    const float* mu = args.in[10]; const float* w0 = args.in[11]; const float* w2 = args.in[12]; const float* a0 = args.in[13]; const float* a2 = args.in[14];
    const float* k_k = args.in[15]; const float* k_a = args.in[16]; const float* r_k = args.in[17];
    { const int t8 = tid >> 3, c8 = (tid & 7) * 8; const size_t rg = (size_t)(row0 + t8); const bool hasp = (c * 64 + t8) > 0;
      const f32x4 z4 = (f32x4){0.f, 0.f, 0.f, 0.f}; const v4u zu = (v4u){0u, 0u, 0u, 0u};
      { const GAS f32x4* sw = (const GAS f32x4*)(SMALL + rg * 256 + 32 + c8); const GAS f32x4* sa = (const GAS f32x4*)(SMALL + rg * 256 + 96 + c8);
        f32x4 cw0 = sw[0], cw1 = sw[1], ca0 = sa[0], ca1 = sa[1], pw0 = z4, pw1 = z4, pa0 = z4, pa1 = z4;
        if (hasp) { pw0 = sw[-64]; pw1 = sw[-63]; pa0 = sa[-64]; pa1 = sa[-63]; }
        const GAS f32x4* w2p = (const GAS f32x4*)(w2 + t8 * 1024 + h * 64 + c8); const GAS f32x4* a2p = (const GAS f32x4*)(a2 + t8 * 1024 + h * 64 + c8);
        const f32x4 w20 = w2p[0], w21 = w2p[1], a20 = a2p[0], a21 = a2p[1];
        const f32x4 mw0 = *(const GAS f32x4*)(mu + 4096 + c8), mw1 = *(const GAS f32x4*)(mu + 4100 + c8), ma0 = *(const GAS f32x4*)(mu + 4160 + c8), ma1 = *(const GAS f32x4*)(mu + 4164 + c8);
#pragma unroll
        for (int e = 0; e < 8; ++e) { const int o = t8 * TS + c8 + e;
          const float cwv = e < 4 ? cw0[e & 3] : cw1[e & 3], pwv = e < 4 ? pw0[e & 3] : pw1[e & 3], cav = e < 4 ? ca0[e & 3] : ca1[e & 3], pav = e < 4 ? pa0[e & 3] : pa1[e & 3];
          const float muw = e < 4 ? mw0[e & 3] : mw1[e & 3], mua = e < 4 ? ma0[e & 3] : ma1[e & 3];
          const float xw = cwv + muw * (pwv - cwv);
          TL(0)[o] = 1.f - 2.f / (1.f + __expf(2.f * xw)); TL(1)[o] = cav + mua * (pav - cav);
          TL(2)[o] = e < 4 ? w20[e & 3] : w21[e & 3]; TL(3)[o] = e < 4 ? a20[e & 3] : a21[e & 3]; } }
      asm volatile("" ::: "memory");
      { const v4u cr = *(const GAS v4u*)(Rb + rg * 1024 + h * 64 + c8), ck = *(const GAS v4u*)(Kb + rg * 1024 + h * 64 + c8), cv = *(const GAS v4u*)(Vb + rg * 1024 + h * 64 + c8);
        v4u pr = zu, pk = zu, pv = zu;
        if (t8 > 0) { pr = *(const GAS v4u*)(Rb + (rg - 1) * 1024 + h * 64 + c8); pk = *(const GAS v4u*)(Kb + (rg - 1) * 1024 + h * 64 + c8); pv = *(const GAS v4u*)(Vb + (rg - 1) * 1024 + h * 64 + c8); }
        else if (c > 0) { const bf16* hr = HALO + (size_t)((row0 >> 6) - 1) * 4096 + h * 64 + c8; pr = *(const GAS v4u*)(hr); pk = *(const GAS v4u*)(hr + 1024); pv = *(const GAS v4u*)(hr + 2048); }
        const GAS f32x4* mup = (const GAS f32x4*)(mu + h * 64 + c8);
        const f32x4 mr0 = mup[0], mr1 = mup[1], mk0 = mup[256], mk1 = mup[257], mv0 = mup[512], mv1 = mup[513];
#pragma unroll
        for (int e = 0; e < 8; ++e) { const int o = t8 * TS + c8 + e;
          const unsigned crw = cr[e >> 1], ckw = ck[e >> 1], cvw = cv[e >> 1], prw = pr[e >> 1], pkw = pk[e >> 1], pvw = pv[e >> 1];
          const float crf = (e & 1) ? bf_hi_(crw) : bf_lo_(crw), ckf = (e & 1) ? bf_hi_(ckw) : bf_lo_(ckw), cvf = (e & 1) ? bf_hi_(cvw) : bf_lo_(cvw);
          const float prf = (e & 1) ? bf_hi_(prw) : bf_lo_(prw), pkf = (e & 1) ? bf_hi_(pkw) : bf_lo_(pkw), pvf = (e & 1) ? bf_hi_(pvw) : bf_lo_(pvw);
          const float mur = e < 4 ? mr0[e & 3] : mr1[e & 3], muk = e < 4 ? mk0[e & 3] : mk1[e & 3], muv = e < 4 ? mv0[e & 3] : mv1[e & 3];
          TL(5)[o] = crf + mur * (prf - crf); TL(4)[o] = ckf + muk * (pkf - ckf); TL(7)[o] = cvf + muv * (pvf - cvf); } } }
    __syncthreads();
    { float wl[8], al[8]; const float w0c = w0[hc], a0c = a0[hc];
#pragma unroll
      for (int i = 0; i < 8; ++i) { wl[i] = w0c; al[i] = a0c; }
#pragma unroll 4
      for (int j = 0; j < 64; ++j) { const float wv = TL(2)[j * TS + ch], av = TL(3)[j * TS + ch];
#pragma unroll
        for (int i = 0; i < 8; ++i) { const int t = tq + 8 * i; wl[i] += TL(0)[t * TS + j] * wv; al[i] += TL(1)[t * TS + j] * av; } }
      __syncthreads();
#pragma unroll
      for (int i = 0; i < 8; ++i) { const int t = tq + 8 * i; const float wlog = -softplusf_(-wl[i]) - 0.5f; TL(2)[t * TS + ch] = -__expf(wlog); TL(3)[t * TS + ch] = sigm_(al[i]); } }
    __syncthreads();
    { const float kkc = k_k[hc], kac = k_a[hc], rkc = r_k[h * 64 + ch];
#pragma unroll
      for (int i = 0; i < 8; ++i) { const int t = tq + 8 * i; const size_t rg = (size_t)(row0 + t);
        const float rr = TL(5)[t * TS + ch], kx = TL(4)[t * TS + ch];
        const float a = TL(3)[t * TS + ch]; const float kkr = kx * kkc, k2 = kx * (1.f + (a - 1.f) * kac);
        const float nrm = wave_sum(kkr * kkr), sbs = wave_sum(rr * k2 * rkc);
        const float kk = kkr / fmaxf(sqrtf(nrm), 1e-12f);
        TL(4)[t * TS + ch] = kk; TL(6)[t * TS + ch] = k2; TL(0)[t * TS + ch] = kk * a;
        if (ch == 0 && !dry) ((float*)(F.ws + WS_SB))[rg * 16 + h] = sbs; } }
    __syncthreads();
    {
#pragma unroll
      for (int i = 0; i < 8; ++i) { const int cc = 8 * tq + i; float v = TL(2)[ch * TS + cc];
#pragma unroll
        for (int off = 1; off < 64; off <<= 1) { const float t_ = __shfl_up(v, off); if (ch >= off) v += t_; }
        TL(1)[ch * TS + cc] = v; } }
    __syncthreads();
#pragma unroll
    for (int i = 0; i < 8; ++i) { const int t = tq + 8 * i; const float cl = TL(1)[t * TS + ch], ld = TL(2)[t * TS + ch]; const float en = __expf(-cl);
        TL(6)[t * TS + ch] *= en; TL(0)[t * TS + ch] *= en; TL(4)[t * TS + ch] *= __expf(cl - ld); TL(5)[t * TS + ch] *= __expf(cl); if (t == 63) PL[ch] = __expf(cl); }
    __syncthreads();
#if RWKV_LOCAL_FAST
    rwkv_local_mfma_part(args, F, row0, b, h, c, dry); return;
#endif
    { float qb[8], qk[8], rk[8], rb[8];
#pragma unroll
      for (int i = 0; i < 8; ++i) { qb[i] = 0.f; qk[i] = 0.f; rk[i] = 0.f; rb[i] = 0.f; }
#pragma unroll 2
      for (int j = 0; j < 64; ++j) { const float bi = TL(0)[ch * TS + j], ki = TL(6)[ch * TS + j];
#pragma unroll
        for (int i = 0; i < 8; ++i) { const int t = tq + 8 * i; const float q = TL(4)[t * TS + j], r = TL(5)[t * TS + j]; qb[i] += q * bi; qk[i] += q * ki; rk[i] += r * ki; rb[i] += r * bi; } }
      __syncthreads();
#pragma unroll
      for (int i = 0; i < 8; ++i) { const int t = tq + 8 * i; const bool st = ch < t, in = ch <= t;
        TL(1)[t * TS + ch] = st ? qb[i] : 0.f; TL(2)[t * TS + ch] = st ? qk[i] : 0.f; TL(3)[t * TS + ch] = in ? rk[i] : 0.f; TL(8)[t * TS + ch] = in ? rb[i] : 0.f; } }
    __syncthreads();
    { float o[8];
#pragma unroll
      for (int i = 0; i < 8; ++i) o[i] = 0.f;
#pragma unroll 2
      for (int j = 0; j < 64; ++j) { const float vj = TL(7)[j * TS + ch];
#pragma unroll
        for (int i = 0; i < 8; ++i) o[i] += TL(2)[(tq + 8 * i) * TS + j] * vj; }
      __syncthreads();
#pragma unroll
      for (int i = 0; i < 8; ++i) TL(2)[(tq + 8 * i) * TS + ch] = o[i]; }
    __syncthreads();
    if (tid < 128) { LAS float* tile = (tid < 64) ? TL(4) : TL(2); const int col = tid & 63;
#pragma unroll 1
        for (int t = 1; t < 64; ++t) { float s = tile[t * TS + col];
#pragma unroll 4
            for (int i = 0; i < t; ++i) s -= TL(1)[t * TS + i] * tile[i * TS + col];
            tile[t * TS + col] = s; } }
    __syncthreads();
    { float o1[8], o2[8];
#pragma unroll
      for (int i = 0; i < 8; ++i) { o1[i] = TL(5)[(tq + 8 * i) * TS + ch]; o2[i] = 0.f; }
#pragma unroll 2
      for (int j = 0; j < 64; ++j) { const float qj = TL(4)[j * TS + ch], vj = TL(7)[j * TS + ch], xj = TL(2)[j * TS + ch];
#pragma unroll
        for (int i = 0; i < 8; ++i) { const int t = tq + 8 * i; const float arb = TL(8)[t * TS + j], ark = TL(3)[t * TS + j]; o1[i] -= arb * qj; o2[i] += ark * vj - arb * xj; } }
      __syncthreads();
#pragma unroll
      for (int i = 0; i < 8; ++i) { TL(5)[(tq + 8 * i) * TS + ch] = o1[i]; TL(3)[(tq + 8 * i) * TS + ch] = o2[i]; } }
    __syncthreads();
    { bf16* GH = (bf16*)(F.ws + WS_GH) + (size_t)((b * 16 + h) * 64 + c) * 8192;
      const int blk = ch >> 4, gg = (ch & 15) >> 2, jj = ch & 3;
      { float g[8];
#pragma unroll
        for (int i = 0; i < 8; ++i) g[i] = 0.f;
#pragma unroll 2
        for (int t = 0; t < 64; ++t) { const float qh = TL(4)[t * TS + ch];
#pragma unroll
          for (int i = 0; i < 8; ++i) g[i] += TL(0)[t * TS + tq + 8 * i] * qh; }
#pragma unroll
        for (int i = 0; i < 8; ++i) { const int k = tq + 8 * i; const float pl = PL[k];
          const int xfrag = (((k >> 4) * 2 + (blk >> 1)) * 64 + gg * 16 + (k & 15)) * 8 + (blk & 1) * 4 + jj;
          GH[xfrag] = (bf16)f2bf(pl * ((k == ch ? 1.f : 0.f) - g[i]));
          Rb[fp_off(row0, h, xfrag)] = (bf16)f2bf(TL(5)[k * TS + ch]); } }
      { float hh[8];
#pragma unroll
        for (int i = 0; i < 8; ++i) hh[i] = 0.f;
#pragma unroll 2
        for (int t = 0; t < 64; ++t) { const float vm = TL(7)[t * TS + ch], xx = TL(2)[t * TS + ch];
#pragma unroll
          for (int i = 0; i < 8; ++i) { const int k = tq + 8 * i; hh[i] += TL(6)[t * TS + k] * vm - TL(0)[t * TS + k] * xx; } }
#pragma unroll
        for (int i = 0; i < 8; ++i) { const int k = tq + 8 * i; const float pl = PL[k];
          GH[4096 + (((k >> 4) * 4 + (ch >> 4)) * 64 + ((k & 15) >> 2) * 16 + (ch & 15)) * 4 + (k & 3)] = (bf16)f2bf(pl * hh[i]);
          Kb[fp_off(row0, h, (((k >> 4) * 4 + (ch >> 4)) * 64 + ((ch & 15) >> 2) * 16 + (k & 15)) * 4 + (ch & 3))] = (bf16)f2bf(TL(3)[k * TS + ch]); } } }
    __syncthreads();
}

__device__ __forceinline__ void rwkv_scan_simple(const Args& args, Frame& F, int unit) {
    LAS float* Tb = (LAS float*)F.lds;
    const int tid = F.tid, ch = tid & 63, tq = tid >> 6;
    const int h = unit & 15, b = unit >> 4, hc = h * 64 + ch;
    const bf16* Rb = (const bf16*)(F.ws + WS_RKVG); const bf16* Kb = Rb + (size_t)M * 1024; const bf16* Vb = Kb + (size_t)M * 1024; bf16* Gb = (bf16*)(Vb + (size_t)M * 1024);
    const bf16* HALO = (const bf16*)(F.ws + WS_HALO); const float* SB = (const float*)(F.ws + WS_SB);
    const float* mu = args.in[10]; const float gng = args.in[18][hc], gnb = args.in[19][hc]; const float muv = mu[2048 + hc], mug = mu[3072 + hc];
#pragma unroll
    for (int i = 0; i < 8; ++i) TL(0)[(tq + 8 * i) * TS + ch] = 0.f;
    __syncthreads();
    for (int c = 0; c < NCHUNK; ++c) {
        const int row0 = b * SEQ + c * 64;
        const bf16* GH = (const bf16*)(F.ws + WS_GH) + (size_t)((b * 16 + h) * 64 + c) * 8192;
        float gsh[8], vsh[8];
#pragma unroll
        for (int i = 0; i < 8; ++i) { const int t = tq + 8 * i; const size_t rg = (size_t)(row0 + t);
            TL(1)[t * TS + ch] = bf2f(GH[t * 64 + ch]); TL(2)[t * TS + ch] = bf2f(GH[4096 + t * 64 + ch]);
            TL(3)[t * TS + ch] = bf2f(Rb[rg * 1024 + hc]); TL(4)[t * TS + ch] = bf2f(Kb[rg * 1024 + hc]);
            const float cg = bf2f(Gb[rg * 1024 + hc]), cv = bf2f(Vb[rg * 1024 + hc]); float pg = 0.f, pv = 0.f;
            if (t > 0) { pg = bf2f(Gb[(rg - 1) * 1024 + hc]); pv = bf2f(Vb[(rg - 1) * 1024 + hc]); }
            else if (c > 0) { const bf16* hr = HALO + (size_t)((row0 >> 6) - 1) * 4096; pg = bf2f(hr[3072 + hc]); pv = bf2f(hr[2048 + hc]); }
            gsh[i] = cg + mug * (pg - cg); vsh[i] = cv + muv * (pv - cv); }
        __syncthreads();
        float y[8], zn[8];
#pragma unroll
        for (int i = 0; i < 8; ++i) { y[i] = TL(4)[(tq + 8 * i) * TS + ch]; zn[i] = TL(2)[(tq + 8 * i) * TS + ch]; }
#pragma unroll 2
        for (int j = 0; j < 64; ++j) { const float zj = TL(0)[j * TS + ch];
#pragma unroll
            for (int i = 0; i < 8; ++i) { const int t = tq + 8 * i; y[i] += TL(3)[t * TS + j] * zj; zn[i] += TL(1)[t * TS + j] * zj; } }
#pragma unroll
        for (int i = 0; i < 8; ++i) { const int t = tq + 8 * i; const size_t rg = (size_t)(row0 + t);
            const float mean = wave_sum(y[i]) * (1.f / 64.f); const float d = y[i] - mean; const float var = wave_sum(d * d) * (1.f / 64.f);
            float o = d * (1.f / sqrtf(var + GN_EPS)) * gng + gnb + SB[rg * 16 + h] * vsh[i];
            o *= siluf_(gsh[i]);
            Gb[rg * 1024 + hc] = (bf16)f2bf(o); }
        __syncthreads();
#pragma unroll
        for (int i = 0; i < 8; ++i) TL(0)[(tq + 8 * i) * TS + ch] = zn[i];
        __syncthreads();
    }
}

#define TS2 129
__device__ __forceinline__ void ssd_scan_simple(const Args& args, Frame& F, int unit) {
    LAS float* X = (LAS float*)F.lds; LAS float* Bm = X + 64 * TS; LAS float* Cm = Bm + 64 * TS2; LAS float* Gs = Cm + 64 * TS2; LAS float* St = Gs + 64 * TS;
    LAS float* acum = St + 64 * TS2; LAS float* dtv = acum + 64;
    const int tid = F.tid, ch = tid & 63, tq = tid >> 6;
    const int hd = unit & 31, b = unit >> 5, g = hd >> 3;
    const bf16* XBC = (const bf16*)(F.ws + WS_XBC); bf16* Zb = (bf16*)(F.ws + WS_Z); const float* SMALL = (const float*)(F.ws + WS_SMALL); float* SSQ = (float*)(F.ws + WS_SSQ);
    const float* conv_w = args.in[4]; const float* conv_b = args.in[5];
    const float dtb = args.in[6][hd], Aneg = -__expf(args.in[7][hd]), Dsk = args.in[8][hd];
    for (int i = tid; i < 64 * TS2; i += 512) St[i] = 0.f;
    __syncthreads();
    for (int c = 0; c < NCHUNK; ++c) {
        const int row0 = b * SEQ + c * 64;
        { const int chan = hd * 64 + ch; const float w0_ = conv_w[chan], w1_ = conv_w[3072 + chan], w2_ = conv_w[2 * 3072 + chan], w3_ = conv_w[3 * 3072 + chan], cb = conv_b[chan];
#pragma unroll
          for (int i = 0; i < 8; ++i) { const int l = tq + 8 * i; const int tp = c * 64 + l; const size_t rg = (size_t)(row0 + l);
            float a = cb + w3_ * bf2f(XBC[rg * 3072 + chan]);
            if (tp >= 1) a += w2_ * bf2f(XBC[(rg - 1) * 3072 + chan]);
            if (tp >= 2) a += w1_ * bf2f(XBC[(rg - 2) * 3072 + chan]);
            if (tp >= 3) a += w0_ * bf2f(XBC[(rg - 3) * 3072 + chan]);
            X[l * TS + ch] = siluf_(a); } }
        { const int n = tid & 127, lq = tid >> 7;
#pragma unroll
          for (int which = 0; which < 2; ++which) { const int chan = 2048 + which * 512 + g * 128 + n; LAS float* dst = which ? Cm : Bm;
            const float w0_ = conv_w[chan], w1_ = conv_w[3072 + chan], w2_ = conv_w[2 * 3072 + chan], w3_ = conv_w[3 * 3072 + chan], cb = conv_b[chan];
            for (int i = 0; i < 16; ++i) { const int l = lq + 4 * i; const int tp = c * 64 + l; const size_t rg = (size_t)(row0 + l);
                float a = cb + w3_ * bf2f(XBC[rg * 3072 + chan]);
                if (tp >= 1) a += w2_ * bf2f(XBC[(rg - 1) * 3072 + chan]);
                if (tp >= 2) a += w1_ * bf2f(XBC[(rg - 2) * 3072 + chan]);
                if (tp >= 3) a += w0_ * bf2f(XBC[(rg - 3) * 3072 + chan]);
                dst[l * TS2 + n] = siluf_(a); } } }
        if (tid < 64) { const float dt = softplusf_(SMALL[(size_t)(row0 + tid) * 256 + hd] + dtb); dtv[tid] = dt; acum[tid] = dt * Aneg; }
        __syncthreads();
        if (tid == 0) { float s = 0.f; for (int l = 0; l < 64; ++l) { s += acum[l]; acum[l] = s; } }
        __syncthreads();
        { float o[8];
#pragma unroll
          for (int i = 0; i < 8; ++i) o[i] = 0.f;
#pragma unroll 2
          for (int n = 0; n < 128; ++n) { const float bs = Bm[ch * TS2 + n];
#pragma unroll
            for (int i = 0; i < 8; ++i) o[i] += Cm[(tq + 8 * i) * TS2 + n] * bs; }
#pragma unroll
          for (int i = 0; i < 8; ++i) { const int l = tq + 8 * i; Gs[l * TS + ch] = (ch <= l) ? o[i] * __expf(acum[l] - acum[ch]) * dtv[ch] : 0.f; } }
        __syncthreads();
        { float yd[8], yo[8];
#pragma unroll
          for (int i = 0; i < 8; ++i) { yd[i] = 0.f; yo[i] = 0.f; }
#pragma unroll 2
          for (int s = 0; s < 64; ++s) { const float xs = X[s * TS + ch];
#pragma unroll
            for (int i = 0; i < 8; ++i) yd[i] += Gs[(tq + 8 * i) * TS + s] * xs; }
#pragma unroll 2
          for (int n = 0; n < 128; ++n) { const float sp = St[ch * TS2 + n];
#pragma unroll
            for (int i = 0; i < 8; ++i) yo[i] += Cm[(tq + 8 * i) * TS2 + n] * sp; }
#pragma unroll
          for (int i = 0; i < 8; ++i) { const int l = tq + 8 * i; const size_t rg = (size_t)(row0 + l);
            const float yv = yd[i] + __expf(acum[l]) * yo[i] + Dsk * X[l * TS + ch];
            const float z = bf2f(Zb[rg * 2048 + hd * 64 + ch]); const float yz = yv * siluf_(z);
            Zb[rg * 2048 + hd * 64 + ch] = (bf16)f2bf(yz);
            const float ss = wave_sum(yz * yz); if (ch == 0) { SSQ[rg * 64 + hd * 2] = ss; SSQ[rg * 64 + hd * 2 + 1] = 0.f; } } }
        __syncthreads();
        { const int p = tid >> 3, n0 = tid & 7; float o[16]; const float a63 = acum[63]; const float dec = __expf(a63);
#pragma unroll
          for (int i = 0; i < 16; ++i) o[i] = dec * St[p * TS2 + n0 + 8 * i];
#pragma unroll 2
          for (int l = 0; l < 64; ++l) { const float xs = X[l * TS + p] * dtv[l] * __expf(a63 - acum[l]);
#pragma unroll
            for (int i = 0; i < 16; ++i) o[i] += xs * Bm[l * TS2 + n0 + 8 * i]; }
#pragma unroll
          for (int i = 0; i < 16; ++i) St[p * TS2 + n0 + 8 * i] = o[i]; }
        __syncthreads();
    }
}

__device__ __forceinline__ void rwkv_gate_rows(const Args& args, Frame& F) {
    const int gw = F.vcu * NWAVES + F.wave, NGW = F.G * NWAVES, lane = F.lane;
    bf16* Yo = (bf16*)((unsigned char*)F.out + WS_YRWKV_OUT); const bf16* Gb = (const bf16*)(F.ws + WS_RKVG) + (size_t)3 * M * 1024;
    f32x4 mg[4];
#pragma unroll
    for (int j = 0; j < 4; ++j) mg[j] = *(const GAS f32x4*)(args.in[10] + 3072 + lane * 16 + 4 * j);
    for (int m = gw; m < M; m += NGW) {
        GAS v4u* up = (GAS v4u*)(Yo + (size_t)m * 1024 + lane * 16); const GAS v4u* gp = (const GAS v4u*)(Gb + (size_t)m * 1024 + lane * 16);
#define LD16_SC1(p) ({ const unsigned long long a_ = __hip_atomic_load((const GAS unsigned long long*)(p), __ATOMIC_RELAXED, __HIP_MEMORY_SCOPE_AGENT), b_ = __hip_atomic_load((const GAS unsigned long long*)(p) + 1, __ATOMIC_RELAXED, __HIP_MEMORY_SCOPE_AGENT); \
        v4u r_; r_.x = (unsigned)a_; r_.y = (unsigned)(a_ >> 32); r_.z = (unsigned)b_; r_.w = (unsigned)(b_ >> 32); r_; })
        const v4u u0 = LD16_SC1(up), u1 = LD16_SC1(up + 1), g0 = LD16_SC1(gp), g1 = LD16_SC1(gp + 1); v4u p0 = (v4u){0u, 0u, 0u, 0u}, p1 = p0;
        if ((m & (SEQ - 1)) != 0) { p0 = LD16_SC1(gp - 128); p1 = LD16_SC1(gp - 127); }
        v4u o0, o1;
#pragma unroll
        for (int e = 0; e < 4; ++e) {
            { const float gl = bf_lo_(g0[e]), gh = bf_hi_(g0[e]), pl = bf_lo_(p0[e]), ph = bf_hi_(p0[e]); const float ml = mg[e >> 1][(2 * e) & 3], mh = mg[e >> 1][(2 * e + 1) & 3];
              o0[e] = pk2(bf_lo_(u0[e]) * siluf_(gl + ml * (pl - gl)), bf_hi_(u0[e]) * siluf_(gh + mh * (ph - gh))); }
            { const float gl = bf_lo_(g1[e]), gh = bf_hi_(g1[e]), pl = bf_lo_(p1[e]), ph = bf_hi_(p1[e]); const float ml = mg[2 + (e >> 1)][(2 * e) & 3], mh = mg[2 + (e >> 1)][(2 * e + 1) & 3];
              o1[e] = pk2(bf_lo_(u1[e]) * siluf_(gl + ml * (pl - gl)), bf_hi_(u1[e]) * siluf_(gh + mh * (ph - gh))); } }
        up[0] = o0; up[1] = o1;
    }
}
__device__ __forceinline__ void ssd_conv_unit(const Args& args, Frame& F, int wu, bool dry = false) {
    const int lane = F.lane, q = lane & 7, rgp = lane >> 3;
    const int bc = wu / 48, slab = wu - bc * 48, c = bc & 63;
    const int row0 = bc * 64, ch0 = slab * 64 + q * 8;
    bf16* XBC = (bf16*)(F.ws + WS_XBC); const bf16* HALOX = (const bf16*)(F.ws + WS_HALOX);
    const float* conv_w = args.in[4]; const float* conv_b = args.in[5];
    v4u raw[11];
#pragma unroll
    for (int i = 0; i < 11; ++i) { const int l = rgp * 8 - 3 + i;
        if (l >= 0) raw[i] = *(const GAS v4u*)(XBC + (size_t)(row0 + l) * 3072 + ch0);
        else if (c > 0) raw[i] = *(const GAS v4u*)(HALOX + ((size_t)(bc - 1) * 3 + (3 + l)) * 3072 + ch0);
        else raw[i] = (v4u){0u, 0u, 0u, 0u}; }
    float wt[4][8], bs[8];
#pragma unroll
    for (int j = 0; j < 4; ++j) { const f32x4 a = *(const GAS f32x4*)(conv_w + j * 3072 + ch0), b = *(const GAS f32x4*)(conv_w + j * 3072 + ch0 + 4);
        wt[j][0] = a.x; wt[j][1] = a.y; wt[j][2] = a.z; wt[j][3] = a.w; wt[j][4] = b.x; wt[j][5] = b.y; wt[j][6] = b.z; wt[j][7] = b.w; }
    { const f32x4 a = *(const GAS f32x4*)(conv_b + ch0), b = *(const GAS f32x4*)(conv_b + ch0 + 4); bs[0] = a.x; bs[1] = a.y; bs[2] = a.z; bs[3] = a.w; bs[4] = b.x; bs[5] = b.y; bs[6] = b.z; bs[7] = b.w; }
    asm volatile("s_waitcnt vmcnt(0)" ::: "memory");
    float o[8][8];
#pragma unroll
    for (int r = 0; r < 8; ++r)
#pragma unroll
        for (int e = 0; e < 8; ++e) { float a = bs[e];
#pragma unroll
            for (int j = 0; j < 4; ++j) { const unsigned w = raw[r + j][e >> 1]; const float v = (e & 1) ? __builtin_bit_cast(float, w & 0xffff0000u) : __builtin_bit_cast(float, w << 16); a += wt[j][e] * v; }
            o[r][e] = siluf_(a); }
    if (dry) { asm volatile("" :: "v"(o[0][0]), "v"(o[7][7]), "v"(o[3][4])); return; }
    if (slab < 32) {
#pragma unroll
        for (int e = 0; e < 8; ++e) { v4u w; w.x = pk2(o[0][e], o[1][e]); w.y = pk2(o[2][e], o[3][e]); w.z = pk2(o[4][e], o[5][e]); w.w = pk2(o[6][e], o[7][e]);
            *(GAS v4u*)(XBC + (size_t)(row0 + q * 8 + e) * 3072 + slab * 64 + rgp * 8) = w; }
    } else {
#pragma unroll
        for (int r = 0; r < 8; ++r) { v4u w; w.x = pk2(o[r][0], o[r][1]); w.y = pk2(o[r][2], o[r][3]); w.z = pk2(o[r][4], o[r][5]); w.w = pk2(o[r][6], o[r][7]);
            *(GAS v4u*)(XBC + (size_t)(row0 + rgp * 8 + r) * 3072 + ch0) = w; }
        if (slab < 40) { bf16* BT = (bf16*)(F.ws + WS_BT); const int g = (slab - 32) >> 1, n0 = ((slab - 32) & 1) * 64 + q * 8;
#pragma unroll
            for (int e = 0; e < 8; ++e) { v4u w; w.x = pk2(o[0][e], o[1][e]); w.y = pk2(o[2][e], o[3][e]); w.z = pk2(o[4][e], o[5][e]); w.w = pk2(o[6][e], o[7][e]);
                *(GAS v4u*)(BT + ((size_t)(bc * 4 + g) * 128 + n0 + e) * 64 + rgp * 8) = w; } }
    }
}

#define L256(base, row, ch) ((base) + (row) * 256 + ((((ch) ^ ((row) & 15))) << 4))
#define L128(base, row, ch) ((base) + (row) * 128 + ((((ch) ^ ((row) & 7))) << 4))
constexpr int SS_CM = 0, SS_BM = 16384, SS_BT = 32768, SS_XT = 49152, SS_XW = 57344, SS_MM = 65536, SS_STB = 73728, SS_SC = 90112;
struct SsdStage { v4u rC[2], rB[2], rT[2], rX; float rdt; };
struct SsdCtx { const bf16* XBC; const bf16* BT; bf16* Zb; const float* SMALL; float* SSQ; float dtb, Aneg, Dsk; int hd, b, g; int cmrow0, cmrow1, cmch, btrow0, btrow1, btch, xtrow, xtch; };
__device__ __forceinline__ void ssd_stage_load(const SsdCtx& X, SsdStage& S, int cc, int tid) {
    const int row0_ = X.b * SEQ + cc * 64;
    S.rC[0] = *(const GAS v4u*)(X.XBC + (size_t)(row0_ + X.cmrow0) * 3072 + 2560 + X.g * 128 + X.cmch * 8); S.rC[1] = *(const GAS v4u*)(X.XBC + (size_t)(row0_ + X.cmrow1) * 3072 + 2560 + X.g * 128 + X.cmch * 8);
    S.rB[0] = *(const GAS v4u*)(X.XBC + (size_t)(row0_ + X.cmrow0) * 3072 + 2048 + X.g * 128 + X.cmch * 8); S.rB[1] = *(const GAS v4u*)(X.XBC + (size_t)(row0_ + X.cmrow1) * 3072 + 2048 + X.g * 128 + X.cmch * 8);
    S.rT[0] = *(const GAS v4u*)(X.BT + ((size_t)((row0_ >> 6) * 4 + X.g) * 128 + X.btrow0) * 64 + X.btch * 8); S.rT[1] = *(const GAS v4u*)(X.BT + ((size_t)((row0_ >> 6) * 4 + X.g) * 128 + X.btrow1) * 64 + X.btch * 8);
    S.rX = *(const GAS v4u*)(X.XBC + (size_t)(row0_ + X.xtrow) * 3072 + X.hd * 64 + X.xtch * 8);
    if (tid < 64) S.rdt = X.SMALL[(size_t)(row0_ + tid) * 256 + X.hd];
}
__device__ __forceinline__ void ssd_chunk(const SsdCtx& X, SsdStage& S, int c, LAS unsigned char* lds, f32x4 (&accS)[4], int tid, int lane, int w, bool dry) {
    LAS float* dtv = (LAS float*)(lds + SS_SC); LAS float* acum = dtv + 64; LAS float* scl = acum + 64;
    const int q = lane >> 4, r16 = lane & 15; const int hd = X.hd; const int row0 = X.b * SEQ + c * 64;
    *(LAS v4u*)(lds + L256(SS_CM, X.cmrow0, X.cmch)) = S.rC[0]; *(LAS v4u*)(lds + L256(SS_CM, X.cmrow1, X.cmch)) = S.rC[1];
    *(LAS v4u*)(lds + L256(SS_BM, X.cmrow0, X.cmch)) = S.rB[0]; *(LAS v4u*)(lds + L256(SS_BM, X.cmrow1, X.cmch)) = S.rB[1];
    *(LAS v4u*)(lds + L128(SS_BT, X.btrow0, X.btch)) = S.rT[0]; *(LAS v4u*)(lds + L128(SS_BT, X.btrow1, X.btch)) = S.rT[1];
    *(LAS v4u*)(lds + L128(SS_XT, X.xtrow, X.xtch)) = S.rX;
    if (w == 0) { const float dt = softplusf_(S.rdt + X.dtb); float a = dt * X.Aneg;
#pragma unroll
        for (int off = 1; off < 64; off <<= 1) { const float t = __shfl_up(a, off); if (lane >= off) a += t; }
        const float a63 = __shfl(a, 63); dtv[lane] = dt; acum[lane] = a; scl[lane] = dt * __expf(a63 - a); }
    LDS_BARRIER();
    if (c + 2 < NCHUNK) ssd_stage_load(X, S, c + 2, tid);
    { const int sb = w >> 1, s0 = 16 * sb;
#pragma unroll
      for (int t = 0; t < 2; ++t) { const int lb = 2 * (w & 1) + t, l0 = 16 * lb; f32x4 acc = (f32x4){0.f, 0.f, 0.f, 0.f};
        if (sb <= lb) {
#pragma unroll
            for (int ks = 0; ks < 4; ++ks) { const bf16x8 a = *(const LAS bf16x8*)(lds + L256(SS_BM, s0 + r16, 4 * ks + q)); const bf16x8 bb = *(const LAS bf16x8*)(lds + L256(SS_CM, l0 + r16, 4 * ks + q));
                acc = __builtin_amdgcn_mfma_f32_16x16x32_bf16(a, bb, acc, 0, 0, 0); } }
        const int l = l0 + r16; const float al = acum[l]; float v[4];
#pragma unroll
        for (int e = 0; e < 4; ++e) { const int s = s0 + 4 * q + e; v[e] = (s <= l) ? acc[e] * __expf(fminf(al - acum[s], 0.f)) * dtv[s] : 0.f; }
        u32x2_t pk; pk.x = pk2(v[0], v[1]); pk.y = pk2(v[2], v[3]);
        *(LAS u32x2_t*)(lds + L128(SS_MM, l, 2 * sb + (q >> 1)) + (q & 1) * 8) = pk; } }
    { const v4u xv = *(const LAS v4u*)(lds + L128(SS_XT, X.xtrow, X.xtch)); v4u o;
#pragma unroll
      for (int e = 0; e < 4; ++e) { const unsigned ww = xv[e]; const float lo = __builtin_bit_cast(float, ww << 16) * scl[X.xtch * 8 + 2 * e], hi = __builtin_bit_cast(float, ww & 0xffff0000u) * scl[X.xtch * 8 + 2 * e + 1]; o[e] = pk2(lo, hi); }
      *(LAS v4u*)(lds + L128(SS_XW, X.xtrow, X.xtch)) = o; }
    LDS_BARRIER();
    { const int lb = w >> 1, l0 = 16 * lb, l = l0 + r16; const float el = __expf(acum[l]); float ss = 0.f;
#pragma unroll
      for (int t = 0; t < 2; ++t) { const int pb = 2 * (w & 1) + t, p0 = 16 * pb; f32x4 a1 = (f32x4){0.f, 0.f, 0.f, 0.f}, a2 = (f32x4){0.f, 0.f, 0.f, 0.f};
#pragma unroll
        for (int ks = 0; ks < 2; ++ks) { const bf16x8 a = *(const LAS bf16x8*)(lds + L128(SS_XT, p0 + r16, 4 * ks + q)); const bf16x8 bb = *(const LAS bf16x8*)(lds + L128(SS_MM, l0 + r16, 4 * ks + q));
            a1 = __builtin_amdgcn_mfma_f32_16x16x32_bf16(a, bb, a1, 0, 0, 0); }
#pragma unroll
        for (int ks = 0; ks < 4; ++ks) { const bf16x8 a = *(const LAS bf16x8*)(lds + L256(SS_STB, p0 + r16, 4 * ks + q)); const bf16x8 bb = *(const LAS bf16x8*)(lds + L256(SS_CM, l0 + r16, 4 * ks + q));
            a2 = __builtin_amdgcn_mfma_f32_16x16x32_bf16(a, bb, a2, 0, 0, 0); }
        bf16* zp = X.Zb + (size_t)(row0 + l) * 2048 + hd * 64 + p0 + 4 * q; const u32x2_t zz = *(const GAS u32x2_t*)zp; float yv[4];
#pragma unroll
        for (int e = 0; e < 4; ++e) { const int p = p0 + 4 * q + e; const float xlp = bf2f(*(const LAS bf16*)(lds + L128(SS_XT, p, l >> 3) + (l & 7) * 2));
            const unsigned zw = zz[e >> 1]; const float z = (e & 1) ? __builtin_bit_cast(float, zw & 0xffff0000u) : __builtin_bit_cast(float, zw << 16);
            const float y = (a1[e] + el * a2[e] + X.Dsk * xlp) * siluf_(z); yv[e] = y; ss += y * y; }
        u32x2_t pk; pk.x = pk2(yv[0], yv[1]); pk.y = pk2(yv[2], yv[3]); if (!dry) *(GAS u32x2_t*)zp = pk; }
      ss += __shfl_xor(ss, 16); ss += __shfl_xor(ss, 32);
      if (q == 0 && !dry) X.SSQ[(size_t)(row0 + l) * 64 + hd * 2 + (w & 1)] = ss; }
    { const float dec = __expf(acum[63]); const int n0 = 16 * w;
#pragma unroll
      for (int pb = 0; pb < 4; ++pb) { accS[pb] = accS[pb] * dec;
#pragma unroll
        for (int ks = 0; ks < 2; ++ks) { const bf16x8 a = *(const LAS bf16x8*)(lds + L128(SS_BT, n0 + r16, 4 * ks + q)); const bf16x8 bb = *(const LAS bf16x8*)(lds + L128(SS_XW, 16 * pb + r16, 4 * ks + q));
            accS[pb] = __builtin_amdgcn_mfma_f32_16x16x32_bf16(a, bb, accS[pb], 0, 0, 0); } } }
    LDS_BARRIER();
#pragma unroll
    for (int pb = 0; pb < 4; ++pb) { u32x2_t pk; pk.x = pk2(accS[pb][0], accS[pb][1]); pk.y = pk2(accS[pb][2], accS[pb][3]);
        *(LAS u32x2_t*)(lds + L256(SS_STB, 16 * pb + r16, 2 * w + (q >> 1)) + (q & 1) * 8) = pk; }
}
__device__ __forceinline__ void ssd_scan_mfma(const Args& args, Frame& F, int unit, bool dry = false) {
    LAS unsigned char* lds = F.lds;
    const int tid = F.tid, lane = F.lane, w = F.wave;
    SsdCtx X;
    X.hd = unit & 31; X.b = unit >> 5; X.g = X.hd >> 3;
    X.XBC = (const bf16*)(F.ws + WS_XBC); X.BT = (const bf16*)(F.ws + WS_BT); X.Zb = (bf16*)(F.ws + WS_Z); X.SMALL = (const float*)(F.ws + WS_SMALL); X.SSQ = (float*)(F.ws + WS_SSQ);
    X.dtb = args.in[6][X.hd]; X.Aneg = -__expf(args.in[7][X.hd]); X.Dsk = args.in[8][X.hd];
    X.cmrow0 = tid >> 4; X.cmrow1 = (tid + 512) >> 4; X.cmch = tid & 15; X.btrow0 = tid >> 3; X.btrow1 = (tid + 512) >> 3; X.btch = tid & 7; X.xtrow = tid >> 3; X.xtch = tid & 7;
    for (int i = tid; i < 16384 / 16; i += 512) *(LAS v4u*)(lds + SS_STB + i * 16) = (v4u){0u, 0u, 0u, 0u};
    f32x4 accS[4];
#pragma unroll
    for (int i = 0; i < 4; ++i) accS[i] = (f32x4){0.f, 0.f, 0.f, 0.f};
    SsdStage SA, SB_; SA.rdt = 0.f; SB_.rdt = 0.f;
    ssd_stage_load(X, SA, 0, tid); ssd_stage_load(X, SB_, 1, tid);
    for (int c = 0; c < NCHUNK; c += 2) { ssd_chunk(X, SA, c, lds, accS, tid, lane, w, dry); ssd_chunk(X, SB_, c + 1, lds, accS, tid, lane, w, dry); }
    LDS_BARRIER();
}

__device__ __forceinline__ void ssd_norm_rows(const Args& args, Frame& F) {
    const int gw = F.vcu * NWAVES + F.wave, NGW = F.G * NWAVES;
    bf16* Zb = (bf16*)(F.ws + WS_Z); const float* SSQ = (const float*)(F.ws + WS_SSQ); const float* gain = args.in[9];
    for (int m = gw; m < M; m += NGW) {
        const int grp = F.lane >> 4; float ss = 0.f;
#pragma unroll
        for (int j = 0; j < 16; ++j) ss += SSQ[(size_t)m * 64 + grp * 16 + j];
        const float rstd = 1.f / sqrtf(ss * (1.f / 512.f) + EPS);
        GAS v4u* p = (GAS v4u*)(Zb + (size_t)m * 2048 + F.lane * 32);
#pragma unroll
        for (int q = 0; q < 4; ++q) { v4u w = p[q]; const float* gp = gain + F.lane * 32 + q * 8; unsigned o[4];
#pragma unroll
            for (int e = 0; e < 4; ++e) { const unsigned ww = w[e]; const float lo = __builtin_bit_cast(float, ww << 16) * rstd * gp[2 * e], hi = __builtin_bit_cast(float, ww & 0xffff0000u) * rstd * gp[2 * e + 1]; o[e] = pk2(lo, hi); }
            v4u ov; ov.x = o[0]; ov.y = o[1]; ov.z = o[2]; ov.w = o[3]; p[q] = ov; }
    }
}
__device__ __forceinline__ void final_norm_rows(const Args& args, Frame& F) {
    const int gw = F.vcu * NWAVES + F.wave, NGW = F.G * NWAVES;
    const float* x = args.in[0]; const float* pg = args.in[23];
    f32x4 gv[4];
#pragma unroll
    for (int j = 0; j < 4; ++j) gv[j] = ((const GAS f32x4*)pg)[F.lane + 64 * j];
    for (int m = gw; m < M; m += NGW) {
        GAS f32x4* orow = (GAS f32x4*)(F.out + (size_t)m * D) + F.lane; const GAS f32x4* xr = (const GAS f32x4*)(x + (size_t)m * D) + F.lane;
        f32x4 v[4]; float s = 0.f;
#pragma unroll
        for (int j = 0; j < 4; ++j) { v[j] = orow[64 * j]; s += (v[j].x * v[j].x + v[j].y * v[j].y) + (v[j].z * v[j].z + v[j].w * v[j].w); }
        const float rstd = 1.f / sqrtf(wave_sum(s) * (1.f / D) + EPS);
#pragma unroll
        for (int j = 0; j < 4; ++j) orow[64 * j] = xr[64 * j] + v[j] * rstd * gv[j];
    }
}

#ifndef SSD_SIMPLE
#define SSD_SIMPLE 0
#endif
__global__ void __launch_bounds__(NWAVES * 64, 2) hybrid_fwd(Args args) {
    extern __shared__ __attribute__((aligned(16))) unsigned char lds[];
    Frame F;
    F.lds = (LAS unsigned char*)lds;
    F.MISC = (volatile LAS unsigned*)(F.lds + MISC_OFF);
    F.tid = threadIdx.x; F.lane = F.tid & 63; F.wave = __builtin_amdgcn_readfirstlane(F.tid >> 6);
    F.G = gridDim.x; { const int bx = blockIdx.x; F.vcu = (F.G % 8 == 0) ? (bx % 8) * (F.G / 8) + bx / 8 : bx; }
    F.out = args.out; F.ws = args.ws;
    F.ctl = (gu32*)(F.ws + WS_CTL);
    for (int u = F.tid; u < (LDS_BYTES - LDSCTL_OFF) / 4; u += NWAVES * 64) ((LAS unsigned*)(F.lds + LDSCTL_OFF))[u] = 0u;
    __syncthreads();
    XcdBarrier bar; bar.bar = (unsigned*)(F.ctl + CW_BAR); bar.x = 0; bar.st = nullptr;
    if (N_LAUNCHES == 1) bar = xcd_barrier_post((unsigned*)(F.ctl + CW_BAR), F.MISC + 8);
#define GRID_BAR() do { if (N_LAUNCHES == 1) xcd_barrier(bar); } while (0)
    const int lo = args.ph_lo, hi = args.ph_hi;
#ifndef PH_MASK
#define PH_MASK 0x1FFF
#endif
#define IN(k) ((((PH_MASK) >> (k)) & 1) && lo <= (k) && (k) < hi)
#define BOTH(k) (IN(k) && IN((k) + 1))
#ifndef REP_MASK
#define REP_MASK 0
#endif
#define REP(k) (((REP_MASK) >> (k)) & 1)
    bf16* Win_t = (bf16*)(F.ws + WS_WIN);
    bf16* Hb = (bf16*)F.out;

    if (IN(0)) { p0_prologue(args, F); if (REP(0)) { GRID_BAR(); p0_prologue(args, F); } if (BOTH(0)) GRID_BAR(); }
    if (IN(1)) {
      for (int rep = 0; rep < (REP(1) ? 2 : 1); ++rep) {
        pg8::Gemm g{Hb, Win_t, M, NT_RW * 256, D}; pg8::StaticOrder S; S.init(M, NT_RW * 256, F.G, (int)blockIdx.x);
        pg8::EpiRW E{(bf16*)(F.ws + WS_RKVG), (bf16*)(F.ws + WS_HALO), (float*)(F.ws + WS_SMALL), M};
        pg8::gemm_phase<pg8::EpiRW, pg8::StaticOrder, PG8_ALIGN, PG8_SP2>(F.lds + RING_OFF, g, S, E);
        if (rep == 0 && REP(1)) GRID_BAR(); }
        if (BOTH(1)) GRID_BAR();
    }
    if (IN(2)) { if (REP(2)) { for (int u = F.vcu; u < NB * NCHUNK * 16; u += F.G) rwkv_local_simple(args, F, u, true); GRID_BAR(); }
                 for (int u = F.vcu; u < NB * NCHUNK * 16; u += F.G) rwkv_local_simple(args, F, u, false); if (BOTH(2)) GRID_BAR(); }
    if (IN(3)) { for (int rep = 0; rep < (REP(3) ? 2 : 1); ++rep) { for (int u = (int)blockIdx.x; u < NB * 16; u += F.G) rwkv_scan_mfma(args, F, u); if (rep == 0 && REP(3)) GRID_BAR(); } if (BOTH(3)) GRID_BAR(); }
    if (IN(4)) {
      for (int rep = 0; rep < (REP(4) ? 2 : 1); ++rep) {
        pg8::Gemm g{Hb, Win_t + (size_t)NT_RW * 256 * D, M, NT_SSD * 256, D}; pg8::StaticOrder S; S.init(M, NT_SSD * 256, F.G, (int)blockIdx.x);
        pg8::EpiSSD E{(bf16*)(F.ws + WS_Z), (bf16*)(F.ws + WS_XBC), (bf16*)(F.ws + WS_HALOX)};
        pg8::gemm_phase<pg8::EpiSSD, pg8::StaticOrder, PG8_ALIGN, PG8_SP2>(F.lds + RING_OFF, g, S, E);
        if (rep == 0 && REP(4)) GRID_BAR(); }
        if (BOTH(4)) GRID_BAR();
    }
#if SSD_SIMPLE
    if (IN(5)) { if (BOTH(5)) GRID_BAR(); }
    if (IN(6)) { for (int u = F.vcu; u < NB * 32; u += F.G) ssd_scan_simple(args, F, u); if (BOTH(6)) GRID_BAR(); }
#else
    if (IN(5)) { if (REP(5)) { for (int wu = F.vcu * NWAVES + F.wave; wu < NB * NCHUNK * 48; wu += F.G * NWAVES) ssd_conv_unit(args, F, wu, true); GRID_BAR(); }
                 for (int wu = F.vcu * NWAVES + F.wave; wu < NB * NCHUNK * 48; wu += F.G * NWAVES) ssd_conv_unit(args, F, wu, false);
                 rwkv_gate_rows(args, F); if (BOTH(5)) GRID_BAR(); }
    if (IN(6)) { if (REP(6)) { for (int u = (int)blockIdx.x; u < NB * 32; u += F.G) ssd_scan_mfma(args, F, u, true); GRID_BAR(); }
                 for (int u = (int)blockIdx.x; u < NB * 32; u += F.G) ssd_scan_mfma(args, F, u, false); if (BOTH(6)) GRID_BAR(); }
#endif
    if (IN(7)) { ssd_norm_rows(args, F); if (BOTH(7)) GRID_BAR(); }
    if (IN(8)) {
      for (int rep = 0; rep < (REP(8) ? 2 : 1); ++rep) {
        pg8::Gemm g{Hb, Win_t + (size_t)(NT_RW + NT_SSD) * 256 * D, M, NT_GATE * 256, D}; pg8::StaticOrder S; S.init(M, NT_GATE * 256, F.G, (int)blockIdx.x);
        pg8::EpiGate E{(bf16*)(F.ws + WS_GATES), args.in[3]};
        pg8::gemm_phase<pg8::EpiGate, pg8::StaticOrder, PG8_ALIGN, PG8_SP2>(F.lds + RING_OFF, g, S, E);
        if (rep == 0 && REP(8)) GRID_BAR(); }
        if (BOTH(8)) GRID_BAR();
    }
    if (IN(9)) {
      for (int rep = 0; rep < (REP(9) ? 2 : 1); ++rep) {
        pg8::Gemm g{(const bf16*)(F.ws + WS_Z), (const bf16*)(F.ws + WS_WSSM), M, D, 2048}; pg8::StaticOrder S; S.init(M, D, F.G, (int)blockIdx.x);
        pg8::EpiT1 E{(float*)(F.ws + WS_T1), (const bf16*)(F.ws + WS_GATES)};
        pg8::gemm_phase<pg8::EpiT1, pg8::StaticOrder, PG8_ALIGN, PG8_SP2>(F.lds + RING_OFF, g, S, E);
        if (rep == 0 && REP(9)) GRID_BAR(); }
        if (BOTH(9)) GRID_BAR();
    }
    if (IN(10)) {
      for (int rep = 0; rep < (REP(10) ? 2 : 1); ++rep) {
        pg8::Gemm g{(const bf16*)((const unsigned char*)F.out + WS_YRWKV_OUT), (const bf16*)(F.ws + WS_WRWKV), M, D, D}; pg8::StaticOrder S; S.init(M, D, F.G, (int)blockIdx.x);
        pg8::EpiMerge E{(bf16*)(F.ws + WS_MERGED), (const float*)(F.ws + WS_T1), (const bf16*)(F.ws + WS_GATES)};
        pg8::gemm_phase<pg8::EpiMerge, pg8::StaticOrder, PG8_ALIGN, PG8_SP2>(F.lds + RING_OFF, g, S, E);
        if (rep == 0 && REP(10)) GRID_BAR(); }
        if (BOTH(10)) GRID_BAR();
    }
    if (IN(11)) {
      for (int rep = 0; rep < (REP(11) ? 2 : 1); ++rep) {
        pg8::Gemm g{(const bf16*)(F.ws + WS_MERGED), (const bf16*)(F.ws + WS_WOUT), M, D, D}; pg8::StaticOrder S; S.init(M, D, F.G, (int)blockIdx.x);
        pg8::EpiF32 E{F.out, D};
        pg8::gemm_phase<pg8::EpiF32, pg8::StaticOrder, PG8_ALIGN, PG8_SP2>(F.lds + RING_OFF, g, S, E);
        if (rep == 0 && REP(11)) GRID_BAR(); }
        if (BOTH(11)) GRID_BAR();
    }
    if (IN(12)) { final_norm_rows(args, F); }
#undef IN
#undef BOTH
}

extern "C" void kernel_launch(void* const* d_in, const int* in_sizes, int n_in, void* d_out, int out_size, void* d_ws, size_t ws_size, hipStream_t stream) {
    static int grid = 0;
    if (grid == 0) {
        if (n_in != 24 || in_sizes[0] != M * D || out_size != M * D || ws_size < WS_END) { fprintf(stderr, "kernel_launch: unexpected shapes (n_in %d, in0 %d, out %d, ws %zu)\n", n_in, n_in > 0 ? in_sizes[0] : -1, out_size, ws_size); grid = -1; return; }
        int dev = 0, cus = 0;
        if (hipGetDevice(&dev) != hipSuccess || hipDeviceGetAttribute(&cus, hipDeviceAttributeMultiprocessorCount, dev) != hipSuccess) { grid = -1; return; }
        if (hipFuncSetAttribute((const void*)hybrid_fwd, hipFuncAttributeMaxDynamicSharedMemorySize, LDS_BYTES) != hipSuccess) { fprintf(stderr, "kernel_launch: hipFuncSetAttribute failed\n"); grid = -1; return; }
        (void)hipGetLastError();
        grid = cus;
    }
    if (grid < 0) return;
    if (hipMemsetAsync((char*)d_ws + WS_CTL, 0, CTL_ZERO_BYTES, stream) != hipSuccess) return;
    Args a{};
    for (int i = 0; i < 24; ++i) a.in[i] = (const float*)d_in[i];
    a.out = (float*)d_out; a.ws = (unsigned char*)d_ws;
    for (int li = 0; li < N_LAUNCHES; ++li) {
        if (N_LAUNCHES == 1) { a.ph_lo = 0; a.ph_hi = N_PHASES; } else { a.ph_lo = li; a.ph_hi = li + 1; }
        a.li = li;
        hipLaunchKernelGGL(hybrid_fwd, dim3(grid), dim3(NWAVES * 64), LDS_BYTES, stream, a);
    }
}
```

```cpp
#include <hip/hip_runtime.h>
#include <cstdio>
#include <cstdint>
#define MK_N_LAUNCHES 1
#define REP_MASK 0
#define SCAN_VAR 1
namespace pg8 {
#define PG8_LAS __attribute__((address_space(3)))
typedef unsigned short bf16_t;
typedef short bf16x8 __attribute__((ext_vector_type(8)));
typedef float f32x4 __attribute__((ext_vector_type(4)));
typedef unsigned u32x4 __attribute__((ext_vector_type(4)));
constexpr int BM = 256, BK = 64, HALF = 128, HTB = HALF * BK * 2  , STAGE_BYTES = 8 * HTB, NXCD = 8, WGM = 8;

__host__ __device__ __forceinline__ int lds_byte(int r, int c) { const int st = (r >> 4) * 2 + (c >> 5), rr = r & 15, cc = c & 31, ob = rr * 64 + cc * 2; return st * 1024 + (ob ^ (((ob >> 9) & 1) << 5)); }
__host__ __device__ __forceinline__ void stage_rc(int b, int& R, int& C) { const int st = b / 1024, sb = b % 1024, swz = sb ^ (((sb >> 9) & 1) << 5); R = (st >> 1) * 16 + swz / 64; C = (st & 1) * 32 + (swz % 64) / 2; }
__host__ __device__ __forceinline__ int perm32(int rho) { const int n = rho >> 4, i = rho & 15; return 8 * (i >> 2) + 4 * n + (i & 3); }

struct Unit { int pm, pn; };
struct Gemm { const bf16_t* A; const bf16_t* Bt; int M, N, K; };

struct StaticOrder {
    int nM, nN, nwg, G, c;
    __host__ __device__ void init(int M, int N, int G_, int c_) { nM = M / BM; nN = N / BM; nwg = nM * nN; G = G_; c = c_; }
    __host__ __device__ bool next(int i, Unit& u) const {
        const long L = (long)i * G + c; if (L >= nwg) return false;
        int wgid = (int)L; { const int q = nwg / NXCD, r = nwg % NXCD, xcd = wgid % NXCD, off = wgid / NXCD; wgid = (xcd < r ? xcd * (q + 1) : r * (q + 1) + (xcd - r) * q) + off; }
        const int nig = WGM * nN, gid = wgid / nig, fm = gid * WGM, gsz = (nM - fm) < WGM ? (nM - fm) : WGM;
        u.pm = fm + ((wgid % nig) % gsz); u.pn = (wgid % nig) / gsz; return true;
    }
    __device__ __forceinline__ void a_ready(const Unit&) const {}
    __device__ __forceinline__ void done(const Unit&) const {}
};

__device__ __forceinline__ unsigned cvt_pk_bf16(float lo, float hi) { unsigned r; asm volatile("v_cvt_pk_bf16_f32 %0, %1, %2" : "=v"(r) : "v"(lo), "v"(hi)); return r; }
__device__ __forceinline__ float bf_lo(unsigned w) { return __builtin_bit_cast(float, w << 16); }
__device__ __forceinline__ float bf_hi(unsigned w) { return __builtin_bit_cast(float, w & 0xffff0000u); }
__device__ __forceinline__ float sigmoidf_(float x) { return 1.0f / (1.0f + __expf(-x)); }
typedef unsigned u32x2 __attribute__((ext_vector_type(2)));

struct EpiRW {
    static constexpr bool PERM = true, AFTER_DRAIN = false;
    bf16_t* RKVG; bf16_t* HALO; float* SMALL; int Mrows;
    __device__ __forceinline__ void operator()(const f32x4 (&acc)[2][2][4][2], const Unit& u, int wr, int wc, int fr, int fq) const {
        const int row0 = u.pm * BM + wr * 64 + fr;
        if (u.pn < 16) {
            bf16_t* base = RKVG + (size_t)(u.pn >> 2) * ((size_t)Mrows * 1024);
            const int col0 = (u.pn & 3) * 256 + wc * 32 + 8 * fq;
#pragma unroll
            for (int ai = 0; ai < 2; ++ai)
#pragma unroll
                for (int m = 0; m < 4; ++m) { const int row = row0 + ai * HALF + m * 16; bf16_t* rowp = base + (size_t)row * 1024 + col0;
#pragma unroll
                    for (int bj = 0; bj < 2; ++bj) { const f32x4 v0 = acc[ai][bj][m][0], v1 = acc[ai][bj][m][1];
                        u32x4 w; w.x = cvt_pk_bf16(v0[0], v0[1]); w.y = cvt_pk_bf16(v0[2], v0[3]); w.z = cvt_pk_bf16(v1[0], v1[1]); w.w = cvt_pk_bf16(v1[2], v1[3]);
                        *(u32x4*)(rowp + bj * HALF) = w;
                        if (m == 3 && fr == 15) *(u32x4*)(HALO + (size_t)(row >> 6) * 4096 + u.pn * 256 + wc * 32 + 8 * fq + bj * HALF) = w; } }
        } else {
            const int col0 = wc * 32 + 8 * fq;
#pragma unroll
            for (int ai = 0; ai < 2; ++ai)
#pragma unroll
                for (int m = 0; m < 4; ++m) { float* rowp = SMALL + (size_t)(row0 + ai * HALF + m * 16) * 256 + col0;
#pragma unroll
                    for (int bj = 0; bj < 2; ++bj) { *(f32x4*)(rowp + bj * HALF) = acc[ai][bj][m][0]; *(f32x4*)(rowp + bj * HALF + 4) = acc[ai][bj][m][1]; } }
        }
    }
};
struct EpiSSD {
    static constexpr bool PERM = true, AFTER_DRAIN = false;
    bf16_t* Z; bf16_t* XBC; bf16_t* HALOX;
    __device__ __forceinline__ void operator()(const f32x4 (&acc)[2][2][4][2], const Unit& u, int wr, int wc, int fr, int fq) const {
        const int row0 = u.pm * BM + wr * 64 + fr;
        bf16_t* base; int ldc, colt;
        if (u.pn < 8) { base = Z; ldc = 2048; colt = u.pn * 256; } else { base = XBC; ldc = 3072; colt = (u.pn - 8) * 256; }
        const int col0 = colt + wc * 32 + 8 * fq;
#pragma unroll
        for (int ai = 0; ai < 2; ++ai)
#pragma unroll
            for (int m = 0; m < 4; ++m) { bf16_t* rowp = base + (size_t)(row0 + ai * HALF + m * 16) * ldc + col0;
#pragma unroll
                for (int bj = 0; bj < 2; ++bj) { const f32x4 v0 = acc[ai][bj][m][0], v1 = acc[ai][bj][m][1];
                    u32x4 w; w.x = cvt_pk_bf16(v0[0], v0[1]); w.y = cvt_pk_bf16(v0[2], v0[3]); w.z = cvt_pk_bf16(v1[0], v1[1]); w.w = cvt_pk_bf16(v1[2], v1[3]);
                    *(u32x4*)(rowp + bj * HALF) = w;
                    if (m == 3 && fr >= 13 && u.pn >= 8) { const int row = row0 + ai * HALF + m * 16; *(u32x4*)(HALOX + ((size_t)(row >> 6) * 3 + (fr - 13)) * 3072 + col0 + bj * HALF) = w; } } }
    }
};
struct EpiGate {
    static constexpr bool PERM = true, AFTER_DRAIN = false;
    bf16_t* O; const float* bias;
    __device__ __forceinline__ void operator()(const f32x4 (&acc)[2][2][4][2], const Unit& u, int wr, int wc, int fr, int fq) const {
        const int row0 = u.pm * BM + wr * 64 + fr; const int col0 = u.pn * BM + wc * 32 + 8 * fq;
        f32x4 bv[2][2];
#pragma unroll
        for (int bj = 0; bj < 2; ++bj)
#pragma unroll
            for (int n = 0; n < 2; ++n) bv[bj][n] = *(const f32x4*)(bias + col0 + bj * HALF + 4 * n);
#pragma unroll
        for (int ai = 0; ai < 2; ++ai)
#pragma unroll
            for (int m = 0; m < 4; ++m) { bf16_t* rowp = O + (size_t)(row0 + ai * HALF + m * 16) * 2048 + col0;
#pragma unroll
                for (int bj = 0; bj < 2; ++bj) { f32x4 v0 = acc[ai][bj][m][0] + bv[bj][0], v1 = acc[ai][bj][m][1] + bv[bj][1];
#pragma unroll
                    for (int j = 0; j < 4; ++j) { v0[j] = sigmoidf_(v0[j]); v1[j] = sigmoidf_(v1[j]); }
                    u32x4 w; w.x = cvt_pk_bf16(v0[0], v0[1]); w.y = cvt_pk_bf16(v0[2], v0[3]); w.z = cvt_pk_bf16(v1[0], v1[1]); w.w = cvt_pk_bf16(v1[2], v1[3]);
                    *(u32x4*)(rowp + bj * HALF) = w; } }
    }
};
struct EpiT1 {
    static constexpr bool PERM = false, AFTER_DRAIN = false;
    float* T1; const bf16_t* GATES;
    __device__ __forceinline__ void operator()(const f32x4 (&acc)[2][2][4][2], const Unit& u, int wr, int wc, int fr, int fq) const {
        const int row0 = u.pm * BM + wr * 64 + fr, col0 = u.pn * BM + wc * 32 + 4 * fq;
#pragma unroll
        for (int ai = 0; ai < 2; ++ai)
#pragma unroll
            for (int m = 0; m < 4; ++m) { const size_t row = (size_t)(row0 + ai * HALF + m * 16);
#pragma unroll
                for (int bj = 0; bj < 2; ++bj)
#pragma unroll
                    for (int n = 0; n < 2; ++n) { const int c = col0 + bj * HALF + n * 16; const u32x2 g = *(const u32x2*)(GATES + row * 2048 + c);
                        f32x4 v = acc[ai][bj][m][n]; v[0] *= bf_lo(g.x); v[1] *= bf_hi(g.x); v[2] *= bf_lo(g.y); v[3] *= bf_hi(g.y);
                        *(f32x4*)(T1 + row * 1024 + c) = v; } }
    }
};
struct EpiMerge {
    static constexpr bool PERM = true, AFTER_DRAIN = false;
    bf16_t* O; const float* T1; const bf16_t* GATES;
    __device__ __forceinline__ void operator()(const f32x4 (&acc)[2][2][4][2], const Unit& u, int wr, int wc, int fr, int fq) const {
        const int row0 = u.pm * BM + wr * 64 + fr; const int col0 = u.pn * BM + wc * 32 + 8 * fq;
#pragma unroll
        for (int ai = 0; ai < 2; ++ai)
#pragma unroll
            for (int m = 0; m < 4; ++m) { const size_t row = (size_t)(row0 + ai * HALF + m * 16);
#pragma unroll
                for (int bj = 0; bj < 2; ++bj) { const int c = col0 + bj * HALF;
                    const u32x4 g = *(const u32x4*)(GATES + row * 2048 + 1024 + c);
                    const f32x4 t0 = *(const f32x4*)(T1 + row * 1024 + c), t1 = *(const f32x4*)(T1 + row * 1024 + c + 4);
                    f32x4 v0 = acc[ai][bj][m][0], v1 = acc[ai][bj][m][1];
                    v0[0] = t0[0] + bf_lo(g.x) * v0[0]; v0[1] = t0[1] + bf_hi(g.x) * v0[1]; v0[2] = t0[2] + bf_lo(g.y) * v0[2]; v0[3] = t0[3] + bf_hi(g.y) * v0[3];
                    v1[0] = t1[0] + bf_lo(g.z) * v1[0]; v1[1] = t1[1] + bf_hi(g.z) * v1[1]; v1[2] = t1[2] + bf_lo(g.w) * v1[2]; v1[3] = t1[3] + bf_hi(g.w) * v1[3];
                    u32x4 w; w.x = cvt_pk_bf16(v0[0], v0[1]); w.y = cvt_pk_bf16(v0[2], v0[3]); w.z = cvt_pk_bf16(v1[0], v1[1]); w.w = cvt_pk_bf16(v1[2], v1[3]);
                    *(u32x4*)(O + row * 1024 + c) = w; } }
    }
};
struct EpiF32 {
    static constexpr bool PERM = false, AFTER_DRAIN = false;
    float* C; int ldc;
    __device__ __forceinline__ void operator()(const f32x4 (&acc)[2][2][4][2], const Unit& u, int wr, int wc, int fr, int fq) const {
        const int row0 = u.pm * BM + wr * 64 + fr, col0 = u.pn * BM + wc * 32 + 4 * fq;
#pragma unroll
        for (int ai = 0; ai < 2; ++ai)
#pragma unroll
            for (int m = 0; m < 4; ++m) { float* rowp = C + (size_t)(row0 + ai * HALF + m * 16) * ldc + col0;
#pragma unroll
                for (int bj = 0; bj < 2; ++bj)
#pragma unroll
                    for (int n = 0; n < 2; ++n) *(f32x4*)(rowp + bj * HALF + n * 16) = acc[ai][bj][m][n]; }
    }
};

template <class Epi, class Sched, bool ALIGN_EPI = false, bool SP2 = false>
__device__ __forceinline__ void gemm_phase(PG8_LAS unsigned char* lds, const Gemm g, const Sched& S, const Epi& E) {
    const int tid = threadIdx.x, wid = __builtin_amdgcn_readfirstlane(tid >> 6), lane = tid & 63, wr = wid >> 2, wc = wid & 3, fr = lane & 15, fq = lane >> 4;
    const int K = g.K, nt = K / BK;
    unsigned voffA[2], voffB[2];
#pragma unroll
    for (int i = 0; i < 2; ++i) { int R, C; stage_rc(tid * 16 + i * 8192, R, C); const int Rb = Epi::PERM ? ((R & ~31) + perm32(R & 31)) : R;
        voffA[i] = (unsigned)(R * K + C) * 2u; voffB[i] = (unsigned)(Rb * K + C) * 2u; }
    const size_t kstep = (size_t)(BK * 2);
    const size_t hstep = (size_t)HALF * K * 2;
    const size_t tstep = 2 * hstep;
    const unsigned ldsw = (unsigned)wid * 1024u;
    const int aoff = lds_byte(wr * 64 + fr, fq * 8), boff = lds_byte(wc * 32 + fr, fq * 8);
#define PG8_SA(b, h) (((b) * 2 + (h)) * HTB)
#define PG8_SB(b, h) ((4 + (b) * 2 + (h)) * HTB)
#define PG8_STAGE(bufoff, gbase, voff) do { _Pragma("unroll") for (int _i = 0; _i < 2; ++_i) \
        __builtin_amdgcn_global_load_lds((const unsigned*)((const char*)(gbase) + (voff)[_i]), (PG8_LAS unsigned*)(lds + (bufoff) + ldsw + _i * 8192), 16, 0, 0); } while (0)
#define PG8_LDA(dst, b, h) do { _Pragma("unroll") for (int m = 0; m < 4; ++m) _Pragma("unroll") for (int k = 0; k < 2; ++k) dst[m][k] = *(const PG8_LAS bf16x8*)(lds + PG8_SA(b, h) + aoff + m * 2048 + k * 1024); } while (0)
#define PG8_LDB(dst, b, h) do { _Pragma("unroll") for (int n = 0; n < 2; ++n) _Pragma("unroll") for (int k = 0; k < 2; ++k) dst[n][k] = *(const PG8_LAS bf16x8*)(lds + PG8_SB(b, h) + boff + n * 2048 + k * 1024); } while (0)
#define PG8_MMA(ai, bj, At, Bt) do { __builtin_amdgcn_s_setprio(1); _Pragma("unroll") for (int m = 0; m < 4; ++m) _Pragma("unroll") for (int n = 0; n < 2; ++n) _Pragma("unroll") for (int k = 0; k < 2; ++k) \
        acc[ai][bj][m][n] = __builtin_amdgcn_mfma_f32_16x16x32_bf16(Bt[n][k], At[m][k], acc[ai][bj][m][n], 0, 0, 0); __builtin_amdgcn_s_setprio(0); } while (0)
#define PG8_WAIT_V(n) asm volatile("s_waitcnt vmcnt(" #n ")" ::: "memory")
#define PG8_WAIT_L(n) asm volatile("s_waitcnt lgkmcnt(" #n ")" ::: "memory")
#define PG8_BAR __builtin_amdgcn_s_barrier()
#define PG8_SCHED __builtin_amdgcn_sched_barrier(0)
    Unit cur, nxt; int ui = 0;
    if (!S.next(0, cur)) return;
    f32x4 acc[2][2][4][2];
#pragma unroll
    for (int a = 0; a < 2; ++a)
#pragma unroll
        for (int b = 0; b < 2; ++b)
#pragma unroll
            for (int m = 0; m < 4; ++m)
#pragma unroll
                for (int n = 0; n < 2; ++n) acc[a][b][m][n] = (f32x4){0.f, 0.f, 0.f, 0.f};
    bf16x8 At[4][2], B0[2][2], B1[2][2];
    const char* cA = (const char*)g.A + (size_t)cur.pm * tstep; const char* cB = (const char*)g.Bt + (size_t)cur.pn * tstep;
    S.a_ready(cur);
    if constexpr (SP2) {
        PG8_STAGE(PG8_SB(0, 0), cB, voffB); PG8_STAGE(PG8_SB(0, 1), cB + hstep, voffB); PG8_STAGE(PG8_SA(0, 0), cA, voffA); PG8_STAGE(PG8_SA(0, 1), cA + hstep, voffA);
        if (wr == 1) PG8_BAR;
        PG8_WAIT_V(2); PG8_BAR;
        PG8_STAGE(PG8_SB(1, 0), cB + kstep, voffB); PG8_STAGE(PG8_SA(1, 0), cA + kstep, voffA); PG8_STAGE(PG8_SB(1, 1), cB + hstep + kstep, voffB);
        PG8_WAIT_V(6); PG8_BAR;
    } else {
        PG8_STAGE(PG8_SB(0, 0), cB, voffB); PG8_STAGE(PG8_SA(0, 0), cA, voffA); PG8_STAGE(PG8_SB(0, 1), cB + hstep, voffB); PG8_STAGE(PG8_SA(0, 1), cA + hstep, voffA);
        if (wr == 1) PG8_BAR;
        PG8_WAIT_V(4); PG8_BAR;
        PG8_STAGE(PG8_SB(1, 0), cB + kstep, voffB); PG8_STAGE(PG8_SA(1, 0), cA + kstep, voffA); PG8_STAGE(PG8_SB(1, 1), cB + hstep + kstep, voffB);
        PG8_WAIT_V(6); PG8_BAR;
    }
    for (;;) {
        const bool has_next = S.next(ui + 1, nxt);
        const char* nA = has_next ? (const char*)g.A + (size_t)nxt.pm * tstep : cA; const char* nB = has_next ? (const char*)g.Bt + (size_t)nxt.pn * tstep : cB;
        for (int t = 0; t < nt; t += 2) {
            const bool last = (t == nt - 2);
            const char* a1 = cA + (size_t)(t + 1) * kstep;
            const char* a2 = last ? nA : cA + (size_t)(t + 2) * kstep; const char* b2 = last ? nB : cB + (size_t)(t + 2) * kstep;
            const char* a3 = a2 + kstep; const char* b3 = b2 + kstep;
            if (last && has_next) S.a_ready(nxt);
            if constexpr (SP2) {
            PG8_LDB(B0, 0, 0); PG8_LDB(B1, 0, 1); PG8_SCHED; PG8_LDA(At, 0, 0); PG8_STAGE(PG8_SA(1, 1), a1 + hstep, voffA);
            PG8_WAIT_V(8); PG8_WAIT_L(0); PG8_BAR; PG8_MMA(0, 0, At, B0); PG8_MMA(0, 1, At, B1); PG8_BAR; PG8_SCHED;
            PG8_LDA(At, 0, 1); PG8_STAGE(PG8_SB(0, 0), b2, voffB); PG8_STAGE(PG8_SB(0, 1), b2 + hstep, voffB); PG8_STAGE(PG8_SA(0, 0), a2, voffA);
            PG8_WAIT_V(8); PG8_WAIT_L(0); PG8_BAR; PG8_MMA(1, 0, At, B0); PG8_MMA(1, 1, At, B1); PG8_BAR; PG8_SCHED;
            PG8_LDB(B0, 1, 0); PG8_LDB(B1, 1, 1); PG8_SCHED; PG8_LDA(At, 1, 0); PG8_STAGE(PG8_SA(0, 1), a2 + hstep, voffA);
            PG8_WAIT_V(8); PG8_WAIT_L(0); PG8_BAR; PG8_MMA(0, 0, At, B0); PG8_MMA(0, 1, At, B1); PG8_BAR; PG8_SCHED;
            PG8_LDA(At, 1, 1); PG8_STAGE(PG8_SB(1, 0), b3, voffB); PG8_STAGE(PG8_SB(1, 1), b3 + hstep, voffB); PG8_STAGE(PG8_SA(1, 0), a3, voffA);
            PG8_WAIT_V(8); PG8_WAIT_L(0); PG8_BAR; PG8_MMA(1, 0, At, B0); PG8_MMA(1, 1, At, B1); PG8_BAR; PG8_SCHED;
            } else {
            PG8_LDB(B0, 0, 0); PG8_SCHED; PG8_LDA(At, 0, 0); PG8_STAGE(PG8_SA(1, 1), a1 + hstep, voffA);
            PG8_WAIT_L(8); PG8_BAR; PG8_WAIT_L(0); PG8_MMA(0, 0, At, B0); PG8_BAR; PG8_SCHED;
            PG8_LDB(B1, 0, 1); PG8_STAGE(PG8_SB(0, 0), b2, voffB);
            PG8_BAR; PG8_WAIT_L(0); PG8_MMA(0, 1, At, B1); PG8_BAR;
            PG8_LDA(At, 0, 1); PG8_STAGE(PG8_SA(0, 0), a2, voffA);
            PG8_BAR; PG8_WAIT_L(0); PG8_MMA(1, 0, At, B0); PG8_BAR; PG8_SCHED;
            PG8_STAGE(PG8_SB(0, 1), b2 + hstep, voffB);
            PG8_WAIT_V(6); PG8_BAR; PG8_MMA(1, 1, At, B1); PG8_BAR;
            PG8_LDB(B0, 1, 0); PG8_SCHED; PG8_LDA(At, 1, 0); PG8_STAGE(PG8_SA(0, 1), a2 + hstep, voffA);
            PG8_WAIT_L(8); PG8_BAR; PG8_WAIT_L(0); PG8_MMA(0, 0, At, B0); PG8_BAR; PG8_SCHED;
            PG8_LDB(B1, 1, 1); PG8_STAGE(PG8_SB(1, 0), b3, voffB);
            PG8_BAR; PG8_WAIT_L(0); PG8_MMA(0, 1, At, B1); PG8_BAR;
            PG8_LDA(At, 1, 1); PG8_STAGE(PG8_SA(1, 0), a3, voffA);
            PG8_BAR; PG8_WAIT_L(0); PG8_MMA(1, 0, At, B0); PG8_BAR; PG8_SCHED;
            PG8_STAGE(PG8_SB(1, 1), b3 + hstep, voffB);
            PG8_WAIT_V(6); PG8_BAR; PG8_MMA(1, 1, At, B1); PG8_BAR;
            }
        }
        if constexpr (ALIGN_EPI) { if (wr == 0) PG8_BAR; }
        if constexpr (!Epi::AFTER_DRAIN) { E(acc, cur, wr, wc, fr, fq); S.done(cur); }
        if (!has_next) break;
#pragma unroll
        for (int a = 0; a < 2; ++a)
#pragma unroll
            for (int b = 0; b < 2; ++b)
#pragma unroll
                for (int m = 0; m < 4; ++m)
#pragma unroll
                    for (int n = 0; n < 2; ++n) acc[a][b][m][n] = (f32x4){0.f, 0.f, 0.f, 0.f};
        cur = nxt; cA = nA; cB = nB; ++ui;
        if constexpr (ALIGN_EPI) { if (wr == 1) PG8_BAR; }
    }
    PG8_WAIT_V(0);
    if constexpr (!ALIGN_EPI) { if (wr == 0) PG8_BAR; }
    PG8_BAR;
    if constexpr (Epi::AFTER_DRAIN) { E.fused(acc, cur, wr, wc, fr, fq, lds, wid, lane); S.done(cur); }
#undef PG8_SA
#undef PG8_SB
#undef PG8_STAGE
#undef PG8_LDA
#undef PG8_LDB
#undef PG8_MMA
#undef PG8_WAIT_V
#undef PG8_WAIT_L
#undef PG8_BAR
#undef PG8_SCHED
}
}

#ifndef PG8_SP2
#define PG8_SP2 true
#endif
#ifndef PG8_ALIGN
#define PG8_ALIGN true
#endif
constexpr int NWAVES = 8;
#ifndef MK_N_LAUNCHES
#define MK_N_LAUNCHES 1
#endif
constexpr int N_PHASES = 13;
constexpr int N_LAUNCHES = MK_N_LAUNCHES;

constexpr int NB = 4, SEQ = 4096, D = 1024, M = NB * SEQ;
constexpr int IN_COLS = 11424;
constexpr int C_Z = 0, C_XBC = 2048, C_DT = 5120, C_RW = 5152, C_WD = 9248, C_AD = 9312, C_GATE = 9376;
constexpr int NT_RW = 17, NT_SSD = 20, NT_GATE = 8, NT_IN = NT_RW + NT_SSD + NT_GATE;
constexpr int NCHUNK = SEQ / 64;
constexpr float EPS = 1e-6f, GN_EPS = 64.0f * 1e-5f;

constexpr size_t MiB = 1u << 20;
constexpr size_t WS_CTL = 0, CTL_ZERO_BYTES = 64 * 1024;
constexpr size_t WS_WIN = 1 * MiB;
constexpr size_t WS_WSSM = 24 * MiB, WS_WRWKV = 28 * MiB, WS_WOUT = 30 * MiB;
constexpr size_t WS_RKVG = 32 * MiB;
constexpr size_t WS_GH = 160 * MiB;
constexpr size_t WS_SMALL = 224 * MiB;
constexpr size_t WS_HALO = 240 * MiB;
constexpr size_t WS_SB = 242 * MiB;
constexpr size_t WS_SSQ = 243 * MiB;
constexpr size_t WS_HALOX = 247 * MiB;
constexpr size_t WS_BT = 1 * MiB;
constexpr size_t WS_END = 256 * MiB;
constexpr size_t WS_XBC = 32 * MiB;
constexpr size_t WS_Z = 160 * MiB;
constexpr size_t WS_GATES = 32 * MiB;
constexpr size_t WS_MERGED = 224 * MiB;
constexpr size_t WS_T1 = 96 * MiB;
constexpr size_t WS_YRWKV_OUT = 32 * MiB;
constexpr size_t WS_YRWKV = WS_RKVG + 3 * 32 * MiB;
constexpr int CW_TMO = 0, CW_CODE = 1, CW_BAR = 4096;

constexpr int RING_OFF = 0, RING_BYTES = 131072;
constexpr int LDS_BYTES = 163840;
constexpr int MISC_OFF = LDS_BYTES - 256;
constexpr int LDSCTL_OFF = MISC_OFF;

#define GAS __attribute__((address_space(1)))
#define LAS __attribute__((address_space(3)))
typedef unsigned short bf16;
typedef unsigned v4u __attribute__((ext_vector_type(4)));
typedef float f32x4 __attribute__((ext_vector_type(4)));
typedef short bf16x8 __attribute__((ext_vector_type(8)));
typedef GAS unsigned gu32;
typedef GAS unsigned long long gu64;
#define RLX_AGENT __ATOMIC_RELAXED, __HIP_MEMORY_SCOPE_AGENT
#define LDS_WAIT() asm volatile("s_waitcnt lgkmcnt(0)" ::: "memory")
#define VM_WAIT() asm volatile("s_waitcnt vmcnt(0)" ::: "memory")
__device__ __forceinline__ unsigned long long rt() { return __builtin_amdgcn_s_memrealtime(); }
__device__ __forceinline__ unsigned f2bf(float f) { unsigned u = __builtin_bit_cast(unsigned, f); return (u + 0x7fffu + ((u >> 16) & 1u)) >> 16; }
__device__ __forceinline__ unsigned pk2(float lo, float hi) { typedef float f32x2_t_ __attribute__((ext_vector_type(2))); typedef __bf16 bf16x2_t_ __attribute__((ext_vector_type(2))); f32x2_t_ v = {lo, hi}; bf16x2_t_ b = __builtin_convertvector(v, bf16x2_t_); return __builtin_bit_cast(unsigned, b); }

#define XB_TMO      128
#define XB_XCNT(j)  (256  + 64 * (j))
#define XB_XSUB(j)  (1280 + 64 * (j))
#define XB_XGEN(j)  (2304 + 64 * (j))
#define XB_TOP      3328
#define XB_TOPGEN   3392
#define XCD_BAR_WORDS 3456
#define XB_SPIN_CAP (1u << 18)

__device__ __forceinline__ unsigned xb_ld(unsigned* p)              { return __hip_atomic_load(p, __ATOMIC_RELAXED, __HIP_MEMORY_SCOPE_AGENT); }
__device__ __forceinline__ unsigned xb_add(unsigned* p, unsigned v) { return __hip_atomic_fetch_add(p, v, __ATOMIC_RELAXED, __HIP_MEMORY_SCOPE_AGENT); }
__device__ __forceinline__ unsigned xb_xcc_id() { return (unsigned)__builtin_amdgcn_s_getreg((3 << 11) | 20) & 0xFu; }
#define XB_SPIN(cond, bar) do { unsigned _sp = 0; while (cond) { __builtin_amdgcn_s_sleep(1); \
    if ((++_sp & 255u) == 0u) { if (xb_ld(&(bar)[XB_TMO])) break; if (_sp > XB_SPIN_CAP) { atomicAdd(&(bar)[XB_TMO], 1u); break; } } } } while (0)

struct XcdBarrier {
    unsigned* bar; unsigned x;
    volatile LAS unsigned* st;
};

__device__ __forceinline__ XcdBarrier xcd_barrier_post(unsigned* bar, volatile LAS unsigned* st) {
    XcdBarrier b; b.bar = bar; b.x = xb_xcc_id(); b.st = st;
    if (threadIdx.x == 0) (void)xb_add(&bar[XB_XCNT(b.x)], 1u);
    return b;
}
__device__ __forceinline__ void xcd_barrier_complete(unsigned* bar, unsigned x, unsigned& nloc, unsigned& nx) {
    const unsigned G = gridDim.x * gridDim.y * gridDim.z;
    unsigned sum, cnt, mine, sp = 0u;
    for (;;) {
        sum = 0u; cnt = 0u; mine = 0u;
#pragma unroll
        for (unsigned j = 0; j < 16; ++j) { const unsigned c = xb_ld(&bar[XB_XCNT(j)]); sum += c; cnt += (c > 0u) ? 1u : 0u; mine = (j == x) ? c : mine; }
        if (sum == G) break;
        __builtin_amdgcn_s_sleep(1);
        if ((++sp & 255u) == 0u) { if (xb_ld(&bar[XB_TMO])) break; if (sp > XB_SPIN_CAP) { atomicAdd(&bar[XB_TMO], 1u); break; } }
    }
    nloc = mine > 0u ? mine : 1u; nx = cnt > 0u ? cnt : 1u;
}

__device__ __forceinline__ void xcd_barrier(const XcdBarrier& b) {
    asm volatile("s_waitcnt vmcnt(0)" ::: "memory");
    __syncthreads();
    if (threadIdx.x == 0) {
        unsigned* bar = b.bar;
        __builtin_amdgcn_s_waitcnt(0);
        unsigned nloc = b.st[0], nx = b.st[1];
        if (nloc == 0u) { xcd_barrier_complete(bar, b.x, nloc, nx); b.st[0] = nloc; b.st[1] = nx; }
        const unsigned old = xb_add(&bar[XB_XSUB(b.x)], 1u);
        const unsigned gen = old / nloc;
        if (old + 1u == (gen + 1u) * nloc) {
            __builtin_amdgcn_fence(__ATOMIC_RELEASE, "agent");
            asm volatile("s_waitcnt vmcnt(0)" ::: "memory");
            const unsigned og = xb_add(&bar[XB_TOP], 1u);
            const unsigned tg = og / nx;
            if (og + 1u == (tg + 1u) * nx) xb_add(&bar[XB_TOPGEN], 1u);
            else XB_SPIN(xb_ld(&bar[XB_TOPGEN]) == tg, bar);
            __builtin_amdgcn_fence(__ATOMIC_ACQUIRE, "agent");
            xb_add(&bar[XB_XGEN(b.x)], 1u);
            asm volatile("s_waitcnt vmcnt(0)" ::: "memory");
        } else {
            XB_SPIN(xb_ld(&bar[XB_XGEN(b.x)]) == gen, bar);
            __builtin_amdgcn_fence(__ATOMIC_ACQUIRE, "agent");
            asm volatile("s_waitcnt vmcnt(0)" ::: "memory");
        }
    }
    __syncthreads();
}
struct Args { const float* in[24]; float* out; unsigned char* ws; int ph_lo, ph_hi, li, pad; };
struct Frame {
    LAS unsigned char* lds;
    volatile LAS unsigned* MISC;
    gu32* ctl;
    int tid, lane, wave;
    int vcu, G;
    float* out; unsigned char* ws;
};
__device__ __forceinline__ float wave_sum(float v) {
#pragma unroll
    for (int o = 1; o < 64; o <<= 1) v += __shfl_xor(v, o);
    return v;
}
__device__ __forceinline__ float bf2f(bf16 v) { return __builtin_bit_cast(float, (unsigned)v << 16); }
#define LDS_BARRIER() do { asm volatile("s_waitcnt lgkmcnt(0)" ::: "memory"); __builtin_amdgcn_s_barrier(); asm volatile("" ::: "memory"); } while (0)
__device__ __forceinline__ float bf_lo_(unsigned w) { return __builtin_bit_cast(float, w << 16); }
__device__ __forceinline__ float bf_hi_(unsigned w) { return __builtin_bit_cast(float, w & 0xffff0000u); }
typedef unsigned u32x2_t __attribute__((ext_vector_type(2)));
__device__ __forceinline__ float softplusf_(float x) { return x > 20.f ? x : __logf(1.0f + __expf(x)); }
__device__ __forceinline__ float siluf_(float x) { return x / (1.0f + __expf(-x)); }
__device__ __forceinline__ float sigm_(float x) { return 1.0f / (1.0f + __expf(-x)); }

__device__ __forceinline__ void p0_transpose_item(const float* W, int ldw, int sc0, bf16* WT, int Kd, int dr0, int k0, LAS float* scr, int lane) {
    if (sc0 >= 0) {
#pragma unroll 8
        for (int i = 0; i < 32; ++i) { const int kk = 2 * i + (lane >> 5); scr[kk * 33 + (lane & 31)] = W[(size_t)(k0 + kk) * ldw + sc0 + (lane & 31)]; }
    } else {
#pragma unroll 8
        for (int i = 0; i < 32; ++i) { const int kk = 2 * i + (lane >> 5); scr[kk * 33 + (lane & 31)] = 0.f; }
    }
    LDS_WAIT(); asm volatile("" ::: "memory");
    const int c = lane & 7;
#pragma unroll
    for (int j = 0; j < 4; ++j) { const int n = (lane >> 3) + 8 * j; const LAS float* s = scr + (8 * c) * 33 + n;
        v4u o; o.x = pk2(s[0 * 33], s[1 * 33]); o.y = pk2(s[2 * 33], s[3 * 33]); o.z = pk2(s[4 * 33], s[5 * 33]); o.w = pk2(s[6 * 33], s[7 * 33]);
        *(GAS v4u*)(WT + (size_t)(dr0 + n) * Kd + k0 + 8 * c) = o; }
    LDS_WAIT(); asm volatile("" ::: "memory");
}
__device__ __forceinline__ int win_src_col(int db) {
    if (db < 128) return C_RW + 32 * db;
    if (db < 136) { const int b = db - 128; if (b == 0) return C_DT; if (b <= 2) return C_WD + 32 * (b - 1); if (b <= 4) return C_AD + 32 * (b - 3); return -1; }
    if (db < 200) return C_Z + 32 * (db - 136);
    if (db < 296) return C_XBC + 32 * (db - 200);
    return C_GATE + 32 * (db - 296);
}
__device__ __forceinline__ void p0_prologue(const Args& args, Frame& F) {
    LAS float* scr = (LAS float*)(F.lds + RING_OFF + F.wave * 16384);
    const int gw = F.vcu * NWAVES + F.wave, NGW = F.G * NWAVES;
    bf16* Win_t = (bf16*)(F.ws + WS_WIN); bf16* Wssm_t = (bf16*)(F.ws + WS_WSSM); bf16* Wrwkv_t = (bf16*)(F.ws + WS_WRWKV); bf16* Wout_t = (bf16*)(F.ws + WS_WOUT);
    constexpr int I_IN = 16 * (NT_IN * 8), I_SSM = 32 * 32, I_RW = 16 * 32, I_OUT = 16 * 32;
    constexpr int NITEMS = I_IN + I_SSM + I_RW + I_OUT;
    for (int it = gw; it < NITEMS; it += NGW) {
        int r = it;
        if (r < I_IN) { const int kb = r / (NT_IN * 8), db = r % (NT_IN * 8); p0_transpose_item(args.in[2], IN_COLS, win_src_col(db), Win_t, D, 32 * db, 64 * kb, scr, F.lane); continue; } r -= I_IN;
        if (r < I_SSM) { const int kb = r / 32, nb = r % 32; p0_transpose_item(args.in[20], D, 32 * nb, Wssm_t, 2048, 32 * nb, 64 * kb, scr, F.lane); continue; } r -= I_SSM;
        if (r < I_RW) { const int kb = r / 32, nb = r % 32; p0_transpose_item(args.in[21], D, 32 * nb, Wrwkv_t, D, 32 * nb, 64 * kb, scr, F.lane); continue; } r -= I_RW;
        { const int kb = r / 32, nb = r % 32; p0_transpose_item(args.in[22], D, 32 * nb, Wout_t, D, 32 * nb, 64 * kb, scr, F.lane); }
    }
    bf16* H = (bf16*)F.out; const float* x = args.in[0]; const float* pg = args.in[1];
    f32x4 gv[4];
#pragma unroll
    for (int j = 0; j < 4; ++j) gv[j] = ((const GAS f32x4*)pg)[F.lane + 64 * j];
    for (int m = gw; m < M; m += NGW) {
        const GAS f32x4* xr = (const GAS f32x4*)(x + (size_t)m * D) + F.lane;
        f32x4 v[4]; float s = 0.f;
#pragma unroll
        for (int j = 0; j < 4; ++j) { v[j] = xr[64 * j]; s += (v[j].x * v[j].x + v[j].y * v[j].y) + (v[j].z * v[j].z + v[j].w * v[j].w); }
        const float rstd = 1.f / sqrtf(wave_sum(s) * (1.f / D) + EPS);
        GAS unsigned long long* o8 = (GAS unsigned long long*)(H + (size_t)m * D) + F.lane;
#pragma unroll
        for (int j = 0; j < 4; ++j) { const f32x4 w = v[j] * rstd * gv[j]; o8[64 * j] = (unsigned long long)pk2(w.x, w.y) | ((unsigned long long)pk2(w.z, w.w) << 32); }
    }
}

__device__ __forceinline__ int kidx(int pr, int g, int j) { return 16 * (2 * pr + (j >> 2)) + 4 * g + (j & 3); }
__device__ __forceinline__ size_t fp_off(int row0, int h, int x) { return (size_t)(row0 + (x >> 6)) * 1024 + h * 64 + (x & 63); }
__device__ __forceinline__ bf16x8 pack_tiles(const f32x4& a, const f32x4& b) {
    v4u w; w.x = pk2(a[0], a[1]); w.y = pk2(a[2], a[3]); w.z = pk2(b[0], b[1]); w.w = pk2(b[2], b[3]); return __builtin_bit_cast(bf16x8, w); }

constexpr int RS_ZBUF = 0, RS_GV = 16384, RS_SB = 53824, RS_YB = 54336, RS_PAR = 72768, RS_ROWB = 144;
template <int VAR>
__device__ __forceinline__ void rwkv_scan_mfma(const Args& args, Frame& F, int unit) {
    LAS unsigned char* lds = F.lds;
    const int tid = F.tid, lane = F.lane, w = F.wave, q = lane >> 4, r16 = lane & 15;
    const int h = unit & 15, b = unit >> 4; const bool zw = w < 4; const int wb = w & 3;
    const bf16* Rb = (const bf16*)(F.ws + WS_RKVG); const bf16* Kb = Rb + (size_t)M * 1024; const bf16* Vb = Kb + (size_t)M * 1024;
    bf16* Yo = (bf16*)((unsigned char*)F.out + WS_YRWKV_OUT); const float* SB = (const float*)(F.ws + WS_SB);
    if (tid < 192) { const int k = tid >> 6, cc = tid & 63; const float* src = k == 0 ? args.in[18] + h * 64 : k == 1 ? args.in[19] + h * 64 : args.in[10] + 2048 + h * 64;
        ((LAS float*)(lds + RS_PAR))[tid] = src[cc]; }
    f32x4 Z[4];
#pragma unroll
    for (int i = 0; i < 4; ++i) Z[i] = (f32x4){0.f, 0.f, 0.f, 0.f};
    v4u gf[4][2]; u32x2_t hf[4];
    v4u rf[2]; u32x2_t yf[4];
    v4u sg[3]; float ssb = 0.f;
#define RS_LOAD(cc) do { const bf16* GH_ = (const bf16*)(F.ws + WS_GH) + (size_t)((b * 16 + h) * 64 + (cc)) * 8192; const int row0_ = b * SEQ + (cc) * 64; \
        if (zw) { _Pragma("unroll") for (int i = 0; i < 4; ++i) { gf[i][0] = *(const GAS v4u*)(GH_ + ((i * 2 + 0) * 64 + lane) * 8); gf[i][1] = *(const GAS v4u*)(GH_ + ((i * 2 + 1) * 64 + lane) * 8); \
                hf[i] = *(const GAS u32x2_t*)(GH_ + 4096 + ((i * 4 + wb) * 64 + lane) * 4); } } \
        else { rf[0] = *(const GAS v4u*)(Rb + fp_off(row0_, h, ((wb * 2 + 0) * 64 + lane) * 8)); rf[1] = *(const GAS v4u*)(Rb + fp_off(row0_, h, ((wb * 2 + 1) * 64 + lane) * 8)); \
            _Pragma("unroll") for (int i = 0; i < 4; ++i) yf[i] = *(const GAS u32x2_t*)(Kb + fp_off(row0_, h, ((wb * 4 + i) * 64 + lane) * 4)); } } while (0)
#define RS_GVLOAD(cc) do { const int row0_ = b * SEQ + (cc) * 64; \
        _Pragma("unroll") for (int k = 0; k < 3; ++k) { const int p = tid + 256 * k; sg[k] = (v4u){0u, 0u, 0u, 0u}; \
            if (p < 520) { const int rr = p >> 3, ch = p & 7; \
                if (rr > 0 || (cc) > 0) sg[k] = *(const GAS v4u*)(Vb + (size_t)(row0_ + rr - 1) * 1024 + h * 64 + ch * 8); } } \
        if (tid < 64) ssb = SB[(size_t)(row0_ + tid) * 16 + h]; } while (0)
#define RS_GVSTORE(par) do { \
        _Pragma("unroll") for (int k = 0; k < 3; ++k) { const int p = tid + 256 * k; \
            if (p < 520) { const int rr = p >> 3, ch = p & 7; *(LAS v4u*)(lds + RS_GV + ((par) * 65 + rr) * RS_ROWB + ch * 16) = sg[k]; } } \
        if (tid < 64) ((LAS float*)(lds + RS_SB))[(par) * 64 + tid] = ssb; } while (0)
    RS_LOAD(0);
    if (zw) {
        RS_GVLOAD(0); RS_GVSTORE(0); RS_GVLOAD(1);
        { const bf16x8 z0 = pack_tiles(Z[0], Z[1]);
          *(LAS bf16x8*)(lds + RS_ZBUF + (((0 * 4 + wb) * 2 + 0) * 64 + lane) * 16) = z0; *(LAS bf16x8*)(lds + RS_ZBUF + (((0 * 4 + wb) * 2 + 1) * 64 + lane) * 16) = z0; }
        LDS_BARRIER();
        for (int c = 0; c < NCHUNK; ++c) {
            const int par = c & 1;
            const bf16x8 zp0 = pack_tiles(Z[0], Z[1]), zp1 = pack_tiles(Z[2], Z[3]);
#pragma unroll
            for (int i = 0; i < 4; ++i) {
                f32x4 zn; zn[0] = bf_lo_(hf[i].x); zn[1] = bf_hi_(hf[i].x); zn[2] = bf_lo_(hf[i].y); zn[3] = bf_hi_(hf[i].y);
                zn = __builtin_amdgcn_mfma_f32_16x16x32_bf16(__builtin_bit_cast(bf16x8, gf[i][0]), zp0, zn, 0, 0, 0);
                zn = __builtin_amdgcn_mfma_f32_16x16x32_bf16(__builtin_bit_cast(bf16x8, gf[i][1]), zp1, zn, 0, 0, 0);
                Z[i] = zn; }
            if (c + 1 < NCHUNK) { if (VAR < 2) RS_LOAD(c + 1);
                *(LAS bf16x8*)(lds + RS_ZBUF + ((((par ^ 1) * 4 + wb) * 2 + 0) * 64 + lane) * 16) = pack_tiles(Z[0], Z[1]);
                *(LAS bf16x8*)(lds + RS_ZBUF + ((((par ^ 1) * 4 + wb) * 2 + 1) * 64 + lane) * 16) = pack_tiles(Z[2], Z[3]);
                RS_GVSTORE(par ^ 1); if (VAR < 2 && c + 2 < NCHUNK) RS_GVLOAD(c + 2); }
            if (c > 0) { const int rowp = b * SEQ + (c - 1) * 64;
#pragma unroll
                for (int k = 0; k < 2; ++k) { const int p = tid + 256 * k, t = p >> 3, ch = p & 7;
                    const v4u yv_ = *(const LAS v4u*)(lds + RS_YB + ((par ^ 1) * 64 + t) * RS_ROWB + ch * 16); if (VAR == 0) *(GAS v4u*)(Yo + (size_t)(rowp + t) * 1024 + h * 64 + ch * 8) = yv_; else asm volatile("" :: "v"(yv_)); } }
            LDS_BARRIER();
        }
        { const int rowp = b * SEQ + (NCHUNK - 1) * 64;
#pragma unroll
          for (int k = 0; k < 2; ++k) { const int p = tid + 256 * k, t = p >> 3, ch = p & 7;
            const v4u yv_ = *(const LAS v4u*)(lds + RS_YB + (((NCHUNK - 1) & 1) * 64 + t) * RS_ROWB + ch * 16); if (VAR == 0) *(GAS v4u*)(Yo + (size_t)(rowp + t) * 1024 + h * 64 + ch * 8) = yv_; else asm volatile("" :: "v"(yv_)); } }
        LDS_BARRIER();
    } else {
        LDS_BARRIER();
        for (int c = 0; c < NCHUNK; ++c) {
            const int par = c & 1;
            f32x4 Y[4];
#pragma unroll
            for (int i = 0; i < 4; ++i) {
                const bf16x8 zp0 = *(const LAS bf16x8*)(lds + RS_ZBUF + (((par * 4 + i) * 2 + 0) * 64 + lane) * 16), zp1 = *(const LAS bf16x8*)(lds + RS_ZBUF + (((par * 4 + i) * 2 + 1) * 64 + lane) * 16);
                f32x4 yy; yy[0] = bf_lo_(yf[i].x); yy[1] = bf_hi_(yf[i].x); yy[2] = bf_lo_(yf[i].y); yy[3] = bf_hi_(yf[i].y);
                yy = __builtin_amdgcn_mfma_f32_16x16x32_bf16(zp0, __builtin_bit_cast(bf16x8, rf[0]), yy, 0, 0, 0);
                yy = __builtin_amdgcn_mfma_f32_16x16x32_bf16(zp1, __builtin_bit_cast(bf16x8, rf[1]), yy, 0, 0, 0);
                Y[i] = yy; }
            if (VAR < 2 && c + 1 < NCHUNK) RS_LOAD(c + 1);
            float s1 = 0.f, s2 = 0.f;
#pragma unroll
            for (int i = 0; i < 4; ++i) { s1 += (Y[i][0] + Y[i][1]) + (Y[i][2] + Y[i][3]); s2 += (Y[i][0] * Y[i][0] + Y[i][1] * Y[i][1]) + (Y[i][2] * Y[i][2] + Y[i][3] * Y[i][3]); }
            s1 += __shfl_xor(s1, 16); s1 += __shfl_xor(s1, 32); s2 += __shfl_xor(s2, 16); s2 += __shfl_xor(s2, 32);
            const float mean = s1 * (1.f / 64.f); const float rstd = 1.f / sqrtf(fmaxf(s2 * (1.f / 64.f) - mean * mean, 0.f) + GN_EPS);
            const int t = 16 * wb + r16; const float sbv = ((const LAS float*)(lds + RS_SB))[par * 64 + t];
            const LAS float* PAR = (const LAS float*)(lds + RS_PAR);
#pragma unroll
            for (int i = 0; i < 4; ++i) { const int v0 = 16 * i + 4 * q;
                const f32x4 gng = *(const LAS f32x4*)(PAR + v0), gnb = *(const LAS f32x4*)(PAR + 64 + v0), muv = *(const LAS f32x4*)(PAR + 128 + v0);
                const LAS unsigned char* vp = lds + RS_GV + (par * 65 + t) * RS_ROWB + v0 * 2;
                const u32x2_t pv = *(const LAS u32x2_t*)vp, cv = *(const LAS u32x2_t*)(vp + RS_ROWB);
                float o[4];
#pragma unroll
                for (int e = 0; e < 4; ++e) { const unsigned cvw = cv[e >> 1], pvw = pv[e >> 1];
                    const float cvf = (e & 1) ? bf_hi_(cvw) : bf_lo_(cvw), pvf = (e & 1) ? bf_hi_(pvw) : bf_lo_(pvw);
                    const float vs = cvf + muv[e] * (pvf - cvf);
                    o[e] = (Y[i][e] - mean) * rstd * gng[e] + gnb[e] + sbv * vs; }
                u32x2_t pk; pk.x = pk2(o[0], o[1]); pk.y = pk2(o[2], o[3]); *(LAS u32x2_t*)(lds + RS_YB + (par * 64 + t) * RS_ROWB + v0 * 2) = pk; }
            LDS_BARRIER();
        }
        LDS_BARRIER();
    }
#undef RS_LOAD
#undef RS_GVLOAD
#undef RS_GVSTORE
}

#define TS 65
#define TL(i) (Tb + (i) * (64 * TS))
constexpr int RL_KB = 16640, RL_QR = 33280, RL_KTT = 49920, RL_BTT = 58112, RL_VT = 133120;
constexpr int RL_NN = 99840, RL_AQK = 108032, RL_ARK = 116480, RL_ARB = 124672, RL_DD = 0;
#define C256(base, row, ch) ((base) + (row) * 256 + ((((ch) ^ ((row) & 15))) << 4))
#define C128(base, row, ch) ((base) + (row) * 128 + ((((ch) ^ ((row) & 7))) << 4))
__device__ __forceinline__ bf16x8 pack_tile_lo(const f32x4& a) { v4u w; w.x = pk2(a[0], a[1]); w.y = pk2(a[2], a[3]); w.z = 0u; w.w = 0u; return __builtin_bit_cast(bf16x8, w); }
__device__ __forceinline__ bf16x8 neg_bf16x8(const bf16x8& a) { v4u w = __builtin_bit_cast(v4u, a); w.x ^= 0x80008000u; w.y ^= 0x80008000u; w.z ^= 0x80008000u; w.w ^= 0x80008000u; return __builtin_bit_cast(bf16x8, w); }
__device__ __forceinline__ bf16x8 ld_frag2(LAS unsigned char* lds, int a0, int a1) {
    const u32x2_t lo = *(const LAS u32x2_t*)(lds + a0), hi = *(const LAS u32x2_t*)(lds + a1); v4u w; w.x = lo.x; w.y = lo.y; w.z = hi.x; w.w = hi.y; return __builtin_bit_cast(bf16x8, w); }
#define MFMA16(a, b, c) __builtin_amdgcn_mfma_f32_16x16x32_bf16((a), (b), (c), 0, 0, 0)

__device__ __forceinline__ void rwkv_local_mfma_part(const Args& args, Frame& F, int row0, int b, int h, int c, bool dry) {
    LAS unsigned char* lds = F.lds; LAS float* Tb = (LAS float*)F.lds; LAS float* PL = Tb + 9 * 64 * TS;
    const int tid = F.tid, lane = F.lane, w = F.wave, q = lane >> 4, r16 = lane & 15;
    { const int t = tid >> 3, c8 = (tid & 7) * 8, ch = tid & 7; float v[8]; v4u o;
#define CVT_ROW(TI, IMG, CH) do { _Pragma("unroll") for (int e = 0; e < 8; ++e) v[e] = TL(TI)[t * TS + c8 + e]; o.x = pk2(v[0], v[1]); o.y = pk2(v[2], v[3]); o.z = pk2(v[4], v[5]); o.w = pk2(v[6], v[7]); \
        *(LAS v4u*)(lds + C256(IMG, t, CH)) = o; } while (0)
      CVT_ROW(6, RL_KB, ch); CVT_ROW(0, RL_KB, 8 + ch); CVT_ROW(4, RL_QR, ch); CVT_ROW(5, RL_QR, 8 + ch);
#undef CVT_ROW
      const int cc = tid >> 3, t8 = (tid & 7) * 8;
#define CVT_COL(TI, IMG) do { _Pragma("unroll") for (int e = 0; e < 8; ++e) v[e] = TL(TI)[(t8 + e) * TS + cc]; o.x = pk2(v[0], v[1]); o.y = pk2(v[2], v[3]); o.z = pk2(v[4], v[5]); o.w = pk2(v[6], v[7]); \
        *(LAS v4u*)(lds + C128(IMG, cc, ch)) = o; } while (0)
      CVT_COL(6, RL_KTT); CVT_COL(0, RL_BTT); CVT_COL(7, RL_VT);
#undef CVT_COL
    }
    __syncthreads();
    { const int tb = w >> 1, side = w & 1, t = 16 * tb + r16;
      bf16x8 bq[2];
#pragma unroll
      for (int ks = 0; ks < 2; ++ks) bq[ks] = *(const LAS bf16x8*)(lds + C256(RL_QR, t, 8 * side + 4 * ks + q));
#pragma unroll 1
      for (int ib = 0; ib < 4; ++ib) { f32x4 a0 = (f32x4){0.f, 0.f, 0.f, 0.f}, a1 = (f32x4){0.f, 0.f, 0.f, 0.f};
        if (ib <= tb) {
#pragma unroll
            for (int ks = 0; ks < 2; ++ks) { const bf16x8 fb = *(const LAS bf16x8*)(lds + C256(RL_KB, 16 * ib + r16, 8 + 4 * ks + q)), fk = *(const LAS bf16x8*)(lds + C256(RL_KB, 16 * ib + r16, 4 * ks + q));
                a0 = MFMA16(fb, bq[ks], a0); a1 = MFMA16(fk, bq[ks], a1); } }
        float vb_[4], vk_[4];
#pragma unroll
        for (int e = 0; e < 4; ++e) { const int i = 16 * ib + 4 * q + e; const bool keep = side ? (i <= t) : (i < t); vb_[e] = keep ? (side ? a0[e] : -a0[e]) : 0.f; vk_[e] = keep ? a1[e] : 0.f; }
        u32x2_t pb, pk_; pb.x = pk2(vb_[0], vb_[1]); pb.y = pk2(vb_[2], vb_[3]); pk_.x = pk2(vk_[0], vk_[1]); pk_.y = pk2(vk_[2], vk_[3]);
        const int off = C128(0, t, 2 * ib + (q >> 1)) + (q & 1) * 8;
        *(LAS u32x2_t*)(lds + (side ? RL_ARB : RL_NN) + off) = pb; *(LAS u32x2_t*)(lds + (side ? RL_ARK : RL_AQK) + off) = pk_; } }
    __syncthreads();
    if (w < 4) { const int j = w; f32x4 Pa, Pt, Ta, Tt;
#pragma unroll
        for (int e = 0; e < 4; ++e) { const int rr = 16 * j + 4 * q + e, cc = 16 * j + r16; Pa[e] = bf2f(*(const LAS bf16*)(lds + C128(RL_NN, rr, cc >> 3) + (cc & 7) * 2)); }
        { const u32x2_t x = *(const LAS u32x2_t*)(lds + C128(RL_NN, 16 * j + r16, 2 * j + (q >> 1)) + (q & 1) * 8); Pt[0] = bf_lo_(x.x); Pt[1] = bf_hi_(x.x); Pt[2] = bf_lo_(x.y); Pt[3] = bf_hi_(x.y); }
#pragma unroll
        for (int e = 0; e < 4; ++e) { const float id = (4 * q + e == r16) ? 1.f : 0.f; Ta[e] = Pa[e] + id; Tt[e] = Pt[e] + id; }
#pragma unroll
        for (int rnd = 0; rnd < 3; ++rnd) { const bf16x8 pa = pack_tile_lo(Pa), pt = pack_tile_lo(Pt); const f32x4 z4 = (f32x4){0.f, 0.f, 0.f, 0.f};
            const f32x4 nPa = MFMA16(pt, pa, z4), nPt = MFMA16(pa, pt, z4);
            const bf16x8 npa = pack_tile_lo(nPa), tt = pack_tile_lo(Tt);
            Ta = MFMA16(tt, npa, Ta);
            Tt = MFMA16(npa, tt, Tt);
            Pa = nPa; Pt = nPt; }
        u32x2_t pk_; pk_.x = pk2(Tt[0], Tt[1]); pk_.y = pk2(Tt[2], Tt[3]);
        *(LAS u32x2_t*)(lds + RL_DD + j * 512 + r16 * 32 + q * 8) = pk_; }
    __syncthreads();
    { const int cb = w & 3, side = w >> 2, col = 16 * cb + r16; f32x4 S[4];
      if (side == 0) {
#pragma unroll
        for (int j = 0; j < 4; ++j)
#pragma unroll
            for (int e = 0; e < 4; ++e) S[j][e] = TL(4)[(16 * j + 4 * q + e) * TS + col];
      } else {
        bf16x8 bv[2];
#pragma unroll
        for (int ks = 0; ks < 2; ++ks) bv[ks] = *(const LAS bf16x8*)(lds + C128(RL_VT, col, 4 * ks + q));
#pragma unroll
        for (int j = 0; j < 4; ++j) { f32x4 a = (f32x4){0.f, 0.f, 0.f, 0.f};
#pragma unroll
            for (int ks = 0; ks < 2; ++ks) a = MFMA16(*(const LAS bf16x8*)(lds + C128(RL_AQK, 16 * j + r16, 4 * ks + q)), bv[ks], a);
            S[j] = a; } }
#pragma unroll
      for (int j = 0; j < 4; ++j) { const int t = 16 * j + r16; f32x4 a = S[j];
        if (j == 1) a = MFMA16(ld_frag2(lds, RL_NN + C128(0, t, 0 + (q >> 1)) + (q & 1) * 8, RL_NN + C128(0, t, 0 + (q >> 1)) + (q & 1) * 8), pack_tile_lo(S[0]), a);
        if (j >= 2) a = MFMA16(ld_frag2(lds, RL_NN + C128(0, t, 0 + (q >> 1)) + (q & 1) * 8, RL_NN + C128(0, t, 2 + (q >> 1)) + (q & 1) * 8), pack_tiles(S[0], S[1]), a);
        if (j == 3) a = MFMA16(ld_frag2(lds, RL_NN + C128(0, t, 4 + (q >> 1)) + (q & 1) * 8, RL_NN + C128(0, t, 4 + (q >> 1)) + (q & 1) * 8), pack_tile_lo(S[2]), a);
        const int dd = RL_DD + j * 512 + r16 * 32 + q * 8;
        const f32x4 z4 = (f32x4){0.f, 0.f, 0.f, 0.f}; S[j] = MFMA16(ld_frag2(lds, dd, dd), pack_tile_lo(a), z4); }
      const bf16x8 sp0 = pack_tiles(S[0], S[1]), sp1 = pack_tiles(S[2], S[3]);
      bf16* GH = (bf16*)(F.ws + WS_GH) + (size_t)((b * 16 + h) * 64 + c) * 8192;
      bf16* Rb = (bf16*)(F.ws + WS_RKVG); bf16* Kb = Rb + (size_t)M * 1024;
      if (side == 0) {
#pragma unroll 1
        for (int tb = 0; tb < 4; ++tb) { const int t = 16 * tb + r16; f32x4 a = (f32x4){0.f, 0.f, 0.f, 0.f};
            a = MFMA16(sp0, ld_frag2(lds, RL_ARB + C128(0, t, 0 + (q >> 1)) + (q & 1) * 8, RL_ARB + C128(0, t, 2 + (q >> 1)) + (q & 1) * 8), a);
            a = MFMA16(sp1, ld_frag2(lds, RL_ARB + C128(0, t, 4 + (q >> 1)) + (q & 1) * 8, RL_ARB + C128(0, t, 6 + (q >> 1)) + (q & 1) * 8), a);
            float o[4];
#pragma unroll
            for (int e = 0; e < 4; ++e) o[e] = TL(5)[t * TS + 16 * cb + 4 * q + e] - a[e];
            u32x2_t pk_; pk_.x = pk2(o[0], o[1]); pk_.y = pk2(o[2], o[3]);
            if (!dry) *(GAS u32x2_t*)(Rb + fp_off(row0, h, ((tb * 2 + (cb >> 1)) * 64 + lane) * 8 + 4 * (cb & 1))) = pk_; }
#pragma unroll 1
        for (int kb = 0; kb < 4; ++kb) { const int k = 16 * kb + r16; f32x4 a = (f32x4){0.f, 0.f, 0.f, 0.f};
            a = MFMA16(sp0, ld_frag2(lds, RL_BTT + C128(0, k, 0 + (q >> 1)) + (q & 1) * 8, RL_BTT + C128(0, k, 2 + (q >> 1)) + (q & 1) * 8), a);
            a = MFMA16(sp1, ld_frag2(lds, RL_BTT + C128(0, k, 4 + (q >> 1)) + (q & 1) * 8, RL_BTT + C128(0, k, 6 + (q >> 1)) + (q & 1) * 8), a);
            const float pl = PL[k]; float o[4];
#pragma unroll
            for (int e = 0; e < 4; ++e) o[e] = pl * (((16 * cb + 4 * q + e) == k ? 1.f : 0.f) - a[e]);
            u32x2_t pk_; pk_.x = pk2(o[0], o[1]); pk_.y = pk2(o[2], o[3]);
            if (!dry) *(GAS u32x2_t*)(GH + ((kb * 2 + (cb >> 1)) * 64 + lane) * 8 + 4 * (cb & 1)) = pk_; }
      } else {
        const bf16x8 nsp0 = neg_bf16x8(sp0), nsp1 = neg_bf16x8(sp1);
        bf16x8 av[2];
#pragma unroll
        for (int ks = 0; ks < 2; ++ks) av[ks] = *(const LAS bf16x8*)(lds + C128(RL_VT, col, 4 * ks + q));
#pragma unroll 1
        for (int tb = 0; tb < 4; ++tb) { const int t = 16 * tb + r16; f32x4 a = (f32x4){0.f, 0.f, 0.f, 0.f};
#pragma unroll
            for (int ks = 0; ks < 2; ++ks) a = MFMA16(av[ks], *(const LAS bf16x8*)(lds + C128(RL_ARK, t, 4 * ks + q)), a);
            a = MFMA16(nsp0, ld_frag2(lds, RL_ARB + C128(0, t, 0 + (q >> 1)) + (q & 1) * 8, RL_ARB + C128(0, t, 2 + (q >> 1)) + (q & 1) * 8), a);
            a = MFMA16(nsp1, ld_frag2(lds, RL_ARB + C128(0, t, 4 + (q >> 1)) + (q & 1) * 8, RL_ARB + C128(0, t, 6 + (q >> 1)) + (q & 1) * 8), a);
            u32x2_t pk_; pk_.x = pk2(a[0], a[1]); pk_.y = pk2(a[2], a[3]);
            if (!dry) *(GAS u32x2_t*)(Kb + fp_off(row0, h, ((tb * 4 + cb) * 64 + lane) * 4)) = pk_; }
#pragma unroll 1
        for (int kb = 0; kb < 4; ++kb) { const int k = 16 * kb + r16; f32x4 a = (f32x4){0.f, 0.f, 0.f, 0.f};
#pragma unroll
            for (int ks = 0; ks < 2; ++ks) a = MFMA16(*(const LAS bf16x8*)(lds + C128(RL_KTT, k, 4 * ks + q)), av[ks], a);
            a = MFMA16(ld_frag2(lds, RL_BTT + C128(0, k, 0 + (q >> 1)) + (q & 1) * 8, RL_BTT + C128(0, k, 2 + (q >> 1)) + (q & 1) * 8), nsp0, a);
            a = MFMA16(ld_frag2(lds, RL_BTT + C128(0, k, 4 + (q >> 1)) + (q & 1) * 8, RL_BTT + C128(0, k, 6 + (q >> 1)) + (q & 1) * 8), nsp1, a);
            float o[4];
#pragma unroll
            for (int e = 0; e < 4; ++e) o[e] = PL[16 * kb + 4 * q + e] * a[e];
            u32x2_t pk_; pk_.x = pk2(o[0], o[1]); pk_.y = pk2(o[2], o[3]);
            if (!dry) *(GAS u32x2_t*)(GH + 4096 + ((kb * 4 + cb) * 64 + lane) * 4) = pk_; }
      } }
    __syncthreads();
}

#ifndef RWKV_LOCAL_FAST
#define RWKV_LOCAL_FAST 1
#endif
__device__ __forceinline__ void rwkv_local_simple(const Args& args, Frame& F, int unit, bool dry = false) {
    LAS float* Tb = (LAS float*)F.lds; LAS float* PL = Tb + 9 * 64 * TS;
    const int tid = F.tid, ch = tid & 63, tq = tid >> 6;
    const int h = unit & 15, c = (unit >> 4) & 63, b = unit >> 10;
    const int row0 = b * SEQ + c * 64, hc = h * 64 + ch;
    bf16* Rb = (bf16*)(F.ws + WS_RKVG); bf16* Kb = Rb + (size_t)M * 1024; bf16* Vb = Kb + (size_t)M * 1024;
    const bf16* HALO = (const bf16*)(F.ws + WS_HALO); const float* SMALL = (const float*)(F.ws + WS_SMALL);
    const float* mu = args.in[10]; const float* w0 = args.in[11]; const float* w2 = args.in[12]; const float* a0 = args.in[13]; const float* a2 = args.in[14];
    const float* k_k = args.in[15]; const float* k_a = args.in[16]; const float* r_k = args.in[17];
    { const int t8 = tid >> 3, c8 = (tid & 7) * 8; const size_t rg = (size_t)(row0 + t8); const bool hasp = (c * 64 + t8) > 0;
      const f32x4 z4 = (f32x4){0.f, 0.f, 0.f, 0.f}; const v4u zu = (v4u){0u, 0u, 0u, 0u};
      { const GAS f32x4* sw = (const GAS f32x4*)(SMALL + rg * 256 + 32 + c8); const GAS f32x4* sa = (const GAS f32x4*)(SMALL + rg * 256 + 96 + c8);
        f32x4 cw0 = sw[0], cw1 = sw[1], ca0 = sa[0], ca1 = sa[1], pw0 = z4, pw1 = z4, pa0 = z4, pa1 = z4;
        if (hasp) { pw0 = sw[-64]; pw1 = sw[-63]; pa0 = sa[-64]; pa1 = sa[-63]; }
        const GAS f32x4* w2p = (const GAS f32x4*)(w2 + t8 * 1024 + h * 64 + c8); const GAS f32x4* a2p = (const GAS f32x4*)(a2 + t8 * 1024 + h * 64 + c8);
        const f32x4 w20 = w2p[0], w21 = w2p[1], a20 = a2p[0], a21 = a2p[1];
        const f32x4 mw0 = *(const GAS f32x4*)(mu + 4096 + c8), mw1 = *(const GAS f32x4*)(mu + 4100 + c8), ma0 = *(const GAS f32x4*)(mu + 4160 + c8), ma1 = *(const GAS f32x4*)(mu + 4164 + c8);
#pragma unroll
        for (int e = 0; e < 8; ++e) { const int o = t8 * TS + c8 + e;
          const float cwv = e < 4 ? cw0[e & 3] : cw1[e & 3], pwv = e < 4 ? pw0[e & 3] : pw1[e & 3], cav = e < 4 ? ca0[e & 3] : ca1[e & 3], pav = e < 4 ? pa0[e & 3] : pa1[e & 3];
          const float muw = e < 4 ? mw0[e & 3] : mw1[e & 3], mua = e < 4 ? ma0[e & 3] : ma1[e & 3];
          const float xw = cwv + muw * (pwv - cwv);
          TL(0)[o] = 1.f - 2.f / (1.f + __expf(2.f * xw)); TL(1)[o] = cav + mua * (pav - cav);
          TL(2)[o] = e < 4 ? w20[e & 3] : w21[e & 3]; TL(3)[o] = e < 4 ? a20[e & 3] : a21[e & 3]; } }
      asm volatile("" ::: "memory");
      { const v4u cr = *(const GAS v4u*)(Rb + rg * 1024 + h * 64 + c8), ck = *(const GAS v4u*)(Kb + rg * 1024 + h * 64 + c8), cv = *(const GAS v4u*)(Vb + rg * 1024 + h * 64 + c8);
        v4u pr = zu, pk = zu, pv = zu;
        if (t8 > 0) { pr = *(const GAS v4u*)(Rb + (rg - 1) * 1024 + h * 64 + c8); pk = *(const GAS v4u*)(Kb + (rg - 1) * 1024 + h * 64 + c8); pv = *(const GAS v4u*)(Vb + (rg - 1) * 1024 + h * 64 + c8); }
        else if (c > 0) { const bf16* hr = HALO + (size_t)((row0 >> 6) - 1) * 4096 + h * 64 + c8; pr = *(const GAS v4u*)(hr); pk = *(const GAS v4u*)(hr + 1024); pv = *(const GAS v4u*)(hr + 2048); }
        const GAS f32x4* mup = (const GAS f32x4*)(mu + h * 64 + c8);
        const f32x4 mr0 = mup[0], mr1 = mup[1], mk0 = mup[256], mk1 = mup[257], mv0 = mup[512], mv1 = mup[513];
#pragma unroll
        for (int e = 0; e < 8; ++e) { const int o = t8 * TS + c8 + e;
          const unsigned crw = cr[e >> 1], ckw = ck[e >> 1], cvw = cv[e >> 1], prw = pr[e >> 1], pkw = pk[e >> 1], pvw = pv[e >> 1];
          const float crf = (e & 1) ? bf_hi_(crw) : bf_lo_(crw), ckf = (e & 1) ? bf_hi_(ckw) : bf_lo_(ckw), cvf = (e & 1) ? bf_hi_(cvw) : bf_lo_(cvw);
          const float prf = (e & 1) ? bf_hi_(prw) : bf_lo_(prw), pkf = (e & 1) ? bf_hi_(pkw) : bf_lo_(pkw), pvf = (e & 1) ? bf_hi_(pvw) : bf_lo_(pvw);
          const float mur = e < 4 ? mr0[e & 3] : mr1[e & 3], muk = e < 4 ? mk0[e & 3] : mk1[e & 3], muv = e < 4 ? mv0[e & 3] : mv1[e & 3];
          TL(5)[o] = crf + mur * (prf - crf); TL(4)[o] = ckf + muk * (pkf - ckf); TL(7)[o] = cvf + muv * (pvf - cvf); } } }
    __syncthreads();
    { float wl[8], al[8]; const float w0c = w0[hc], a0c = a0[hc];
#pragma unroll
      for (int i = 0; i < 8; ++i) { wl[i] = w0c; al[i] = a0c; }
#pragma unroll 4
      for (int j = 0; j < 64; ++j) { const float wv = TL(2)[j * TS + ch], av = TL(3)[j * TS + ch];
#pragma unroll
        for (int i = 0; i < 8; ++i) { const int t = tq + 8 * i; wl[i] += TL(0)[t * TS + j] * wv; al[i] += TL(1)[t * TS + j] * av; } }
      __syncthreads();
#pragma unroll
      for (int i = 0; i < 8; ++i) { const int t = tq + 8 * i; const float wlog = -softplusf_(-wl[i]) - 0.5f; TL(2)[t * TS + ch] = -__expf(wlog); TL(3)[t * TS + ch] = sigm_(al[i]); } }
    __syncthreads();
    { const float kkc = k_k[hc], kac = k_a[hc], rkc = r_k[h * 64 + ch];
#pragma unroll
      for (int i = 0; i < 8; ++i) { const int t = tq + 8 * i; const size_t rg = (size_t)(row0 + t);
        const float rr = TL(5)[t * TS + ch], kx = TL(4)[t * TS + ch];
        const float a = TL(3)[t * TS + ch]; const float kkr = kx * kkc, k2 = kx * (1.f + (a - 1.f) * kac);
        const float nrm = wave_sum(kkr * kkr), sbs = wave_sum(rr * k2 * rkc);
        const float kk = kkr / fmaxf(sqrtf(nrm), 1e-12f);
        TL(4)[t * TS + ch] = kk; TL(6)[t * TS + ch] = k2; TL(0)[t * TS + ch] = kk * a;
        if (ch == 0 && !dry) ((float*)(F.ws + WS_SB))[rg * 16 + h] = sbs; } }
    __syncthreads();
    {
#pragma unroll
      for (int i = 0; i < 8; ++i) { const int cc = 8 * tq + i; float v = TL(2)[ch * TS + cc];
#pragma unroll
        for (int off = 1; off < 64; off <<= 1) { const float t_ = __shfl_up(v, off); if (ch >= off) v += t_; }
        TL(1)[ch * TS + cc] = v; } }
    __syncthreads();
#pragma unroll
    for (int i = 0; i < 8; ++i) { const int t = tq + 8 * i; const float cl = TL(1)[t * TS + ch], ld = TL(2)[t * TS + ch]; const float en = __expf(-cl);
        TL(6)[t * TS + ch] *= en; TL(0)[t * TS + ch] *= en; TL(4)[t * TS + ch] *= __expf(cl - ld); TL(5)[t * TS + ch] *= __expf(cl); if (t == 63) PL[ch] = __expf(cl); }
    __syncthreads();
#if RWKV_LOCAL_FAST
    rwkv_local_mfma_part(args, F, row0, b, h, c, dry); return;
#endif
    { float qb[8], qk[8], rk[8], rb[8];
#pragma unroll
      for (int i = 0; i < 8; ++i) { qb[i] = 0.f; qk[i] = 0.f; rk[i] = 0.f; rb[i] = 0.f; }
#pragma unroll 2
      for (int j = 0; j < 64; ++j) { const float bi = TL(0)[ch * TS + j], ki = TL(6)[ch * TS + j];
#pragma unroll
        for (int i = 0; i < 8; ++i) { const int t = tq + 8 * i; const float q = TL(4)[t * TS + j], r = TL(5)[t * TS + j]; qb[i] += q * bi; qk[i] += q * ki; rk[i] += r * ki; rb[i] += r * bi; } }
      __syncthreads();
#pragma unroll
      for (int i = 0; i < 8; ++i) { const int t = tq + 8 * i; const bool st = ch < t, in = ch <= t;
        TL(1)[t * TS + ch] = st ? qb[i] : 0.f; TL(2)[t * TS + ch] = st ? qk[i] : 0.f; TL(3)[t * TS + ch] = in ? rk[i] : 0.f; TL(8)[t * TS + ch] = in ? rb[i] : 0.f; } }
    __syncthreads();
    { float o[8];
#pragma unroll
      for (int i = 0; i < 8; ++i) o[i] = 0.f;
#pragma unroll 2
      for (int j = 0; j < 64; ++j) { const float vj = TL(7)[j * TS + ch];
#pragma unroll
        for (int i = 0; i < 8; ++i) o[i] += TL(2)[(tq + 8 * i) * TS + j] * vj; }
      __syncthreads();
#pragma unroll
      for (int i = 0; i < 8; ++i) TL(2)[(tq + 8 * i) * TS + ch] = o[i]; }
    __syncthreads();
    if (tid < 128) { LAS float* tile = (tid < 64) ? TL(4) : TL(2); const int col = tid & 63;
#pragma unroll 1
        for (int t = 1; t < 64; ++t) { float s = tile[t * TS + col];
#pragma unroll 4
            for (int i = 0; i < t; ++i) s -= TL(1)[t * TS + i] * tile[i * TS + col];
            tile[t * TS + col] = s; } }
    __syncthreads();
    { float o1[8], o2[8];
#pragma unroll
      for (int i = 0; i < 8; ++i) { o1[i] = TL(5)[(tq + 8 * i) * TS + ch]; o2[i] = 0.f; }
#pragma unroll 2
      for (int j = 0; j < 64; ++j) { const float qj = TL(4)[j * TS + ch], vj = TL(7)[j * TS + ch], xj = TL(2)[j * TS + ch];
#pragma unroll
        for (int i = 0; i < 8; ++i) { const int t = tq + 8 * i; const float arb = TL(8)[t * TS + j], ark = TL(3)[t * TS + j]; o1[i] -= arb * qj; o2[i] += ark * vj - arb * xj; } }
      __syncthreads();
#pragma unroll
      for (int i = 0; i < 8; ++i) { TL(5)[(tq + 8 * i) * TS + ch] = o1[i]; TL(3)[(tq + 8 * i) * TS + ch] = o2[i]; } }
    __syncthreads();
    { bf16* GH = (bf16*)(F.ws + WS_GH) + (size_t)((b * 16 + h) * 64 + c) * 8192;
      const int blk = ch >> 4, gg = (ch & 15) >> 2, jj = ch & 3;
      { float g[8];
#pragma unroll
        for (int i = 0; i < 8; ++i) g[i] = 0.f;
#pragma unroll 2
        for (int t = 0; t < 64; ++t) { const float qh = TL(4)[t * TS + ch];
#pragma unroll
          for (int i = 0; i < 8; ++i) g[i] += TL(0)[t * TS + tq + 8 * i] * qh; }
#pragma unroll
        for (int i = 0; i < 8; ++i) { const int k = tq + 8 * i; const float pl = PL[k];
          const int xfrag = (((k >> 4) * 2 + (blk >> 1)) * 64 + gg * 16 + (k & 15)) * 8 + (blk & 1) * 4 + jj;
          GH[xfrag] = (bf16)f2bf(pl * ((k == ch ? 1.f : 0.f) - g[i]));
          Rb[fp_off(row0, h, xfrag)] = (bf16)f2bf(TL(5)[k * TS + ch]); } }
      { float hh[8];
#pragma unroll
        for (int i = 0; i < 8; ++i) hh[i] = 0.f;
#pragma unroll 2
        for (int t = 0; t < 64; ++t) { const float vm = TL(7)[t * TS + ch], xx = TL(2)[t * TS + ch];
#pragma unroll
          for (int i = 0; i < 8; ++i) { const int k = tq + 8 * i; hh[i] += TL(6)[t * TS + k] * vm - TL(0)[t * TS + k] * xx; } }
#pragma unroll
        for (int i = 0; i < 8; ++i) { const int k = tq + 8 * i; const float pl = PL[k];
          GH[4096 + (((k >> 4) * 4 + (ch >> 4)) * 64 + ((k & 15) >> 2) * 16 + (ch & 15)) * 4 + (k & 3)] = (bf16)f2bf(pl * hh[i]);
          Kb[fp_off(row0, h, (((k >> 4) * 4 + (ch >> 4)) * 64 + ((ch & 15) >> 2) * 16 + (k & 15)) * 4 + (ch & 3))] = (bf16)f2bf(TL(3)[k * TS + ch]); } } }
    __syncthreads();
}

__device__ __forceinline__ void rwkv_scan_simple(const Args& args, Frame& F, int unit) {
    LAS float* Tb = (LAS float*)F.lds;
    const int tid = F.tid, ch = tid & 63, tq = tid >> 6;
    const int h = unit & 15, b = unit >> 4, hc = h * 64 + ch;
    const bf16* Rb = (const bf16*)(F.ws + WS_RKVG); const bf16* Kb = Rb + (size_t)M * 1024; const bf16* Vb = Kb + (size_t)M * 1024; bf16* Gb = (bf16*)(Vb + (size_t)M * 1024);
    const bf16* HALO = (const bf16*)(F.ws + WS_HALO); const float* SB = (const float*)(F.ws + WS_SB);
    const float* mu = args.in[10]; const float gng = args.in[18][hc], gnb = args.in[19][hc]; const float muv = mu[2048 + hc], mug = mu[3072 + hc];
#pragma unroll
    for (int i = 0; i < 8; ++i) TL(0)[(tq + 8 * i) * TS + ch] = 0.f;
    __syncthreads();
    for (int c = 0; c < NCHUNK; ++c) {
        const int row0 = b * SEQ + c * 64;
        const bf16* GH = (const bf16*)(F.ws + WS_GH) + (size_t)((b * 16 + h) * 64 + c) * 8192;
        float gsh[8], vsh[8];
#pragma unroll
        for (int i = 0; i < 8; ++i) { const int t = tq + 8 * i; const size_t rg = (size_t)(row0 + t);
            TL(1)[t * TS + ch] = bf2f(GH[t * 64 + ch]); TL(2)[t * TS + ch] = bf2f(GH[4096 + t * 64 + ch]);
            TL(3)[t * TS + ch] = bf2f(Rb[rg * 1024 + hc]); TL(4)[t * TS + ch] = bf2f(Kb[rg * 1024 + hc]);
            const float cg = bf2f(Gb[rg * 1024 + hc]), cv = bf2f(Vb[rg * 1024 + hc]); float pg = 0.f, pv = 0.f;
            if (t > 0) { pg = bf2f(Gb[(rg - 1) * 1024 + hc]); pv = bf2f(Vb[(rg - 1) * 1024 + hc]); }
            else if (c > 0) { const bf16* hr = HALO + (size_t)((row0 >> 6) - 1) * 4096; pg = bf2f(hr[3072 + hc]); pv = bf2f(hr[2048 + hc]); }
            gsh[i] = cg + mug * (pg - cg); vsh[i] = cv + muv * (pv - cv); }
        __syncthreads();
        float y[8], zn[8];
#pragma unroll
        for (int i = 0; i < 8; ++i) { y[i] = TL(4)[(tq + 8 * i) * TS + ch]; zn[i] = TL(2)[(tq + 8 * i) * TS + ch]; }
#pragma unroll 2
        for (int j = 0; j < 64; ++j) { const float zj = TL(0)[j * TS + ch];
#pragma unroll
            for (int i = 0; i < 8; ++i) { const int t = tq + 8 * i; y[i] += TL(3)[t * TS + j] * zj; zn[i] += TL(1)[t * TS + j] * zj; } }
#pragma unroll
        for (int i = 0; i < 8; ++i) { const int t = tq + 8 * i; const size_t rg = (size_t)(row0 + t);
            const float mean = wave_sum(y[i]) * (1.f / 64.f); const float d = y[i] - mean; const float var = wave_sum(d * d) * (1.f / 64.f);
            float o = d * (1.f / sqrtf(var + GN_EPS)) * gng + gnb + SB[rg * 16 + h] * vsh[i];
            o *= siluf_(gsh[i]);
            Gb[rg * 1024 + hc] = (bf16)f2bf(o); }
        __syncthreads();
#pragma unroll
        for (int i = 0; i < 8; ++i) TL(0)[(tq + 8 * i) * TS + ch] = zn[i];
        __syncthreads();
    }
}

#define TS2 129
__device__ __forceinline__ void ssd_scan_simple(const Args& args, Frame& F, int unit) {
    LAS float* X = (LAS float*)F.lds; LAS float* Bm = X + 64 * TS; LAS float* Cm = Bm + 64 * TS2; LAS float* Gs = Cm + 64 * TS2; LAS float* St = Gs + 64 * TS;
    LAS float* acum = St + 64 * TS2; LAS float* dtv = acum + 64;
    const int tid = F.tid, ch = tid & 63, tq = tid >> 6;
    const int hd = unit & 31, b = unit >> 5, g = hd >> 3;
    const bf16* XBC = (const bf16*)(F.ws + WS_XBC); bf16* Zb = (bf16*)(F.ws + WS_Z); const float* SMALL = (const float*)(F.ws + WS_SMALL); float* SSQ = (float*)(F.ws + WS_SSQ);
    const float* conv_w = args.in[4]; const float* conv_b = args.in[5];
    const float dtb = args.in[6][hd], Aneg = -__expf(args.in[7][hd]), Dsk = args.in[8][hd];
    for (int i = tid; i < 64 * TS2; i += 512) St[i] = 0.f;
    __syncthreads();
    for (int c = 0; c < NCHUNK; ++c) {
        const int row0 = b * SEQ + c * 64;
        { const int chan = hd * 64 + ch; const float w0_ = conv_w[chan], w1_ = conv_w[3072 + chan], w2_ = conv_w[2 * 3072 + chan], w3_ = conv_w[3 * 3072 + chan], cb = conv_b[chan];
#pragma unroll
          for (int i = 0; i < 8; ++i) { const int l = tq + 8 * i; const int tp = c * 64 + l; const size_t rg = (size_t)(row0 + l);
            float a = cb + w3_ * bf2f(XBC[rg * 3072 + chan]);
            if (tp >= 1) a += w2_ * bf2f(XBC[(rg - 1) * 3072 + chan]);
            if (tp >= 2) a += w1_ * bf2f(XBC[(rg - 2) * 3072 + chan]);
            if (tp >= 3) a += w0_ * bf2f(XBC[(rg - 3) * 3072 + chan]);
            X[l * TS + ch] = siluf_(a); } }
        { const int n = tid & 127, lq = tid >> 7;
#pragma unroll
          for (int which = 0; which < 2; ++which) { const int chan = 2048 + which * 512 + g * 128 + n; LAS float* dst = which ? Cm : Bm;
            const float w0_ = conv_w[chan], w1_ = conv_w[3072 + chan], w2_ = conv_w[2 * 3072 + chan], w3_ = conv_w[3 * 3072 + chan], cb = conv_b[chan];
            for (int i = 0; i < 16; ++i) { const int l = lq + 4 * i; const int tp = c * 64 + l; const size_t rg = (size_t)(row0 + l);
                float a = cb + w3_ * bf2f(XBC[rg * 3072 + chan]);
                if (tp >= 1) a += w2_ * bf2f(XBC[(rg - 1) * 3072 + chan]);
                if (tp >= 2) a += w1_ * bf2f(XBC[(rg - 2) * 3072 + chan]);
                if (tp >= 3) a += w0_ * bf2f(XBC[(rg - 3) * 3072 + chan]);
                dst[l * TS2 + n] = siluf_(a); } } }
        if (tid < 64) { const float dt = softplusf_(SMALL[(size_t)(row0 + tid) * 256 + hd] + dtb); dtv[tid] = dt; acum[tid] = dt * Aneg; }
        __syncthreads();
        if (tid == 0) { float s = 0.f; for (int l = 0; l < 64; ++l) { s += acum[l]; acum[l] = s; } }
        __syncthreads();
        { float o[8];
#pragma unroll
          for (int i = 0; i < 8; ++i) o[i] = 0.f;
#pragma unroll 2
          for (int n = 0; n < 128; ++n) { const float bs = Bm[ch * TS2 + n];
#pragma unroll
            for (int i = 0; i < 8; ++i) o[i] += Cm[(tq + 8 * i) * TS2 + n] * bs; }
#pragma unroll
          for (int i = 0; i < 8; ++i) { const int l = tq + 8 * i; Gs[l * TS + ch] = (ch <= l) ? o[i] * __expf(acum[l] - acum[ch]) * dtv[ch] : 0.f; } }
        __syncthreads();
        { float yd[8], yo[8];
#pragma unroll
          for (int i = 0; i < 8; ++i) { yd[i] = 0.f; yo[i] = 0.f; }
#pragma unroll 2
          for (int s = 0; s < 64; ++s) { const float xs = X[s * TS + ch];
#pragma unroll
            for (int i = 0; i < 8; ++i) yd[i] += Gs[(tq + 8 * i) * TS + s] * xs; }
#pragma unroll 2
          for (int n = 0; n < 128; ++n) { const float sp = St[ch * TS2 + n];
#pragma unroll
            for (int i = 0; i < 8; ++i) yo[i] += Cm[(tq + 8 * i) * TS2 + n] * sp; }
#pragma unroll
          for (int i = 0; i < 8; ++i) { const int l = tq + 8 * i; const size_t rg = (size_t)(row0 + l);
            const float yv = yd[i] + __expf(acum[l]) * yo[i] + Dsk * X[l * TS + ch];
            const float z = bf2f(Zb[rg * 2048 + hd * 64 + ch]); const float yz = yv * siluf_(z);
            Zb[rg * 2048 + hd * 64 + ch] = (bf16)f2bf(yz);
            const float ss = wave_sum(yz * yz); if (ch == 0) { SSQ[rg * 64 + hd * 2] = ss; SSQ[rg * 64 + hd * 2 + 1] = 0.f; } } }
        __syncthreads();
        { const int p = tid >> 3, n0 = tid & 7; float o[16]; const float a63 = acum[63]; const float dec = __expf(a63);
#pragma unroll
          for (int i = 0; i < 16; ++i) o[i] = dec * St[p * TS2 + n0 + 8 * i];
#pragma unroll 2
          for (int l = 0; l < 64; ++l) { const float xs = X[l * TS + p] * dtv[l] * __expf(a63 - acum[l]);
#pragma unroll
            for (int i = 0; i < 16; ++i) o[i] += xs * Bm[l * TS2 + n0 + 8 * i]; }
#pragma unroll
          for (int i = 0; i < 16; ++i) St[p * TS2 + n0 + 8 * i] = o[i]; }
        __syncthreads();
    }
}

__device__ __forceinline__ void rwkv_gate_rows(const Args& args, Frame& F) {
    const int gw = F.vcu * NWAVES + F.wave, NGW = F.G * NWAVES, lane = F.lane;
    bf16* Yo = (bf16*)((unsigned char*)F.out + WS_YRWKV_OUT); const bf16* Gb = (const bf16*)(F.ws + WS_RKVG) + (size_t)3 * M * 1024;
    f32x4 mg[4];
#pragma unroll
    for (int j = 0; j < 4; ++j) mg[j] = *(const GAS f32x4*)(args.in[10] + 3072 + lane * 16 + 4 * j);
    for (int m = gw; m < M; m += NGW) {
        GAS v4u* up = (GAS v4u*)(Yo + (size_t)m * 1024 + lane * 16); const GAS v4u* gp = (const GAS v4u*)(Gb + (size_t)m * 1024 + lane * 16);
#define LD16_SC1(p) ({ const unsigned long long a_ = __hip_atomic_load((const GAS unsigned long long*)(p), __ATOMIC_RELAXED, __HIP_MEMORY_SCOPE_AGENT), b_ = __hip_atomic_load((const GAS unsigned long long*)(p) + 1, __ATOMIC_RELAXED, __HIP_MEMORY_SCOPE_AGENT); \
        v4u r_; r_.x = (unsigned)a_; r_.y = (unsigned)(a_ >> 32); r_.z = (unsigned)b_; r_.w = (unsigned)(b_ >> 32); r_; })
        const v4u u0 = LD16_SC1(up), u1 = LD16_SC1(up + 1), g0 = LD16_SC1(gp), g1 = LD16_SC1(gp + 1); v4u p0 = (v4u){0u, 0u, 0u, 0u}, p1 = p0;
        if ((m & (SEQ - 1)) != 0) { p0 = LD16_SC1(gp - 128); p1 = LD16_SC1(gp - 127); }
        v4u o0, o1;
#pragma unroll
        for (int e = 0; e < 4; ++e) {
            { const float gl = bf_lo_(g0[e]), gh = bf_hi_(g0[e]), pl = bf_lo_(p0[e]), ph = bf_hi_(p0[e]); const float ml = mg[e >> 1][(2 * e) & 3], mh = mg[e >> 1][(2 * e + 1) & 3];
              o0[e] = pk2(bf_lo_(u0[e]) * siluf_(gl + ml * (pl - gl)), bf_hi_(u0[e]) * siluf_(gh + mh * (ph - gh))); }
            { const float gl = bf_lo_(g1[e]), gh = bf_hi_(g1[e]), pl = bf_lo_(p1[e]), ph = bf_hi_(p1[e]); const float ml = mg[2 + (e >> 1)][(2 * e) & 3], mh = mg[2 + (e >> 1)][(2 * e + 1) & 3];
              o1[e] = pk2(bf_lo_(u1[e]) * siluf_(gl + ml * (pl - gl)), bf_hi_(u1[e]) * siluf_(gh + mh * (ph - gh))); } }
        up[0] = o0; up[1] = o1;
    }
}
__device__ __forceinline__ void ssd_conv_unit(const Args& args, Frame& F, int wu, bool dry = false) {
    const int lane = F.lane, q = lane & 7, rgp = lane >> 3;
    const int bc = wu / 48, slab = wu - bc * 48, c = bc & 63;
    const int row0 = bc * 64, ch0 = slab * 64 + q * 8;
    bf16* XBC = (bf16*)(F.ws + WS_XBC); const bf16* HALOX = (const bf16*)(F.ws + WS_HALOX);
    const float* conv_w = args.in[4]; const float* conv_b = args.in[5];
    v4u raw[11];
#pragma unroll
    for (int i = 0; i < 11; ++i) { const int l = rgp * 8 - 3 + i;
        if (l >= 0) raw[i] = *(const GAS v4u*)(XBC + (size_t)(row0 + l) * 3072 + ch0);
        else if (c > 0) raw[i] = *(const GAS v4u*)(HALOX + ((size_t)(bc - 1) * 3 + (3 + l)) * 3072 + ch0);
        else raw[i] = (v4u){0u, 0u, 0u, 0u}; }
    float wt[4][8], bs[8];
#pragma unroll
    for (int j = 0; j < 4; ++j) { const f32x4 a = *(const GAS f32x4*)(conv_w + j * 3072 + ch0), b = *(const GAS f32x4*)(conv_w + j * 3072 + ch0 + 4);
        wt[j][0] = a.x; wt[j][1] = a.y; wt[j][2] = a.z; wt[j][3] = a.w; wt[j][4] = b.x; wt[j][5] = b.y; wt[j][6] = b.z; wt[j][7] = b.w; }
    { const f32x4 a = *(const GAS f32x4*)(conv_b + ch0), b = *(const GAS f32x4*)(conv_b + ch0 + 4); bs[0] = a.x; bs[1] = a.y; bs[2] = a.z; bs[3] = a.w; bs[4] = b.x; bs[5] = b.y; bs[6] = b.z; bs[7] = b.w; }
    asm volatile("s_waitcnt vmcnt(0)" ::: "memory");
    float o[8][8];
#pragma unroll
    for (int r = 0; r < 8; ++r)
#pragma unroll
        for (int e = 0; e < 8; ++e) { float a = bs[e];
#pragma unroll
            for (int j = 0; j < 4; ++j) { const unsigned w = raw[r + j][e >> 1]; const float v = (e & 1) ? __builtin_bit_cast(float, w & 0xffff0000u) : __builtin_bit_cast(float, w << 16); a += wt[j][e] * v; }
            o[r][e] = siluf_(a); }
    if (dry) { asm volatile("" :: "v"(o[0][0]), "v"(o[7][7]), "v"(o[3][4])); return; }
    if (slab < 32) {
#pragma unroll
        for (int e = 0; e < 8; ++e) { v4u w; w.x = pk2(o[0][e], o[1][e]); w.y = pk2(o[2][e], o[3][e]); w.z = pk2(o[4][e], o[5][e]); w.w = pk2(o[6][e], o[7][e]);
            *(GAS v4u*)(XBC + (size_t)(row0 + q * 8 + e) * 3072 + slab * 64 + rgp * 8) = w; }
    } else {
#pragma unroll
        for (int r = 0; r < 8; ++r) { v4u w; w.x = pk2(o[r][0], o[r][1]); w.y = pk2(o[r][2], o[r][3]); w.z = pk2(o[r][4], o[r][5]); w.w = pk2(o[r][6], o[r][7]);
            *(GAS v4u*)(XBC + (size_t)(row0 + rgp * 8 + r) * 3072 + ch0) = w; }
        if (slab < 40) { bf16* BT = (bf16*)(F.ws + WS_BT); const int g = (slab - 32) >> 1, n0 = ((slab - 32) & 1) * 64 + q * 8;
#pragma unroll
            for (int e = 0; e < 8; ++e) { v4u w; w.x = pk2(o[0][e], o[1][e]); w.y = pk2(o[2][e], o[3][e]); w.z = pk2(o[4][e], o[5][e]); w.w = pk2(o[6][e], o[7][e]);
                *(GAS v4u*)(BT + ((size_t)(bc * 4 + g) * 128 + n0 + e) * 64 + rgp * 8) = w; } }
    }
}

#define L256(base, row, ch) ((base) + (row) * 256 + ((((ch) ^ ((row) & 15))) << 4))
#define L128(base, row, ch) ((base) + (row) * 128 + ((((ch) ^ ((row) & 7))) << 4))
constexpr int SS_CM = 0, SS_BM = 16384, SS_BT = 32768, SS_XT = 49152, SS_XW = 57344, SS_MM = 65536, SS_STB = 73728, SS_SC = 90112;
struct SsdStage { v4u rC[2], rB[2], rT[2], rX; float rdt; };
struct SsdCtx { const bf16* XBC; const bf16* BT; bf16* Zb; const float* SMALL; float* SSQ; float dtb, Aneg, Dsk; int hd, b, g; int cmrow0, cmrow1, cmch, btrow0, btrow1, btch, xtrow, xtch; };
__device__ __forceinline__ void ssd_stage_load(const SsdCtx& X, SsdStage& S, int cc, int tid) {
    const int row0_ = X.b * SEQ + cc * 64;
    S.rC[0] = *(const GAS v4u*)(X.XBC + (size_t)(row0_ + X.cmrow0) * 3072 + 2560 + X.g * 128 + X.cmch * 8); S.rC[1] = *(const GAS v4u*)(X.XBC + (size_t)(row0_ + X.cmrow1) * 3072 + 2560 + X.g * 128 + X.cmch * 8);
    S.rB[0] = *(const GAS v4u*)(X.XBC + (size_t)(row0_ + X.cmrow0) * 3072 + 2048 + X.g * 128 + X.cmch * 8); S.rB[1] = *(const GAS v4u*)(X.XBC + (size_t)(row0_ + X.cmrow1) * 3072 + 2048 + X.g * 128 + X.cmch * 8);
    S.rT[0] = *(const GAS v4u*)(X.BT + ((size_t)((row0_ >> 6) * 4 + X.g) * 128 + X.btrow0) * 64 + X.btch * 8); S.rT[1] = *(const GAS v4u*)(X.BT + ((size_t)((row0_ >> 6) * 4 + X.g) * 128 + X.btrow1) * 64 + X.btch * 8);
    S.rX = *(const GAS v4u*)(X.XBC + (size_t)(row0_ + X.xtrow) * 3072 + X.hd * 64 + X.xtch * 8);
    if (tid < 64) S.rdt = X.SMALL[(size_t)(row0_ + tid) * 256 + X.hd];
}
__device__ __forceinline__ void ssd_chunk(const SsdCtx& X, SsdStage& S, int c, LAS unsigned char* lds, f32x4 (&accS)[4], int tid, int lane, int w, bool dry) {
    LAS float* dtv = (LAS float*)(lds + SS_SC); LAS float* acum = dtv + 64; LAS float* scl = acum + 64;
    const int q = lane >> 4, r16 = lane & 15; const int hd = X.hd; const int row0 = X.b * SEQ + c * 64;
    *(LAS v4u*)(lds + L256(SS_CM, X.cmrow0, X.cmch)) = S.rC[0]; *(LAS v4u*)(lds + L256(SS_CM, X.cmrow1, X.cmch)) = S.rC[1];
    *(LAS v4u*)(lds + L256(SS_BM, X.cmrow0, X.cmch)) = S.rB[0]; *(LAS v4u*)(lds + L256(SS_BM, X.cmrow1, X.cmch)) = S.rB[1];
    *(LAS v4u*)(lds + L128(SS_BT, X.btrow0, X.btch)) = S.rT[0]; *(LAS v4u*)(lds + L128(SS_BT, X.btrow1, X.btch)) = S.rT[1];
    *(LAS v4u*)(lds + L128(SS_XT, X.xtrow, X.xtch)) = S.rX;
    if (w == 0) { const float dt = softplusf_(S.rdt + X.dtb); float a = dt * X.Aneg;
#pragma unroll
        for (int off = 1; off < 64; off <<= 1) { const float t = __shfl_up(a, off); if (lane >= off) a += t; }
        const float a63 = __shfl(a, 63); dtv[lane] = dt; acum[lane] = a; scl[lane] = dt * __expf(a63 - a); }
    LDS_BARRIER();
    if (c + 2 < NCHUNK) ssd_stage_load(X, S, c + 2, tid);
    { const int sb = w >> 1, s0 = 16 * sb;
#pragma unroll
      for (int t = 0; t < 2; ++t) { const int lb = 2 * (w & 1) + t, l0 = 16 * lb; f32x4 acc = (f32x4){0.f, 0.f, 0.f, 0.f};
        if (sb <= lb) {
#pragma unroll
            for (int ks = 0; ks < 4; ++ks) { const bf16x8 a = *(const LAS bf16x8*)(lds + L256(SS_BM, s0 + r16, 4 * ks + q)); const bf16x8 bb = *(const LAS bf16x8*)(lds + L256(SS_CM, l0 + r16, 4 * ks + q));
                acc = __builtin_amdgcn_mfma_f32_16x16x32_bf16(a, bb, acc, 0, 0, 0); } }
        const int l = l0 + r16; const float al = acum[l]; float v[4];
#pragma unroll
        for (int e = 0; e < 4; ++e) { const int s = s0 + 4 * q + e; v[e] = (s <= l) ? acc[e] * __expf(fminf(al - acum[s], 0.f)) * dtv[s] : 0.f; }
        u32x2_t pk; pk.x = pk2(v[0], v[1]); pk.y = pk2(v[2], v[3]);
        *(LAS u32x2_t*)(lds + L128(SS_MM, l, 2 * sb + (q >> 1)) + (q & 1) * 8) = pk; } }
    { const v4u xv = *(const LAS v4u*)(lds + L128(SS_XT, X.xtrow, X.xtch)); v4u o;
#pragma unroll
      for (int e = 0; e < 4; ++e) { const unsigned ww = xv[e]; const float lo = __builtin_bit_cast(float, ww << 16) * scl[X.xtch * 8 + 2 * e], hi = __builtin_bit_cast(float, ww & 0xffff0000u) * scl[X.xtch * 8 + 2 * e + 1]; o[e] = pk2(lo, hi); }
      *(LAS v4u*)(lds + L128(SS_XW, X.xtrow, X.xtch)) = o; }
    LDS_BARRIER();
    { const int lb = w >> 1, l0 = 16 * lb, l = l0 + r16; const float el = __expf(acum[l]); float ss = 0.f;
#pragma unroll
      for (int t = 0; t < 2; ++t) { const int pb = 2 * (w & 1) + t, p0 = 16 * pb; f32x4 a1 = (f32x4){0.f, 0.f, 0.f, 0.f}, a2 = (f32x4){0.f, 0.f, 0.f, 0.f};
#pragma unroll
        for (int ks = 0; ks < 2; ++ks) { const bf16x8 a = *(const LAS bf16x8*)(lds + L128(SS_XT, p0 + r16, 4 * ks + q)); const bf16x8 bb = *(const LAS bf16x8*)(lds + L128(SS_MM, l0 + r16, 4 * ks + q));
            a1 = __builtin_amdgcn_mfma_f32_16x16x32_bf16(a, bb, a1, 0, 0, 0); }
#pragma unroll
        for (int ks = 0; ks < 4; ++ks) { const bf16x8 a = *(const LAS bf16x8*)(lds + L256(SS_STB, p0 + r16, 4 * ks + q)); const bf16x8 bb = *(const LAS bf16x8*)(lds + L256(SS_CM, l0 + r16, 4 * ks + q));
            a2 = __builtin_amdgcn_mfma_f32_16x16x32_bf16(a, bb, a2, 0, 0, 0); }
        bf16* zp = X.Zb + (size_t)(row0 + l) * 2048 + hd * 64 + p0 + 4 * q; const u32x2_t zz = *(const GAS u32x2_t*)zp; float yv[4];
#pragma unroll
        for (int e = 0; e < 4; ++e) { const int p = p0 + 4 * q + e; const float xlp = bf2f(*(const LAS bf16*)(lds + L128(SS_XT, p, l >> 3) + (l & 7) * 2));
            const unsigned zw = zz[e >> 1]; const float z = (e & 1) ? __builtin_bit_cast(float, zw & 0xffff0000u) : __builtin_bit_cast(float, zw << 16);
            const float y = (a1[e] + el * a2[e] + X.Dsk * xlp) * siluf_(z); yv[e] = y; ss += y * y; }
        u32x2_t pk; pk.x = pk2(yv[0], yv[1]); pk.y = pk2(yv[2], yv[3]); if (!dry) *(GAS u32x2_t*)zp = pk; }
      ss += __shfl_xor(ss, 16); ss += __shfl_xor(ss, 32);
      if (q == 0 && !dry) X.SSQ[(size_t)(row0 + l) * 64 + hd * 2 + (w & 1)] = ss; }
    { const float dec = __expf(acum[63]); const int n0 = 16 * w;
#pragma unroll
      for (int pb = 0; pb < 4; ++pb) { accS[pb] = accS[pb] * dec;
#pragma unroll
        for (int ks = 0; ks < 2; ++ks) { const bf16x8 a = *(const LAS bf16x8*)(lds + L128(SS_BT, n0 + r16, 4 * ks + q)); const bf16x8 bb = *(const LAS bf16x8*)(lds + L128(SS_XW, 16 * pb + r16, 4 * ks + q));
            accS[pb] = __builtin_amdgcn_mfma_f32_16x16x32_bf16(a, bb, accS[pb], 0, 0, 0); } } }
    LDS_BARRIER();
#pragma unroll
    for (int pb = 0; pb < 4; ++pb) { u32x2_t pk; pk.x = pk2(accS[pb][0], accS[pb][1]); pk.y = pk2(accS[pb][2], accS[pb][3]);
        *(LAS u32x2_t*)(lds + L256(SS_STB, 16 * pb + r16, 2 * w + (q >> 1)) + (q & 1) * 8) = pk; }
}
__device__ __forceinline__ void ssd_scan_mfma(const Args& args, Frame& F, int unit, bool dry = false) {
    LAS unsigned char* lds = F.lds;
    const int tid = F.tid, lane = F.lane, w = F.wave;
    SsdCtx X;
    X.hd = unit & 31; X.b = unit >> 5; X.g = X.hd >> 3;
    X.XBC = (const bf16*)(F.ws + WS_XBC); X.BT = (const bf16*)(F.ws + WS_BT); X.Zb = (bf16*)(F.ws + WS_Z); X.SMALL = (const float*)(F.ws + WS_SMALL); X.SSQ = (float*)(F.ws + WS_SSQ);
    X.dtb = args.in[6][X.hd]; X.Aneg = -__expf(args.in[7][X.hd]); X.Dsk = args.in[8][X.hd];
    X.cmrow0 = tid >> 4; X.cmrow1 = (tid + 512) >> 4; X.cmch = tid & 15; X.btrow0 = tid >> 3; X.btrow1 = (tid + 512) >> 3; X.btch = tid & 7; X.xtrow = tid >> 3; X.xtch = tid & 7;
    for (int i = tid; i < 16384 / 16; i += 512) *(LAS v4u*)(lds + SS_STB + i * 16) = (v4u){0u, 0u, 0u, 0u};
    f32x4 accS[4];
#pragma unroll
    for (int i = 0; i < 4; ++i) accS[i] = (f32x4){0.f, 0.f, 0.f, 0.f};
    SsdStage SA, SB_; SA.rdt = 0.f; SB_.rdt = 0.f;
    ssd_stage_load(X, SA, 0, tid); ssd_stage_load(X, SB_, 1, tid);
    for (int c = 0; c < NCHUNK; c += 2) { ssd_chunk(X, SA, c, lds, accS, tid, lane, w, dry); ssd_chunk(X, SB_, c + 1, lds, accS, tid, lane, w, dry); }
    LDS_BARRIER();
}

__device__ __forceinline__ void ssd_norm_rows(const Args& args, Frame& F) {
    const int gw = F.vcu * NWAVES + F.wave, NGW = F.G * NWAVES;
    bf16* Zb = (bf16*)(F.ws + WS_Z); const float* SSQ = (const float*)(F.ws + WS_SSQ); const float* gain = args.in[9];
    for (int m = gw; m < M; m += NGW) {
        const int grp = F.lane >> 4; float ss = 0.f;
#pragma unroll
        for (int j = 0; j < 16; ++j) ss += SSQ[(size_t)m * 64 + grp * 16 + j];
        const float rstd = 1.f / sqrtf(ss * (1.f / 512.f) + EPS);
        GAS v4u* p = (GAS v4u*)(Zb + (size_t)m * 2048 + F.lane * 32);
#pragma unroll
        for (int q = 0; q < 4; ++q) { v4u w = p[q]; const float* gp = gain + F.lane * 32 + q * 8; unsigned o[4];
#pragma unroll
            for (int e = 0; e < 4; ++e) { const unsigned ww = w[e]; const float lo = __builtin_bit_cast(float, ww << 16) * rstd * gp[2 * e], hi = __builtin_bit_cast(float, ww & 0xffff0000u) * rstd * gp[2 * e + 1]; o[e] = pk2(lo, hi); }
            v4u ov; ov.x = o[0]; ov.y = o[1]; ov.z = o[2]; ov.w = o[3]; p[q] = ov; }
    }
}
__device__ __forceinline__ void final_norm_rows(const Args& args, Frame& F) {
    const int gw = F.vcu * NWAVES + F.wave, NGW = F.G * NWAVES;
    const float* x = args.in[0]; const float* pg = args.in[23];
    f32x4 gv[4];
#pragma unroll
    for (int j = 0; j < 4; ++j) gv[j] = ((const GAS f32x4*)pg)[F.lane + 64 * j];
    for (int m = gw; m < M; m += NGW) {
        GAS f32x4* orow = (GAS f32x4*)(F.out + (size_t)m * D) + F.lane; const GAS f32x4* xr = (const GAS f32x4*)(x + (size_t)m * D) + F.lane;
        f32x4 v[4]; float s = 0.f;
#pragma unroll
        for (int j = 0; j < 4; ++j) { v[j] = orow[64 * j]; s += (v[j].x * v[j].x + v[j].y * v[j].y) + (v[j].z * v[j].z + v[j].w * v[j].w); }
        const float rstd = 1.f / sqrtf(wave_sum(s) * (1.f / D) + EPS);
#pragma unroll
        for (int j = 0; j < 4; ++j) orow[64 * j] = xr[64 * j] + v[j] * rstd * gv[j];
    }
}

#ifndef SSD_SIMPLE
#define SSD_SIMPLE 0
#endif
__global__ void __launch_bounds__(NWAVES * 64, 2) hybrid_fwd(Args args) {
    extern __shared__ __attribute__((aligned(16))) unsigned char lds[];
    Frame F;
    F.lds = (LAS unsigned char*)lds;
    F.MISC = (volatile LAS unsigned*)(F.lds + MISC_OFF);
    F.tid = threadIdx.x; F.lane = F.tid & 63; F.wave = __builtin_amdgcn_readfirstlane(F.tid >> 6);
    F.G = gridDim.x; { const int bx = blockIdx.x; F.vcu = (F.G % 8 == 0) ? (bx % 8) * (F.G / 8) + bx / 8 : bx; }
    F.out = args.out; F.ws = args.ws;
    F.ctl = (gu32*)(F.ws + WS_CTL);
    for (int u = F.tid; u < (LDS_BYTES - LDSCTL_OFF) / 4; u += NWAVES * 64) ((LAS unsigned*)(F.lds + LDSCTL_OFF))[u] = 0u;
    __syncthreads();
    XcdBarrier bar; bar.bar = (unsigned*)(F.ctl + CW_BAR); bar.x = 0; bar.st = nullptr;
    if (N_LAUNCHES == 1) bar = xcd_barrier_post((unsigned*)(F.ctl + CW_BAR), F.MISC + 8);
#define GRID_BAR() do { if (N_LAUNCHES == 1) xcd_barrier(bar); } while (0)
    const int lo = args.ph_lo, hi = args.ph_hi;
#ifndef PH_MASK
#define PH_MASK 0x1FFF
#endif
#define IN(k) ((((PH_MASK) >> (k)) & 1) && lo <= (k) && (k) < hi)
#define BOTH(k) (IN(k) && IN((k) + 1))
#ifndef REP_MASK
#define REP_MASK 0
#endif
#define REP(k) (((REP_MASK) >> (k)) & 1)
    bf16* Win_t = (bf16*)(F.ws + WS_WIN);
    bf16* Hb = (bf16*)F.out;

    if (IN(0)) { p0_prologue(args, F); if (REP(0)) { GRID_BAR(); p0_prologue(args, F); } if (BOTH(0)) GRID_BAR(); }
    if (IN(1)) {
      for (int rep = 0; rep < (REP(1) ? 2 : 1); ++rep) {
        pg8::Gemm g{Hb, Win_t, M, NT_RW * 256, D}; pg8::StaticOrder S; S.init(M, NT_RW * 256, F.G, (int)blockIdx.x);
        pg8::EpiRW E{(bf16*)(F.ws + WS_RKVG), (bf16*)(F.ws + WS_HALO), (float*)(F.ws + WS_SMALL), M};
        pg8::gemm_phase<pg8::EpiRW, pg8::StaticOrder, PG8_ALIGN, PG8_SP2>(F.lds + RING_OFF, g, S, E);
        if (rep == 0 && REP(1)) GRID_BAR(); }
        if (BOTH(1)) GRID_BAR();
    }
    if (IN(2)) { if (REP(2)) { for (int u = F.vcu; u < NB * NCHUNK * 16; u += F.G) rwkv_local_simple(args, F, u, true); GRID_BAR(); }
                 for (int u = F.vcu; u < NB * NCHUNK * 16; u += F.G) rwkv_local_simple(args, F, u, false); if (BOTH(2)) GRID_BAR(); }
#ifndef SCAN_VAR
#define SCAN_VAR 1
#endif
    if (IN(3)) { if (REP(3)) { for (int u = (int)blockIdx.x; u < NB * 16; u += F.G) rwkv_scan_mfma<SCAN_VAR>(args, F, u); GRID_BAR(); }
                 for (int u = (int)blockIdx.x; u < NB * 16; u += F.G) rwkv_scan_mfma<0>(args, F, u); if (BOTH(3)) GRID_BAR(); }
    if (IN(4)) {
      for (int rep = 0; rep < (REP(4) ? 2 : 1); ++rep) {
        pg8::Gemm g{Hb, Win_t + (size_t)NT_RW * 256 * D, M, NT_SSD * 256, D}; pg8::StaticOrder S; S.init(M, NT_SSD * 256, F.G, (int)blockIdx.x);
        pg8::EpiSSD E{(bf16*)(F.ws + WS_Z), (bf16*)(F.ws + WS_XBC), (bf16*)(F.ws + WS_HALOX)};
        pg8::gemm_phase<pg8::EpiSSD, pg8::StaticOrder, PG8_ALIGN, PG8_SP2>(F.lds + RING_OFF, g, S, E);
        if (rep == 0 && REP(4)) GRID_BAR(); }
        if (BOTH(4)) GRID_BAR();
    }
#if SSD_SIMPLE
    if (IN(5)) { if (BOTH(5)) GRID_BAR(); }
    if (IN(6)) { for (int u = F.vcu; u < NB * 32; u += F.G) ssd_scan_simple(args, F, u); if (BOTH(6)) GRID_BAR(); }
#else
    if (IN(5)) { if (REP(5)) { for (int wu = F.vcu * NWAVES + F.wave; wu < NB * NCHUNK * 48; wu += F.G * NWAVES) ssd_conv_unit(args, F, wu, true); GRID_BAR(); }
                 for (int wu = F.vcu * NWAVES + F.wave; wu < NB * NCHUNK * 48; wu += F.G * NWAVES) ssd_conv_unit(args, F, wu, false);
                 rwkv_gate_rows(args, F); if (BOTH(5)) GRID_BAR(); }
    if (IN(6)) { if (REP(6)) { for (int u = (int)blockIdx.x; u < NB * 32; u += F.G) ssd_scan_mfma(args, F, u, true); GRID_BAR(); }
                 for (int u = (int)blockIdx.x; u < NB * 32; u += F.G) ssd_scan_mfma(args, F, u, false); if (BOTH(6)) GRID_BAR(); }
#endif
    if (IN(7)) { ssd_norm_rows(args, F); if (BOTH(7)) GRID_BAR(); }
    if (IN(8)) {
      for (int rep = 0; rep < (REP(8) ? 2 : 1); ++rep) {
        pg8::Gemm g{Hb, Win_t + (size_t)(NT_RW + NT_SSD) * 256 * D, M, NT_GATE * 256, D}; pg8::StaticOrder S; S.init(M, NT_GATE * 256, F.G, (int)blockIdx.x);
        pg8::EpiGate E{(bf16*)(F.ws + WS_GATES), args.in[3]};
        pg8::gemm_phase<pg8::EpiGate, pg8::StaticOrder, PG8_ALIGN, PG8_SP2>(F.lds + RING_OFF, g, S, E);
        if (rep == 0 && REP(8)) GRID_BAR(); }
        if (BOTH(8)) GRID_BAR();
    }
    if (IN(9)) {
      for (int rep = 0; rep < (REP(9) ? 2 : 1); ++rep) {
        pg8::Gemm g{(const bf16*)(F.ws + WS_Z), (const bf16*)(F.ws + WS_WSSM), M, D, 2048}; pg8::StaticOrder S; S.init(M, D, F.G, (int)blockIdx.x);
        pg8::EpiT1 E{(float*)(F.ws + WS_T1), (const bf16*)(F.ws + WS_GATES)};
        pg8::gemm_phase<pg8::EpiT1, pg8::StaticOrder, PG8_ALIGN, PG8_SP2>(F.lds + RING_OFF, g, S, E);
        if (rep == 0 && REP(9)) GRID_BAR(); }
        if (BOTH(9)) GRID_BAR();
    }
    if (IN(10)) {
      for (int rep = 0; rep < (REP(10) ? 2 : 1); ++rep) {
        pg8::Gemm g{(const bf16*)((const unsigned char*)F.out + WS_YRWKV_OUT), (const bf16*)(F.ws + WS_WRWKV), M, D, D}; pg8::StaticOrder S; S.init(M, D, F.G, (int)blockIdx.x);
        pg8::EpiMerge E{(bf16*)(F.ws + WS_MERGED), (const float*)(F.ws + WS_T1), (const bf16*)(F.ws + WS_GATES)};
        pg8::gemm_phase<pg8::EpiMerge, pg8::StaticOrder, PG8_ALIGN, PG8_SP2>(F.lds + RING_OFF, g, S, E);
        if (rep == 0 && REP(10)) GRID_BAR(); }
        if (BOTH(10)) GRID_BAR();
    }
    if (IN(11)) {
      for (int rep = 0; rep < (REP(11) ? 2 : 1); ++rep) {
        pg8::Gemm g{(const bf16*)(F.ws + WS_MERGED), (const bf16*)(F.ws + WS_WOUT), M, D, D}; pg8::StaticOrder S; S.init(M, D, F.G, (int)blockIdx.x);
        pg8::EpiF32 E{F.out, D};
        pg8::gemm_phase<pg8::EpiF32, pg8::StaticOrder, PG8_ALIGN, PG8_SP2>(F.lds + RING_OFF, g, S, E);
        if (rep == 0 && REP(11)) GRID_BAR(); }
        if (BOTH(11)) GRID_BAR();
    }
    if (IN(12)) { final_norm_rows(args, F); }
#undef IN
#undef BOTH
}

extern "C" void kernel_launch(void* const* d_in, const int* in_sizes, int n_in, void* d_out, int out_size, void* d_ws, size_t ws_size, hipStream_t stream) {
    static int grid = 0;
    if (grid == 0) {
        if (n_in != 24 || in_sizes[0] != M * D || out_size != M * D || ws_size < WS_END) { fprintf(stderr, "kernel_launch: unexpected shapes (n_in %d, in0 %d, out %d, ws %zu)\n", n_in, n_in > 0 ? in_sizes[0] : -1, out_size, ws_size); grid = -1; return; }
        int dev = 0, cus = 0;
        if (hipGetDevice(&dev) != hipSuccess || hipDeviceGetAttribute(&cus, hipDeviceAttributeMultiprocessorCount, dev) != hipSuccess) { grid = -1; return; }
        if (hipFuncSetAttribute((const void*)hybrid_fwd, hipFuncAttributeMaxDynamicSharedMemorySize, LDS_BYTES) != hipSuccess) { fprintf(stderr, "kernel_launch: hipFuncSetAttribute failed\n"); grid = -1; return; }
        (void)hipGetLastError();
        grid = cus;
    }
    if (grid < 0) return;
    if (hipMemsetAsync((char*)d_ws + WS_CTL, 0, CTL_ZERO_BYTES, stream) != hipSuccess) return;
    Args a{};
    for (int i = 0; i < 24; ++i) a.in[i] = (const float*)d_in[i];
    a.out = (float*)d_out; a.ws = (unsigned char*)d_ws;
    for (int li = 0; li < N_LAUNCHES; ++li) {
        if (N_LAUNCHES == 1) { a.ph_lo = 0; a.ph_hi = N_PHASES; } else { a.ph_lo = li; a.ph_hi = li + 1; }
        a.li = li;
        hipLaunchKernelGGL(hybrid_fwd, dim3(grid), dim3(NWAVES * 64), LDS_BYTES, stream, a);
    }
}
```

```cpp
#include <hip/hip_runtime.h>
#include <cstdio>
#include <cstdint>
#define MK_N_LAUNCHES 1
#define REP_MASK 0
#define SCAN_VAR 1
namespace pg8 {
#define PG8_LAS __attribute__((address_space(3)))
typedef unsigned short bf16_t;
typedef short bf16x8 __attribute__((ext_vector_type(8)));
typedef float f32x4 __attribute__((ext_vector_type(4)));
typedef unsigned u32x4 __attribute__((ext_vector_type(4)));
constexpr int BM = 256, BK = 64, HALF = 128, HTB = HALF * BK * 2  , STAGE_BYTES = 8 * HTB, NXCD = 8, WGM = 8;

__host__ __device__ __forceinline__ int lds_byte(int r, int c) { const int st = (r >> 4) * 2 + (c >> 5), rr = r & 15, cc = c & 31, ob = rr * 64 + cc * 2; return st * 1024 + (ob ^ (((ob >> 9) & 1) << 5)); }
__host__ __device__ __forceinline__ void stage_rc(int b, int& R, int& C) { const int st = b / 1024, sb = b % 1024, swz = sb ^ (((sb >> 9) & 1) << 5); R = (st >> 1) * 16 + swz / 64; C = (st & 1) * 32 + (swz % 64) / 2; }
__host__ __device__ __forceinline__ int perm32(int rho) { const int n = rho >> 4, i = rho & 15; return 8 * (i >> 2) + 4 * n + (i & 3); }

struct Unit { int pm, pn; };
struct Gemm { const bf16_t* A; const bf16_t* Bt; int M, N, K; };

struct StaticOrder {
    int nM, nN, nwg, G, c;
    __host__ __device__ void init(int M, int N, int G_, int c_) { nM = M / BM; nN = N / BM; nwg = nM * nN; G = G_; c = c_; }
    __host__ __device__ bool next(int i, Unit& u) const {
        const long L = (long)i * G + c; if (L >= nwg) return false;
        int wgid = (int)L; { const int q = nwg / NXCD, r = nwg % NXCD, xcd = wgid % NXCD, off = wgid / NXCD; wgid = (xcd < r ? xcd * (q + 1) : r * (q + 1) + (xcd - r) * q) + off; }
        const int nig = WGM * nN, gid = wgid / nig, fm = gid * WGM, gsz = (nM - fm) < WGM ? (nM - fm) : WGM;
        u.pm = fm + ((wgid % nig) % gsz); u.pn = (wgid % nig) / gsz; return true;
    }
    __device__ __forceinline__ void a_ready(const Unit&) const {}
    __device__ __forceinline__ void done(const Unit&) const {}
};

__device__ __forceinline__ unsigned cvt_pk_bf16(float lo, float hi) { unsigned r; asm volatile("v_cvt_pk_bf16_f32 %0, %1, %2" : "=v"(r) : "v"(lo), "v"(hi)); return r; }
__device__ __forceinline__ float bf_lo(unsigned w) { return __builtin_bit_cast(float, w << 16); }
__device__ __forceinline__ float bf_hi(unsigned w) { return __builtin_bit_cast(float, w & 0xffff0000u); }
__device__ __forceinline__ float sigmoidf_(float x) { return 1.0f / (1.0f + __expf(-x)); }
typedef unsigned u32x2 __attribute__((ext_vector_type(2)));

struct EpiRW {
    static constexpr bool PERM = true, AFTER_DRAIN = false;
    bf16_t* RKVG; bf16_t* HALO; float* SMALL; int Mrows;
    __device__ __forceinline__ void operator()(const f32x4 (&acc)[2][2][4][2], const Unit& u, int wr, int wc, int fr, int fq) const {
        const int row0 = u.pm * BM + wr * 64 + fr;
        if (u.pn < 16) {
            bf16_t* base = RKVG + (size_t)(u.pn >> 2) * ((size_t)Mrows * 1024);
            const int col0 = (u.pn & 3) * 256 + wc * 32 + 8 * fq;
#pragma unroll
            for (int ai = 0; ai < 2; ++ai)
#pragma unroll
                for (int m = 0; m < 4; ++m) { const int row = row0 + ai * HALF + m * 16; bf16_t* rowp = base + (size_t)row * 1024 + col0;
#pragma unroll
                    for (int bj = 0; bj < 2; ++bj) { const f32x4 v0 = acc[ai][bj][m][0], v1 = acc[ai][bj][m][1];
                        u32x4 w; w.x = cvt_pk_bf16(v0[0], v0[1]); w.y = cvt_pk_bf16(v0[2], v0[3]); w.z = cvt_pk_bf16(v1[0], v1[1]); w.w = cvt_pk_bf16(v1[2], v1[3]);
                        *(u32x4*)(rowp + bj * HALF) = w;
                        if (m == 3 && fr == 15) *(u32x4*)(HALO + (size_t)(row >> 6) * 4096 + u.pn * 256 + wc * 32 + 8 * fq + bj * HALF) = w; } }
        } else {
            const int col0 = wc * 32 + 8 * fq;
#pragma unroll
            for (int ai = 0; ai < 2; ++ai)
#pragma unroll
                for (int m = 0; m < 4; ++m) { float* rowp = SMALL + (size_t)(row0 + ai * HALF + m * 16) * 256 + col0;
#pragma unroll
                    for (int bj = 0; bj < 2; ++bj) { *(f32x4*)(rowp + bj * HALF) = acc[ai][bj][m][0]; *(f32x4*)(rowp + bj * HALF + 4) = acc[ai][bj][m][1]; } }
        }
    }
};
struct EpiSSD {
    static constexpr bool PERM = true, AFTER_DRAIN = false;
    bf16_t* Z; bf16_t* XBC; bf16_t* HALOX;
    __device__ __forceinline__ void operator()(const f32x4 (&acc)[2][2][4][2], const Unit& u, int wr, int wc, int fr, int fq) const {
        const int row0 = u.pm * BM + wr * 64 + fr;
        bf16_t* base; int ldc, colt;
        if (u.pn < 8) { base = Z; ldc = 2048; colt = u.pn * 256; } else { base = XBC; ldc = 3072; colt = (u.pn - 8) * 256; }
        const int col0 = colt + wc * 32 + 8 * fq;
#pragma unroll
        for (int ai = 0; ai < 2; ++ai)
#pragma unroll
            for (int m = 0; m < 4; ++m) { bf16_t* rowp = base + (size_t)(row0 + ai * HALF + m * 16) * ldc + col0;
#pragma unroll
                for (int bj = 0; bj < 2; ++bj) { const f32x4 v0 = acc[ai][bj][m][0], v1 = acc[ai][bj][m][1];
                    u32x4 w; w.x = cvt_pk_bf16(v0[0], v0[1]); w.y = cvt_pk_bf16(v0[2], v0[3]); w.z = cvt_pk_bf16(v1[0], v1[1]); w.w = cvt_pk_bf16(v1[2], v1[3]);
                    *(u32x4*)(rowp + bj * HALF) = w;
                    if (m == 3 && fr >= 13 && u.pn >= 8) { const int row = row0 + ai * HALF + m * 16; *(u32x4*)(HALOX + ((size_t)(row >> 6) * 3 + (fr - 13)) * 3072 + col0 + bj * HALF) = w; } } }
    }
};
struct EpiGate {
    static constexpr bool PERM = true, AFTER_DRAIN = false;
    bf16_t* O; const float* bias;
    __device__ __forceinline__ void operator()(const f32x4 (&acc)[2][2][4][2], const Unit& u, int wr, int wc, int fr, int fq) const {
        const int row0 = u.pm * BM + wr * 64 + fr; const int col0 = u.pn * BM + wc * 32 + 8 * fq;
        f32x4 bv[2][2];
#pragma unroll
        for (int bj = 0; bj < 2; ++bj)
#pragma unroll
            for (int n = 0; n < 2; ++n) bv[bj][n] = *(const f32x4*)(bias + col0 + bj * HALF + 4 * n);
#pragma unroll
        for (int ai = 0; ai < 2; ++ai)
#pragma unroll
            for (int m = 0; m < 4; ++m) { bf16_t* rowp = O + (size_t)(row0 + ai * HALF + m * 16) * 2048 + col0;
#pragma unroll
                for (int bj = 0; bj < 2; ++bj) { f32x4 v0 = acc[ai][bj][m][0] + bv[bj][0], v1 = acc[ai][bj][m][1] + bv[bj][1];
#pragma unroll
                    for (int j = 0; j < 4; ++j) { v0[j] = sigmoidf_(v0[j]); v1[j] = sigmoidf_(v1[j]); }
                    u32x4 w; w.x = cvt_pk_bf16(v0[0], v0[1]); w.y = cvt_pk_bf16(v0[2], v0[3]); w.z = cvt_pk_bf16(v1[0], v1[1]); w.w = cvt_pk_bf16(v1[2], v1[3]);
                    *(u32x4*)(rowp + bj * HALF) = w; } }
    }
};
struct EpiT1 {
    static constexpr bool PERM = false, AFTER_DRAIN = false;
    float* T1; const bf16_t* GATES;
    __device__ __forceinline__ void operator()(const f32x4 (&acc)[2][2][4][2], const Unit& u, int wr, int wc, int fr, int fq) const {
        const int row0 = u.pm * BM + wr * 64 + fr, col0 = u.pn * BM + wc * 32 + 4 * fq;
#pragma unroll
        for (int ai = 0; ai < 2; ++ai)
#pragma unroll
            for (int m = 0; m < 4; ++m) { const size_t row = (size_t)(row0 + ai * HALF + m * 16);
#pragma unroll
                for (int bj = 0; bj < 2; ++bj)
#pragma unroll
                    for (int n = 0; n < 2; ++n) { const int c = col0 + bj * HALF + n * 16; const u32x2 g = *(const u32x2*)(GATES + row * 2048 + c);
                        f32x4 v = acc[ai][bj][m][n]; v[0] *= bf_lo(g.x); v[1] *= bf_hi(g.x); v[2] *= bf_lo(g.y); v[3] *= bf_hi(g.y);
                        *(f32x4*)(T1 + row * 1024 + c) = v; } }
    }
};
struct EpiMerge {
    static constexpr bool PERM = true, AFTER_DRAIN = false;
    bf16_t* O; const float* T1; const bf16_t* GATES;
    __device__ __forceinline__ void operator()(const f32x4 (&acc)[2][2][4][2], const Unit& u, int wr, int wc, int fr, int fq) const {
        const int row0 = u.pm * BM + wr * 64 + fr; const int col0 = u.pn * BM + wc * 32 + 8 * fq;
#pragma unroll
        for (int ai = 0; ai < 2; ++ai)
#pragma unroll
            for (int m = 0; m < 4; ++m) { const size_t row = (size_t)(row0 + ai * HALF + m * 16);
#pragma unroll
                for (int bj = 0; bj < 2; ++bj) { const int c = col0 + bj * HALF;
                    const u32x4 g = *(const u32x4*)(GATES + row * 2048 + 1024 + c);
                    const f32x4 t0 = *(const f32x4*)(T1 + row * 1024 + c), t1 = *(const f32x4*)(T1 + row * 1024 + c + 4);
                    f32x4 v0 = acc[ai][bj][m][0], v1 = acc[ai][bj][m][1];
                    v0[0] = t0[0] + bf_lo(g.x) * v0[0]; v0[1] = t0[1] + bf_hi(g.x) * v0[1]; v0[2] = t0[2] + bf_lo(g.y) * v0[2]; v0[3] = t0[3] + bf_hi(g.y) * v0[3];
                    v1[0] = t1[0] + bf_lo(g.z) * v1[0]; v1[1] = t1[1] + bf_hi(g.z) * v1[1]; v1[2] = t1[2] + bf_lo(g.w) * v1[2]; v1[3] = t1[3] + bf_hi(g.w) * v1[3];
                    u32x4 w; w.x = cvt_pk_bf16(v0[0], v0[1]); w.y = cvt_pk_bf16(v0[2], v0[3]); w.z = cvt_pk_bf16(v1[0], v1[1]); w.w = cvt_pk_bf16(v1[2], v1[3]);
                    *(u32x4*)(O + row * 1024 + c) = w; } }
    }
};
struct EpiF32 {
    static constexpr bool PERM = false, AFTER_DRAIN = false;
    float* C; int ldc;
    __device__ __forceinline__ void operator()(const f32x4 (&acc)[2][2][4][2], const Unit& u, int wr, int wc, int fr, int fq) const {
        const int row0 = u.pm * BM + wr * 64 + fr, col0 = u.pn * BM + wc * 32 + 4 * fq;
#pragma unroll
        for (int ai = 0; ai < 2; ++ai)
#pragma unroll
            for (int m = 0; m < 4; ++m) { float* rowp = C + (size_t)(row0 + ai * HALF + m * 16) * ldc + col0;
#pragma unroll
                for (int bj = 0; bj < 2; ++bj)
#pragma unroll
                    for (int n = 0; n < 2; ++n) *(f32x4*)(rowp + bj * HALF + n * 16) = acc[ai][bj][m][n]; }
    }
};

template <class Epi, class Sched, bool ALIGN_EPI = false, bool SP2 = false>
__device__ __forceinline__ void gemm_phase(PG8_LAS unsigned char* lds, const Gemm g, const Sched& S, const Epi& E) {
    const int tid = threadIdx.x, wid = __builtin_amdgcn_readfirstlane(tid >> 6), lane = tid & 63, wr = wid >> 2, wc = wid & 3, fr = lane & 15, fq = lane >> 4;
    const int K = g.K, nt = K / BK;
    unsigned voffA[2], voffB[2];
#pragma unroll
    for (int i = 0; i < 2; ++i) { int R, C; stage_rc(tid * 16 + i * 8192, R, C); const int Rb = Epi::PERM ? ((R & ~31) + perm32(R & 31)) : R;
        voffA[i] = (unsigned)(R * K + C) * 2u; voffB[i] = (unsigned)(Rb * K + C) * 2u; }
    const size_t kstep = (size_t)(BK * 2);
    const size_t hstep = (size_t)HALF * K * 2;
    const size_t tstep = 2 * hstep;
    const unsigned ldsw = (unsigned)wid * 1024u;
    const int aoff = lds_byte(wr * 64 + fr, fq * 8), boff = lds_byte(wc * 32 + fr, fq * 8);
#define PG8_SA(b, h) (((b) * 2 + (h)) * HTB)
#define PG8_SB(b, h) ((4 + (b) * 2 + (h)) * HTB)
#define PG8_STAGE(bufoff, gbase, voff) do { _Pragma("unroll") for (int _i = 0; _i < 2; ++_i) \
        __builtin_amdgcn_global_load_lds((const unsigned*)((const char*)(gbase) + (voff)[_i]), (PG8_LAS unsigned*)(lds + (bufoff) + ldsw + _i * 8192), 16, 0, 0); } while (0)
#define PG8_LDA(dst, b, h) do { _Pragma("unroll") for (int m = 0; m < 4; ++m) _Pragma("unroll") for (int k = 0; k < 2; ++k) dst[m][k] = *(const PG8_LAS bf16x8*)(lds + PG8_SA(b, h) + aoff + m * 2048 + k * 1024); } while (0)
#define PG8_LDB(dst, b, h) do { _Pragma("unroll") for (int n = 0; n < 2; ++n) _Pragma("unroll") for (int k = 0; k < 2; ++k) dst[n][k] = *(const PG8_LAS bf16x8*)(lds + PG8_SB(b, h) + boff + n * 2048 + k * 1024); } while (0)
#define PG8_MMA(ai, bj, At, Bt) do { __builtin_amdgcn_s_setprio(1); _Pragma("unroll") for (int m = 0; m < 4; ++m) _Pragma("unroll") for (int n = 0; n < 2; ++n) _Pragma("unroll") for (int k = 0; k < 2; ++k) \
        acc[ai][bj][m][n] = __builtin_amdgcn_mfma_f32_16x16x32_bf16(Bt[n][k], At[m][k], acc[ai][bj][m][n], 0, 0, 0); __builtin_amdgcn_s_setprio(0); } while (0)
#define PG8_WAIT_V(n) asm volatile("s_waitcnt vmcnt(" #n ")" ::: "memory")
#define PG8_WAIT_L(n) asm volatile("s_waitcnt lgkmcnt(" #n ")" ::: "memory")
#define PG8_BAR __builtin_amdgcn_s_barrier()
#define PG8_SCHED __builtin_amdgcn_sched_barrier(0)
    Unit cur, nxt; int ui = 0;
    if (!S.next(0, cur)) return;
    f32x4 acc[2][2][4][2];
#pragma unroll
    for (int a = 0; a < 2; ++a)
#pragma unroll
        for (int b = 0; b < 2; ++b)
#pragma unroll
            for (int m = 0; m < 4; ++m)
#pragma unroll
                for (int n = 0; n < 2; ++n) acc[a][b][m][n] = (f32x4){0.f, 0.f, 0.f, 0.f};
    bf16x8 At[4][2], B0[2][2], B1[2][2];
    const char* cA = (const char*)g.A + (size_t)cur.pm * tstep; const char* cB = (const char*)g.Bt + (size_t)cur.pn * tstep;
    S.a_ready(cur);
    if constexpr (SP2) {
        PG8_STAGE(PG8_SB(0, 0), cB, voffB); PG8_STAGE(PG8_SB(0, 1), cB + hstep, voffB); PG8_STAGE(PG8_SA(0, 0), cA, voffA); PG8_STAGE(PG8_SA(0, 1), cA + hstep, voffA);
        if (wr == 1) PG8_BAR;
        PG8_WAIT_V(2); PG8_BAR;
        PG8_STAGE(PG8_SB(1, 0), cB + kstep, voffB); PG8_STAGE(PG8_SA(1, 0), cA + kstep, voffA); PG8_STAGE(PG8_SB(1, 1), cB + hstep + kstep, voffB);
        PG8_WAIT_V(6); PG8_BAR;
    } else {
        PG8_STAGE(PG8_SB(0, 0), cB, voffB); PG8_STAGE(PG8_SA(0, 0), cA, voffA); PG8_STAGE(PG8_SB(0, 1), cB + hstep, voffB); PG8_STAGE(PG8_SA(0, 1), cA + hstep, voffA);
        if (wr == 1) PG8_BAR;
        PG8_WAIT_V(4); PG8_BAR;
        PG8_STAGE(PG8_SB(1, 0), cB + kstep, voffB); PG8_STAGE(PG8_SA(1, 0), cA + kstep, voffA); PG8_STAGE(PG8_SB(1, 1), cB + hstep + kstep, voffB);
        PG8_WAIT_V(6); PG8_BAR;
    }
    for (;;) {
        const bool has_next = S.next(ui + 1, nxt);
        const char* nA = has_next ? (const char*)g.A + (size_t)nxt.pm * tstep : cA; const char* nB = has_next ? (const char*)g.Bt + (size_t)nxt.pn * tstep : cB;
        for (int t = 0; t < nt; t += 2) {
            const bool last = (t == nt - 2);
            const char* a1 = cA + (size_t)(t + 1) * kstep;
            const char* a2 = last ? nA : cA + (size_t)(t + 2) * kstep; const char* b2 = last ? nB : cB + (size_t)(t + 2) * kstep;
            const char* a3 = a2 + kstep; const char* b3 = b2 + kstep;
            if (last && has_next) S.a_ready(nxt);
            if constexpr (SP2) {
            PG8_LDB(B0, 0, 0); PG8_LDB(B1, 0, 1); PG8_SCHED; PG8_LDA(At, 0, 0); PG8_STAGE(PG8_SA(1, 1), a1 + hstep, voffA);
            PG8_WAIT_V(8); PG8_WAIT_L(0); PG8_BAR; PG8_MMA(0, 0, At, B0); PG8_MMA(0, 1, At, B1); PG8_BAR; PG8_SCHED;
            PG8_LDA(At, 0, 1); PG8_STAGE(PG8_SB(0, 0), b2, voffB); PG8_STAGE(PG8_SB(0, 1), b2 + hstep, voffB); PG8_STAGE(PG8_SA(0, 0), a2, voffA);
            PG8_WAIT_V(8); PG8_WAIT_L(0); PG8_BAR; PG8_MMA(1, 0, At, B0); PG8_MMA(1, 1, At, B1); PG8_BAR; PG8_SCHED;
            PG8_LDB(B0, 1, 0); PG8_LDB(B1, 1, 1); PG8_SCHED; PG8_LDA(At, 1, 0); PG8_STAGE(PG8_SA(0, 1), a2 + hstep, voffA);
            PG8_WAIT_V(8); PG8_WAIT_L(0); PG8_BAR; PG8_MMA(0, 0, At, B0); PG8_MMA(0, 1, At, B1); PG8_BAR; PG8_SCHED;
            PG8_LDA(At, 1, 1); PG8_STAGE(PG8_SB(1, 0), b3, voffB); PG8_STAGE(PG8_SB(1, 1), b3 + hstep, voffB); PG8_STAGE(PG8_SA(1, 0), a3, voffA);
            PG8_WAIT_V(8); PG8_WAIT_L(0); PG8_BAR; PG8_MMA(1, 0, At, B0); PG8_MMA(1, 1, At, B1); PG8_BAR; PG8_SCHED;
            } else {
            PG8_LDB(B0, 0, 0); PG8_SCHED; PG8_LDA(At, 0, 0); PG8_STAGE(PG8_SA(1, 1), a1 + hstep, voffA);
            PG8_WAIT_L(8); PG8_BAR; PG8_WAIT_L(0); PG8_MMA(0, 0, At, B0); PG8_BAR; PG8_SCHED;
            PG8_LDB(B1, 0, 1); PG8_STAGE(PG8_SB(0, 0), b2, voffB);
            PG8_BAR; PG8_WAIT_L(0); PG8_MMA(0, 1, At, B1); PG8_BAR;
            PG8_LDA(At, 0, 1); PG8_STAGE(PG8_SA(0, 0), a2, voffA);
            PG8_BAR; PG8_WAIT_L(0); PG8_MMA(1, 0, At, B0); PG8_BAR; PG8_SCHED;
            PG8_STAGE(PG8_SB(0, 1), b2 + hstep, voffB);
            PG8_WAIT_V(6); PG8_BAR; PG8_MMA(1, 1, At, B1); PG8_BAR;
            PG8_LDB(B0, 1, 0); PG8_SCHED; PG8_LDA(At, 1, 0); PG8_STAGE(PG8_SA(0, 1), a2 + hstep, voffA);
            PG8_WAIT_L(8); PG8_BAR; PG8_WAIT_L(0); PG8_MMA(0, 0, At, B0); PG8_BAR; PG8_SCHED;
            PG8_LDB(B1, 1, 1); PG8_STAGE(PG8_SB(1, 0), b3, voffB);
            PG8_BAR; PG8_WAIT_L(0); PG8_MMA(0, 1, At, B1); PG8_BAR;
            PG8_LDA(At, 1, 1); PG8_STAGE(PG8_SA(1, 0), a3, voffA);
            PG8_BAR; PG8_WAIT_L(0); PG8_MMA(1, 0, At, B0); PG8_BAR; PG8_SCHED;
            PG8_STAGE(PG8_SB(1, 1), b3 + hstep, voffB);
            PG8_WAIT_V(6); PG8_BAR; PG8_MMA(1, 1, At, B1); PG8_BAR;
            }
        }
        if constexpr (ALIGN_EPI) { if (wr == 0) PG8_BAR; }
        if constexpr (!Epi::AFTER_DRAIN) { E(acc, cur, wr, wc, fr, fq); S.done(cur); }
        if (!has_next) break;
#pragma unroll
        for (int a = 0; a < 2; ++a)
#pragma unroll
            for (int b = 0; b < 2; ++b)
#pragma unroll
                for (int m = 0; m < 4; ++m)
#pragma unroll
                    for (int n = 0; n < 2; ++n) acc[a][b][m][n] = (f32x4){0.f, 0.f, 0.f, 0.f};
        cur = nxt; cA = nA; cB = nB; ++ui;
        if constexpr (ALIGN_EPI) { if (wr == 1) PG8_BAR; }
    }
    PG8_WAIT_V(0);
    if constexpr (!ALIGN_EPI) { if (wr == 0) PG8_BAR; }
    PG8_BAR;
    if constexpr (Epi::AFTER_DRAIN) { E.fused(acc, cur, wr, wc, fr, fq, lds, wid, lane); S.done(cur); }
#undef PG8_SA
#undef PG8_SB
#undef PG8_STAGE
#undef PG8_LDA
#undef PG8_LDB
#undef PG8_MMA
#undef PG8_WAIT_V
#undef PG8_WAIT_L
#undef PG8_BAR
#undef PG8_SCHED
}
}

#ifndef PG8_SP2
#define PG8_SP2 true
#endif
#ifndef PG8_ALIGN
#define PG8_ALIGN true
#endif
constexpr int NWAVES = 8;
#ifndef MK_N_LAUNCHES
#define MK_N_LAUNCHES 1
#endif
constexpr int N_PHASES = 13;
constexpr int N_LAUNCHES = MK_N_LAUNCHES;

constexpr int NB = 4, SEQ = 4096, D = 1024, M = NB * SEQ;
constexpr int IN_COLS = 11424;
constexpr int C_Z = 0, C_XBC = 2048, C_DT = 5120, C_RW = 5152, C_WD = 9248, C_AD = 9312, C_GATE = 9376;
constexpr int NT_RW = 17, NT_SSD = 20, NT_GATE = 8, NT_IN = NT_RW + NT_SSD + NT_GATE;
constexpr int NCHUNK = SEQ / 64;
constexpr float EPS = 1e-6f, GN_EPS = 64.0f * 1e-5f;

constexpr size_t MiB = 1u << 20;
constexpr size_t WS_CTL = 0, CTL_ZERO_BYTES = 64 * 1024;
constexpr size_t WS_W2T = 128 * 1024, WS_A2T = 256 * 1024;
constexpr size_t WS_WIN = 1 * MiB;
constexpr size_t WS_WSSM = 24 * MiB, WS_WRWKV = 28 * MiB, WS_WOUT = 30 * MiB;
constexpr size_t WS_RKVG = 32 * MiB;
constexpr size_t WS_GH = 160 * MiB;
constexpr size_t WS_SMALL = 224 * MiB;
constexpr size_t WS_HALO = 240 * MiB;
constexpr size_t WS_SB = 242 * MiB;
constexpr size_t WS_SSQ = 243 * MiB;
constexpr size_t WS_HALOX = 247 * MiB;
constexpr size_t WS_BT = 1 * MiB;
constexpr size_t WS_END = 256 * MiB;
constexpr size_t WS_XBC = 32 * MiB;
constexpr size_t WS_Z = 160 * MiB;
constexpr size_t WS_GATES = 32 * MiB;
constexpr size_t WS_MERGED = 224 * MiB;
constexpr size_t WS_T1 = 96 * MiB;
constexpr size_t WS_YRWKV_OUT = 32 * MiB;
constexpr size_t WS_YRWKV = WS_RKVG + 3 * 32 * MiB;
constexpr int CW_TMO = 0, CW_CODE = 1, CW_BAR = 4096;

constexpr int RING_OFF = 0, RING_BYTES = 131072;
constexpr int LDS_BYTES = 163840;
constexpr int MISC_OFF = LDS_BYTES - 256;
constexpr int LDSCTL_OFF = MISC_OFF;

#define GAS __attribute__((address_space(1)))
#define LAS __attribute__((address_space(3)))
typedef unsigned short bf16;
typedef unsigned v4u __attribute__((ext_vector_type(4)));
typedef float f32x4 __attribute__((ext_vector_type(4)));
typedef short bf16x8 __attribute__((ext_vector_type(8)));
typedef GAS unsigned gu32;
typedef GAS unsigned long long gu64;
#define RLX_AGENT __ATOMIC_RELAXED, __HIP_MEMORY_SCOPE_AGENT
#define LDS_WAIT() asm volatile("s_waitcnt lgkmcnt(0)" ::: "memory")
#define VM_WAIT() asm volatile("s_waitcnt vmcnt(0)" ::: "memory")
__device__ __forceinline__ unsigned long long rt() { return __builtin_amdgcn_s_memrealtime(); }
__device__ __forceinline__ unsigned f2bf(float f) { unsigned u = __builtin_bit_cast(unsigned, f); return (u + 0x7fffu + ((u >> 16) & 1u)) >> 16; }
__device__ __forceinline__ unsigned pk2(float lo, float hi) { typedef float f32x2_t_ __attribute__((ext_vector_type(2))); typedef __bf16 bf16x2_t_ __attribute__((ext_vector_type(2))); f32x2_t_ v = {lo, hi}; bf16x2_t_ b = __builtin_convertvector(v, bf16x2_t_); return __builtin_bit_cast(unsigned, b); }

#define XB_TMO      128
#define XB_XCNT(j)  (256  + 64 * (j))
#define XB_XSUB(j)  (1280 + 64 * (j))
#define XB_XGEN(j)  (2304 + 64 * (j))
#define XB_TOP      3328
#define XB_TOPGEN   3392
#define XCD_BAR_WORDS 3456
#define XB_SPIN_CAP (1u << 18)

__device__ __forceinline__ unsigned xb_ld(unsigned* p)              { return __hip_atomic_load(p, __ATOMIC_RELAXED, __HIP_MEMORY_SCOPE_AGENT); }
__device__ __forceinline__ unsigned xb_add(unsigned* p, unsigned v) { return __hip_atomic_fetch_add(p, v, __ATOMIC_RELAXED, __HIP_MEMORY_SCOPE_AGENT); }
__device__ __forceinline__ unsigned xb_xcc_id() { return (unsigned)__builtin_amdgcn_s_getreg((3 << 11) | 20) & 0xFu; }
#define XB_SPIN(cond, bar) do { unsigned _sp = 0; while (cond) { __builtin_amdgcn_s_sleep(1); \
    if ((++_sp & 255u) == 0u) { if (xb_ld(&(bar)[XB_TMO])) break; if (_sp > XB_SPIN_CAP) { atomicAdd(&(bar)[XB_TMO], 1u); break; } } } } while (0)

struct XcdBarrier {
    unsigned* bar; unsigned x;
    volatile LAS unsigned* st;
};

__device__ __forceinline__ XcdBarrier xcd_barrier_post(unsigned* bar, volatile LAS unsigned* st) {
    XcdBarrier b; b.bar = bar; b.x = xb_xcc_id(); b.st = st;
    if (threadIdx.x == 0) (void)xb_add(&bar[XB_XCNT(b.x)], 1u);
    return b;
}
__device__ __forceinline__ void xcd_barrier_complete(unsigned* bar, unsigned x, unsigned& nloc, unsigned& nx) {
    const unsigned G = gridDim.x * gridDim.y * gridDim.z;
    unsigned sum, cnt, mine, sp = 0u;
    for (;;) {
        sum = 0u; cnt = 0u; mine = 0u;
#pragma unroll
        for (unsigned j = 0; j < 16; ++j) { const unsigned c = xb_ld(&bar[XB_XCNT(j)]); sum += c; cnt += (c > 0u) ? 1u : 0u; mine = (j == x) ? c : mine; }
        if (sum == G) break;
        __builtin_amdgcn_s_sleep(1);
        if ((++sp & 255u) == 0u) { if (xb_ld(&bar[XB_TMO])) break; if (sp > XB_SPIN_CAP) { atomicAdd(&bar[XB_TMO], 1u); break; } }
    }
    nloc = mine > 0u ? mine : 1u; nx = cnt > 0u ? cnt : 1u;
}

__device__ __forceinline__ void xcd_barrier(const XcdBarrier& b) {
    asm volatile("s_waitcnt vmcnt(0)" ::: "memory");
    __syncthreads();
    if (threadIdx.x == 0) {
        unsigned* bar = b.bar;
        __builtin_amdgcn_s_waitcnt(0);
        unsigned nloc = b.st[0], nx = b.st[1];
        if (nloc == 0u) { xcd_barrier_complete(bar, b.x, nloc, nx); b.st[0] = nloc; b.st[1] = nx; }
        const unsigned old = xb_add(&bar[XB_XSUB(b.x)], 1u);
        const unsigned gen = old / nloc;
        if (old + 1u == (gen + 1u) * nloc) {
            __builtin_amdgcn_fence(__ATOMIC_RELEASE, "agent");
            asm volatile("s_waitcnt vmcnt(0)" ::: "memory");
            const unsigned og = xb_add(&bar[XB_TOP], 1u);
            const unsigned tg = og / nx;
            if (og + 1u == (tg + 1u) * nx) xb_add(&bar[XB_TOPGEN], 1u);
            else XB_SPIN(xb_ld(&bar[XB_TOPGEN]) == tg, bar);
            __builtin_amdgcn_fence(__ATOMIC_ACQUIRE, "agent");
            xb_add(&bar[XB_XGEN(b.x)], 1u);
            asm volatile("s_waitcnt vmcnt(0)" ::: "memory");
        } else {
            XB_SPIN(xb_ld(&bar[XB_XGEN(b.x)]) == gen, bar);
            __builtin_amdgcn_fence(__ATOMIC_ACQUIRE, "agent");
            asm volatile("s_waitcnt vmcnt(0)" ::: "memory");
        }
    }
    __syncthreads();
}
struct Args { const float* in[24]; float* out; unsigned char* ws; int ph_lo, ph_hi, li, pad; };
struct Frame {
    LAS unsigned char* lds;
    volatile LAS unsigned* MISC;
    gu32* ctl;
    int tid, lane, wave;
    int vcu, G;
    float* out; unsigned char* ws;
};
__device__ __forceinline__ float wave_sum(float v) {
#pragma unroll
    for (int o = 1; o < 64; o <<= 1) v += __shfl_xor(v, o);
    return v;
}
__device__ __forceinline__ float bf2f(bf16 v) { return __builtin_bit_cast(float, (unsigned)v << 16); }
#define LDS_BARRIER() do { asm volatile("s_waitcnt lgkmcnt(0)" ::: "memory"); __builtin_amdgcn_s_barrier(); asm volatile("" ::: "memory"); } while (0)
__device__ __forceinline__ float bf_lo_(unsigned w) { return __builtin_bit_cast(float, w << 16); }
__device__ __forceinline__ float bf_hi_(unsigned w) { return __builtin_bit_cast(float, w & 0xffff0000u); }
typedef unsigned u32x2_t __attribute__((ext_vector_type(2)));
__device__ __forceinline__ float softplusf_(float x) { return x > 20.f ? x : __logf(1.0f + __expf(x)); }
__device__ __forceinline__ float siluf_(float x) { return x / (1.0f + __expf(-x)); }
__device__ __forceinline__ float sigm_(float x) { return 1.0f / (1.0f + __expf(-x)); }

__device__ __forceinline__ void p0_transpose_item(const float* W, int ldw, int sc0, bf16* WT, int Kd, int dr0, int k0, LAS float* scr, int lane) {
    if (sc0 >= 0) {
#pragma unroll 8
        for (int i = 0; i < 32; ++i) { const int kk = 2 * i + (lane >> 5); scr[kk * 33 + (lane & 31)] = W[(size_t)(k0 + kk) * ldw + sc0 + (lane & 31)]; }
    } else {
#pragma unroll 8
        for (int i = 0; i < 32; ++i) { const int kk = 2 * i + (lane >> 5); scr[kk * 33 + (lane & 31)] = 0.f; }
    }
    LDS_WAIT(); asm volatile("" ::: "memory");
    const int c = lane & 7;
#pragma unroll
    for (int j = 0; j < 4; ++j) { const int n = (lane >> 3) + 8 * j; const LAS float* s = scr + (8 * c) * 33 + n;
        v4u o; o.x = pk2(s[0 * 33], s[1 * 33]); o.y = pk2(s[2 * 33], s[3 * 33]); o.z = pk2(s[4 * 33], s[5 * 33]); o.w = pk2(s[6 * 33], s[7 * 33]);
        *(GAS v4u*)(WT + (size_t)(dr0 + n) * Kd + k0 + 8 * c) = o; }
    LDS_WAIT(); asm volatile("" ::: "memory");
}
__device__ __forceinline__ int win_src_col(int db) {
    if (db < 128) return C_RW + 32 * db;
    if (db < 136) { const int b = db - 128; if (b == 0) return C_DT; if (b <= 2) return C_WD + 32 * (b - 1); if (b <= 4) return C_AD + 32 * (b - 3); return -1; }
    if (db < 200) return C_Z + 32 * (db - 136);
    if (db < 296) return C_XBC + 32 * (db - 200);
    return C_GATE + 32 * (db - 296);
}
__device__ __forceinline__ void p0_prologue(const Args& args, Frame& F) {
    LAS float* scr = (LAS float*)(F.lds + RING_OFF + F.wave * 16384);
    const int gw = F.vcu * NWAVES + F.wave, NGW = F.G * NWAVES;
    bf16* Win_t = (bf16*)(F.ws + WS_WIN); bf16* Wssm_t = (bf16*)(F.ws + WS_WSSM); bf16* Wrwkv_t = (bf16*)(F.ws + WS_WRWKV); bf16* Wout_t = (bf16*)(F.ws + WS_WOUT);
    constexpr int I_IN = 16 * (NT_IN * 8), I_SSM = 32 * 32, I_RW = 16 * 32, I_OUT = 16 * 32;
    constexpr int I_L = 32;
    constexpr int NITEMS = I_IN + I_SSM + I_RW + I_OUT + 2 * I_L;
    for (int it = gw; it < NITEMS; it += NGW) {
        int r = it;
        if (r < I_IN) { const int kb = r / (NT_IN * 8), db = r % (NT_IN * 8); p0_transpose_item(args.in[2], IN_COLS, win_src_col(db), Win_t, D, 32 * db, 64 * kb, scr, F.lane); continue; } r -= I_IN;
        if (r < I_SSM) { const int kb = r / 32, nb = r % 32; p0_transpose_item(args.in[20], D, 32 * nb, Wssm_t, 2048, 32 * nb, 64 * kb, scr, F.lane); continue; } r -= I_SSM;
        if (r < I_RW) { const int kb = r / 32, nb = r % 32; p0_transpose_item(args.in[21], D, 32 * nb, Wrwkv_t, D, 32 * nb, 64 * kb, scr, F.lane); continue; } r -= I_RW;
        if (r < I_OUT) { const int kb = r / 32, nb = r % 32; p0_transpose_item(args.in[22], D, 32 * nb, Wout_t, D, 32 * nb, 64 * kb, scr, F.lane); continue; } r -= I_OUT;
        if (r < I_L) { p0_transpose_item(args.in[12], D, 32 * r, (bf16*)(F.ws + WS_W2T), 64, 32 * r, 0, scr, F.lane); continue; } r -= I_L;
        p0_transpose_item(args.in[14], D, 32 * r, (bf16*)(F.ws + WS_A2T), 64, 32 * r, 0, scr, F.lane);
    }
    bf16* H = (bf16*)F.out; const float* x = args.in[0]; const float* pg = args.in[1];
    f32x4 gv[4];
#pragma unroll
    for (int j = 0; j < 4; ++j) gv[j] = ((const GAS f32x4*)pg)[F.lane + 64 * j];
    for (int m = gw; m < M; m += NGW) {
        const GAS f32x4* xr = (const GAS f32x4*)(x + (size_t)m * D) + F.lane;
        f32x4 v[4]; float s = 0.f;
#pragma unroll
        for (int j = 0; j < 4; ++j) { v[j] = xr[64 * j]; s += (v[j].x * v[j].x + v[j].y * v[j].y) + (v[j].z * v[j].z + v[j].w * v[j].w); }
        const float rstd = 1.f / sqrtf(wave_sum(s) * (1.f / D) + EPS);
        GAS unsigned long long* o8 = (GAS unsigned long long*)(H + (size_t)m * D) + F.lane;
#pragma unroll
        for (int j = 0; j < 4; ++j) { const f32x4 w = v[j] * rstd * gv[j]; o8[64 * j] = (unsigned long long)pk2(w.x, w.y) | ((unsigned long long)pk2(w.z, w.w) << 32); }
    }
}

__device__ __forceinline__ int kidx(int pr, int g, int j) { return 16 * (2 * pr + (j >> 2)) + 4 * g + (j & 3); }
__device__ __forceinline__ size_t fp_off(int row0, int h, int x) { return (size_t)(row0 + (x >> 6)) * 1024 + h * 64 + (x & 63); }
__device__ __forceinline__ bf16x8 pack_tiles(const f32x4& a, const f32x4& b) {
    v4u w; w.x = pk2(a[0], a[1]); w.y = pk2(a[2], a[3]); w.z = pk2(b[0], b[1]); w.w = pk2(b[2], b[3]); return __builtin_bit_cast(bf16x8, w); }

constexpr int RS_ZBUF = 0, RS_GV = 16384, RS_SB = 53824, RS_YB = 54336, RS_PAR = 72768, RS_ROWB = 144;
template <int VAR>
__device__ __forceinline__ void rwkv_scan_mfma(const Args& args, Frame& F, int unit) {
    LAS unsigned char* lds = F.lds;
    const int tid = F.tid, lane = F.lane, w = F.wave, q = lane >> 4, r16 = lane & 15;
    const int h = unit & 15, b = unit >> 4; const bool zw = w < 4; const int wb = w & 3;
    const bf16* Rb = (const bf16*)(F.ws + WS_RKVG); const bf16* Kb = Rb + (size_t)M * 1024; const bf16* Vb = Kb + (size_t)M * 1024;
    bf16* Yo = (bf16*)((unsigned char*)F.out + WS_YRWKV_OUT); const float* SB = (const float*)(F.ws + WS_SB);
    if (tid < 192) { const int k = tid >> 6, cc = tid & 63; const float* src = k == 0 ? args.in[18] + h * 64 : k == 1 ? args.in[19] + h * 64 : args.in[10] + 2048 + h * 64;
        ((LAS float*)(lds + RS_PAR))[tid] = src[cc]; }
    f32x4 Z[4];
#pragma unroll
    for (int i = 0; i < 4; ++i) Z[i] = (f32x4){0.f, 0.f, 0.f, 0.f};
    v4u gf[4][2]; u32x2_t hf[4];
    v4u rf[2]; u32x2_t yf[4];
    v4u sg[3]; float ssb = 0.f;
#define RS_LOAD(cc) do { const bf16* GH_ = (const bf16*)(F.ws + WS_GH) + (size_t)((b * 16 + h) * 64 + (cc)) * 8192; const int row0_ = b * SEQ + (cc) * 64; \
        if (zw) { _Pragma("unroll") for (int i = 0; i < 4; ++i) { gf[i][0] = *(const GAS v4u*)(GH_ + ((i * 2 + 0) * 64 + lane) * 8); gf[i][1] = *(const GAS v4u*)(GH_ + ((i * 2 + 1) * 64 + lane) * 8); \
                hf[i] = *(const GAS u32x2_t*)(GH_ + 4096 + ((i * 4 + wb) * 64 + lane) * 4); } } \
        else { rf[0] = *(const GAS v4u*)(Rb + fp_off(row0_, h, ((wb * 2 + 0) * 64 + lane) * 8)); rf[1] = *(const GAS v4u*)(Rb + fp_off(row0_, h, ((wb * 2 + 1) * 64 + lane) * 8)); \
            _Pragma("unroll") for (int i = 0; i < 4; ++i) yf[i] = *(const GAS u32x2_t*)(Kb + fp_off(row0_, h, ((wb * 4 + i) * 64 + lane) * 4)); } } while (0)
#define RS_GVLOAD(cc) do { const int row0_ = b * SEQ + (cc) * 64; \
        _Pragma("unroll") for (int k = 0; k < 3; ++k) { const int p = tid + 256 * k; sg[k] = (v4u){0u, 0u, 0u, 0u}; \
            if (p < 520) { const int rr = p >> 3, ch = p & 7; \
                if (rr > 0 || (cc) > 0) sg[k] = *(const GAS v4u*)(Vb + (size_t)(row0_ + rr - 1) * 1024 + h * 64 + ch * 8); } } \
        if (tid < 64) ssb = SB[(size_t)(row0_ + tid) * 16 + h]; } while (0)
#define RS_GVSTORE(par) do { \
        _Pragma("unroll") for (int k = 0; k < 3; ++k) { const int p = tid + 256 * k; \
            if (p < 520) { const int rr = p >> 3, ch = p & 7; *(LAS v4u*)(lds + RS_GV + ((par) * 65 + rr) * RS_ROWB + ch * 16) = sg[k]; } } \
        if (tid < 64) ((LAS float*)(lds + RS_SB))[(par) * 64 + tid] = ssb; } while (0)
    RS_LOAD(0);
    if (zw) {
        RS_GVLOAD(0); RS_GVSTORE(0); RS_GVLOAD(1);
        { const bf16x8 z0 = pack_tiles(Z[0], Z[1]);
          *(LAS bf16x8*)(lds + RS_ZBUF + (((0 * 4 + wb) * 2 + 0) * 64 + lane) * 16) = z0; *(LAS bf16x8*)(lds + RS_ZBUF + (((0 * 4 + wb) * 2 + 1) * 64 + lane) * 16) = z0; }
        LDS_BARRIER();
        for (int c = 0; c < NCHUNK; ++c) {
            const int par = c & 1;
            const bf16x8 zp0 = pack_tiles(Z[0], Z[1]), zp1 = pack_tiles(Z[2], Z[3]);
#pragma unroll
            for (int i = 0; i < 4; ++i) {
                f32x4 zn; zn[0] = bf_lo_(hf[i].x); zn[1] = bf_hi_(hf[i].x); zn[2] = bf_lo_(hf[i].y); zn[3] = bf_hi_(hf[i].y);
                zn = __builtin_amdgcn_mfma_f32_16x16x32_bf16(__builtin_bit_cast(bf16x8, gf[i][0]), zp0, zn, 0, 0, 0);
                zn = __builtin_amdgcn_mfma_f32_16x16x32_bf16(__builtin_bit_cast(bf16x8, gf[i][1]), zp1, zn, 0, 0, 0);
                Z[i] = zn; }
            if (c + 1 < NCHUNK) { if (VAR < 2) RS_LOAD(c + 1);
                *(LAS bf16x8*)(lds + RS_ZBUF + ((((par ^ 1) * 4 + wb) * 2 + 0) * 64 + lane) * 16) = pack_tiles(Z[0], Z[1]);
                *(LAS bf16x8*)(lds + RS_ZBUF + ((((par ^ 1) * 4 + wb) * 2 + 1) * 64 + lane) * 16) = pack_tiles(Z[2], Z[3]);
                RS_GVSTORE(par ^ 1); if (VAR < 2 && c + 2 < NCHUNK) RS_GVLOAD(c + 2); }
            if (c > 0) { const int rowp = b * SEQ + (c - 1) * 64;
#pragma unroll
                for (int k = 0; k < 2; ++k) { const int p = tid + 256 * k, t = p >> 3, ch = p & 7;
                    const v4u yv_ = *(const LAS v4u*)(lds + RS_YB + ((par ^ 1) * 64 + t) * RS_ROWB + ch * 16); if (VAR == 0) *(GAS v4u*)(Yo + (size_t)(rowp + t) * 1024 + h * 64 + ch * 8) = yv_; else asm volatile("" :: "v"(yv_)); } }
            LDS_BARRIER();
        }
        { const int rowp = b * SEQ + (NCHUNK - 1) * 64;
#pragma unroll
          for (int k = 0; k < 2; ++k) { const int p = tid + 256 * k, t = p >> 3, ch = p & 7;
            const v4u yv_ = *(const LAS v4u*)(lds + RS_YB + (((NCHUNK - 1) & 1) * 64 + t) * RS_ROWB + ch * 16); if (VAR == 0) *(GAS v4u*)(Yo + (size_t)(rowp + t) * 1024 + h * 64 + ch * 8) = yv_; else asm volatile("" :: "v"(yv_)); } }
        LDS_BARRIER();
    } else {
        LDS_BARRIER();
        for (int c = 0; c < NCHUNK; ++c) {
            const int par = c & 1;
            f32x4 Y[4];
#pragma unroll
            for (int i = 0; i < 4; ++i) {
                const bf16x8 zp0 = *(const LAS bf16x8*)(lds + RS_ZBUF + (((par * 4 + i) * 2 + 0) * 64 + lane) * 16), zp1 = *(const LAS bf16x8*)(lds + RS_ZBUF + (((par * 4 + i) * 2 + 1) * 64 + lane) * 16);
                f32x4 yy; yy[0] = bf_lo_(yf[i].x); yy[1] = bf_hi_(yf[i].x); yy[2] = bf_lo_(yf[i].y); yy[3] = bf_hi_(yf[i].y);
                yy = __builtin_amdgcn_mfma_f32_16x16x32_bf16(zp0, __builtin_bit_cast(bf16x8, rf[0]), yy, 0, 0, 0);
                yy = __builtin_amdgcn_mfma_f32_16x16x32_bf16(zp1, __builtin_bit_cast(bf16x8, rf[1]), yy, 0, 0, 0);
                Y[i] = yy; }
            if (VAR < 2 && c + 1 < NCHUNK) RS_LOAD(c + 1);
            float s1 = 0.f, s2 = 0.f;
#pragma unroll
            for (int i = 0; i < 4; ++i) { s1 += (Y[i][0] + Y[i][1]) + (Y[i][2] + Y[i][3]); s2 += (Y[i][0] * Y[i][0] + Y[i][1] * Y[i][1]) + (Y[i][2] * Y[i][2] + Y[i][3] * Y[i][3]); }
            s1 += __shfl_xor(s1, 16); s1 += __shfl_xor(s1, 32); s2 += __shfl_xor(s2, 16); s2 += __shfl_xor(s2, 32);
            const float mean = s1 * (1.f / 64.f); const float rstd = 1.f / sqrtf(fmaxf(s2 * (1.f / 64.f) - mean * mean, 0.f) + GN_EPS);
            const int t = 16 * wb + r16; const float sbv = ((const LAS float*)(lds + RS_SB))[par * 64 + t];
            const LAS float* PAR = (const LAS float*)(lds + RS_PAR);
#pragma unroll
            for (int i = 0; i < 4; ++i) { const int v0 = 16 * i + 4 * q;
                const f32x4 gng = *(const LAS f32x4*)(PAR + v0), gnb = *(const LAS f32x4*)(PAR + 64 + v0), muv = *(const LAS f32x4*)(PAR + 128 + v0);
                const LAS unsigned char* vp = lds + RS_GV + (par * 65 + t) * RS_ROWB + v0 * 2;
                const u32x2_t pv = *(const LAS u32x2_t*)vp, cv = *(const LAS u32x2_t*)(vp + RS_ROWB);
                float o[4];
#pragma unroll
                for (int e = 0; e < 4; ++e) { const unsigned cvw = cv[e >> 1], pvw = pv[e >> 1];
                    const float cvf = (e & 1) ? bf_hi_(cvw) : bf_lo_(cvw), pvf = (e & 1) ? bf_hi_(pvw) : bf_lo_(pvw);
                    const float vs = cvf + muv[e] * (pvf - cvf);
                    o[e] = (Y[i][e] - mean) * rstd * gng[e] + gnb[e] + sbv * vs; }
                u32x2_t pk; pk.x = pk2(o[0], o[1]); pk.y = pk2(o[2], o[3]); *(LAS u32x2_t*)(lds + RS_YB + (par * 64 + t) * RS_ROWB + v0 * 2) = pk; }
            LDS_BARRIER();
        }
        LDS_BARRIER();
    }
#undef RS_LOAD
#undef RS_GVLOAD
#undef RS_GVSTORE
}

#define TS 65
#define TL(i) (Tb + (i) * (64 * TS))
constexpr int RL_KB = 16640, RL_QR = 33280, RL_KTT = 49920, RL_BTT = 58112, RL_VT = 133120;
constexpr int RL_NN = 99840, RL_AQK = 108032, RL_ARK = 116480, RL_ARB = 124672, RL_DD = 0;
constexpr int RLL_XW = 0, RLL_XA = 8192, RLL_W2 = 16640, RLL_A2 = 24832;
#define C256(base, row, ch) ((base) + (row) * 256 + ((((ch) ^ ((row) & 15))) << 4))
#define C128(base, row, ch) ((base) + (row) * 128 + ((((ch) ^ ((row) & 7))) << 4))
__device__ __forceinline__ bf16x8 pack_tile_lo(const f32x4& a) { v4u w; w.x = pk2(a[0], a[1]); w.y = pk2(a[2], a[3]); w.z = 0u; w.w = 0u; return __builtin_bit_cast(bf16x8, w); }
__device__ __forceinline__ bf16x8 neg_bf16x8(const bf16x8& a) { v4u w = __builtin_bit_cast(v4u, a); w.x ^= 0x80008000u; w.y ^= 0x80008000u; w.z ^= 0x80008000u; w.w ^= 0x80008000u; return __builtin_bit_cast(bf16x8, w); }
__device__ __forceinline__ bf16x8 ld_frag2(LAS unsigned char* lds, int a0, int a1) {
    const u32x2_t lo = *(const LAS u32x2_t*)(lds + a0), hi = *(const LAS u32x2_t*)(lds + a1); v4u w; w.x = lo.x; w.y = lo.y; w.z = hi.x; w.w = hi.y; return __builtin_bit_cast(bf16x8, w); }
#define MFMA16(a, b, c) __builtin_amdgcn_mfma_f32_16x16x32_bf16((a), (b), (c), 0, 0, 0)

__device__ __forceinline__ void rwkv_local_mfma_part(const Args& args, Frame& F, int row0, int b, int h, int c, bool dry) {
    LAS unsigned char* lds = F.lds; LAS float* Tb = (LAS float*)F.lds; LAS float* PL = Tb + 9 * 64 * TS;
    const int tid = F.tid, lane = F.lane, w = F.wave, q = lane >> 4, r16 = lane & 15;
    { const int t = tid >> 3, c8 = (tid & 7) * 8, ch = tid & 7; float v[8]; v4u o;
#define CVT_ROW(TI, IMG, CH) do { _Pragma("unroll") for (int e = 0; e < 8; ++e) v[e] = TL(TI)[t * TS + c8 + e]; o.x = pk2(v[0], v[1]); o.y = pk2(v[2], v[3]); o.z = pk2(v[4], v[5]); o.w = pk2(v[6], v[7]); \
        *(LAS v4u*)(lds + C256(IMG, t, CH)) = o; } while (0)
      CVT_ROW(6, RL_KB, ch); CVT_ROW(0, RL_KB, 8 + ch); CVT_ROW(4, RL_QR, ch); CVT_ROW(5, RL_QR, 8 + ch);
#undef CVT_ROW
      const int cc = tid >> 3, t8 = (tid & 7) * 8;
#define CVT_COL(TI, IMG) do { _Pragma("unroll") for (int e = 0; e < 8; ++e) v[e] = TL(TI)[(t8 + e) * TS + cc]; o.x = pk2(v[0], v[1]); o.y = pk2(v[2], v[3]); o.z = pk2(v[4], v[5]); o.w = pk2(v[6], v[7]); \
        *(LAS v4u*)(lds + C128(IMG, cc, ch)) = o; } while (0)
      CVT_COL(6, RL_KTT); CVT_COL(0, RL_BTT); CVT_COL(7, RL_VT);
#undef CVT_COL
    }
    __syncthreads();
    { const int tb = w >> 1, side = w & 1, t = 16 * tb + r16;
      bf16x8 bq[2];
#pragma unroll
      for (int ks = 0; ks < 2; ++ks) bq[ks] = *(const LAS bf16x8*)(lds + C256(RL_QR, t, 8 * side + 4 * ks + q));
#pragma unroll 1
      for (int ib = 0; ib < 4; ++ib) { f32x4 a0 = (f32x4){0.f, 0.f, 0.f, 0.f}, a1 = (f32x4){0.f, 0.f, 0.f, 0.f};
        if (ib <= tb) {
#pragma unroll
            for (int ks = 0; ks < 2; ++ks) { const bf16x8 fb = *(const LAS bf16x8*)(lds + C256(RL_KB, 16 * ib + r16, 8 + 4 * ks + q)), fk = *(const LAS bf16x8*)(lds + C256(RL_KB, 16 * ib + r16, 4 * ks + q));
                a0 = MFMA16(fb, bq[ks], a0); a1 = MFMA16(fk, bq[ks], a1); } }
        float vb_[4], vk_[4];
#pragma unroll
        for (int e = 0; e < 4; ++e) { const int i = 16 * ib + 4 * q + e; const bool keep = side ? (i <= t) : (i < t); vb_[e] = keep ? (side ? a0[e] : -a0[e]) : 0.f; vk_[e] = keep ? a1[e] : 0.f; }
        u32x2_t pb, pk_; pb.x = pk2(vb_[0], vb_[1]); pb.y = pk2(vb_[2], vb_[3]); pk_.x = pk2(vk_[0], vk_[1]); pk_.y = pk2(vk_[2], vk_[3]);
        const int off = C128(0, t, 2 * ib + (q >> 1)) + (q & 1) * 8;
        *(LAS u32x2_t*)(lds + (side ? RL_ARB : RL_NN) + off) = pb; *(LAS u32x2_t*)(lds + (side ? RL_ARK : RL_AQK) + off) = pk_; } }
    __syncthreads();
    if (w < 4) { const int j = w; f32x4 Pa, Pt, Ta, Tt;
#pragma unroll
        for (int e = 0; e < 4; ++e) { const int rr = 16 * j + 4 * q + e, cc = 16 * j + r16; Pa[e] = bf2f(*(const LAS bf16*)(lds + C128(RL_NN, rr, cc >> 3) + (cc & 7) * 2)); }
        { const u32x2_t x = *(const LAS u32x2_t*)(lds + C128(RL_NN, 16 * j + r16, 2 * j + (q >> 1)) + (q & 1) * 8); Pt[0] = bf_lo_(x.x); Pt[1] = bf_hi_(x.x); Pt[2] = bf_lo_(x.y); Pt[3] = bf_hi_(x.y); }
#pragma unroll
        for (int e = 0; e < 4; ++e) { const float id = (4 * q + e == r16) ? 1.f : 0.f; Ta[e] = Pa[e] + id; Tt[e] = Pt[e] + id; }
#pragma unroll
        for (int rnd = 0; rnd < 3; ++rnd) { const bf16x8 pa = pack_tile_lo(Pa), pt = pack_tile_lo(Pt); const f32x4 z4 = (f32x4){0.f, 0.f, 0.f, 0.f};
            const f32x4 nPa = MFMA16(pt, pa, z4), nPt = MFMA16(pa, pt, z4);
            const bf16x8 npa = pack_tile_lo(nPa), tt = pack_tile_lo(Tt);
            Ta = MFMA16(tt, npa, Ta);
            Tt = MFMA16(npa, tt, Tt);
            Pa = nPa; Pt = nPt; }
        u32x2_t pk_; pk_.x = pk2(Tt[0], Tt[1]); pk_.y = pk2(Tt[2], Tt[3]);
        *(LAS u32x2_t*)(lds + RL_DD + j * 512 + r16 * 32 + q * 8) = pk_; }
    __syncthreads();
    { const int cb = w & 3, side = w >> 2, col = 16 * cb + r16; f32x4 S[4];
      if (side == 0) {
#pragma unroll
        for (int j = 0; j < 4; ++j)
#pragma unroll
            for (int e = 0; e < 4; ++e) S[j][e] = TL(4)[(16 * j + 4 * q + e) * TS + col];
      } else {
        bf16x8 bv[2];
#pragma unroll
        for (int ks = 0; ks < 2; ++ks) bv[ks] = *(const LAS bf16x8*)(lds + C128(RL_VT, col, 4 * ks + q));
#pragma unroll
        for (int j = 0; j < 4; ++j) { f32x4 a = (f32x4){0.f, 0.f, 0.f, 0.f};
#pragma unroll
            for (int ks = 0; ks < 2; ++ks) a = MFMA16(*(const LAS bf16x8*)(lds + C128(RL_AQK, 16 * j + r16, 4 * ks + q)), bv[ks], a);
            S[j] = a; } }
#pragma unroll
      for (int j = 0; j < 4; ++j) { const int t = 16 * j + r16; f32x4 a = S[j];
        if (j == 1) a = MFMA16(ld_frag2(lds, RL_NN + C128(0, t, 0 + (q >> 1)) + (q & 1) * 8, RL_NN + C128(0, t, 0 + (q >> 1)) + (q & 1) * 8), pack_tile_lo(S[0]), a);
        if (j >= 2) a = MFMA16(ld_frag2(lds, RL_NN + C128(0, t, 0 + (q >> 1)) + (q & 1) * 8, RL_NN + C128(0, t, 2 + (q >> 1)) + (q & 1) * 8), pack_tiles(S[0], S[1]), a);
        if (j == 3) a = MFMA16(ld_frag2(lds, RL_NN + C128(0, t, 4 + (q >> 1)) + (q & 1) * 8, RL_NN + C128(0, t, 4 + (q >> 1)) + (q & 1) * 8), pack_tile_lo(S[2]), a);
        const int dd = RL_DD + j * 512 + r16 * 32 + q * 8;
        const f32x4 z4 = (f32x4){0.f, 0.f, 0.f, 0.f}; S[j] = MFMA16(ld_frag2(lds, dd, dd), pack_tile_lo(a), z4); }
      const bf16x8 sp0 = pack_tiles(S[0], S[1]), sp1 = pack_tiles(S[2], S[3]);
      bf16* GH = (bf16*)(F.ws + WS_GH) + (size_t)((b * 16 + h) * 64 + c) * 8192;
      bf16* Rb = (bf16*)(F.ws + WS_RKVG); bf16* Kb = Rb + (size_t)M * 1024;
      if (side == 0) {
#pragma unroll 1
        for (int tb = 0; tb < 4; ++tb) { const int t = 16 * tb + r16; f32x4 a = (f32x4){0.f, 0.f, 0.f, 0.f};
            a = MFMA16(sp0, ld_frag2(lds, RL_ARB + C128(0, t, 0 + (q >> 1)) + (q & 1) * 8, RL_ARB + C128(0, t, 2 + (q >> 1)) + (q & 1) * 8), a);
            a = MFMA16(sp1, ld_frag2(lds, RL_ARB + C128(0, t, 4 + (q >> 1)) + (q & 1) * 8, RL_ARB + C128(0, t, 6 + (q >> 1)) + (q & 1) * 8), a);
            float o[4];
#pragma unroll
            for (int e = 0; e < 4; ++e) o[e] = TL(5)[t * TS + 16 * cb + 4 * q + e] - a[e];
            u32x2_t pk_; pk_.x = pk2(o[0], o[1]); pk_.y = pk2(o[2], o[3]);
            if (!dry) *(GAS u32x2_t*)(Rb + fp_off(row0, h, ((tb * 2 + (cb >> 1)) * 64 + lane) * 8 + 4 * (cb & 1))) = pk_; }
#pragma unroll 1
        for (int kb = 0; kb < 4; ++kb) { const int k = 16 * kb + r16; f32x4 a = (f32x4){0.f, 0.f, 0.f, 0.f};
            a = MFMA16(sp0, ld_frag2(lds, RL_BTT + C128(0, k, 0 + (q >> 1)) + (q & 1) * 8, RL_BTT + C128(0, k, 2 + (q >> 1)) + (q & 1) * 8), a);
            a = MFMA16(sp1, ld_frag2(lds, RL_BTT + C128(0, k, 4 + (q >> 1)) + (q & 1) * 8, RL_BTT + C128(0, k, 6 + (q >> 1)) + (q & 1) * 8), a);
            const float pl = PL[k]; float o[4];
#pragma unroll
            for (int e = 0; e < 4; ++e) o[e] = pl * (((16 * cb + 4 * q + e) == k ? 1.f : 0.f) - a[e]);
            u32x2_t pk_; pk_.x = pk2(o[0], o[1]); pk_.y = pk2(o[2], o[3]);
            if (!dry) *(GAS u32x2_t*)(GH + ((kb * 2 + (cb >> 1)) * 64 + lane) * 8 + 4 * (cb & 1)) = pk_; }
      } else {
        const bf16x8 nsp0 = neg_bf16x8(sp0), nsp1 = neg_bf16x8(sp1);
        bf16x8 av[2];
#pragma unroll
        for (int ks = 0; ks < 2; ++ks) av[ks] = *(const LAS bf16x8*)(lds + C128(RL_VT, col, 4 * ks + q));
#pragma unroll 1
        for (int tb = 0; tb < 4; ++tb) { const int t = 16 * tb + r16; f32x4 a = (f32x4){0.f, 0.f, 0.f, 0.f};
#pragma unroll
            for (int ks = 0; ks < 2; ++ks) a = MFMA16(av[ks], *(const LAS bf16x8*)(lds + C128(RL_ARK, t, 4 * ks + q)), a);
            a = MFMA16(nsp0, ld_frag2(lds, RL_ARB + C128(0, t, 0 + (q >> 1)) + (q & 1) * 8, RL_ARB + C128(0, t, 2 + (q >> 1)) + (q & 1) * 8), a);
            a = MFMA16(nsp1, ld_frag2(lds, RL_ARB + C128(0, t, 4 + (q >> 1)) + (q & 1) * 8, RL_ARB + C128(0, t, 6 + (q >> 1)) + (q & 1) * 8), a);
            u32x2_t pk_; pk_.x = pk2(a[0], a[1]); pk_.y = pk2(a[2], a[3]);
            if (!dry) *(GAS u32x2_t*)(Kb + fp_off(row0, h, ((tb * 4 + cb) * 64 + lane) * 4)) = pk_; }
#pragma unroll 1
        for (int kb = 0; kb < 4; ++kb) { const int k = 16 * kb + r16; f32x4 a = (f32x4){0.f, 0.f, 0.f, 0.f};
#pragma unroll
            for (int ks = 0; ks < 2; ++ks) a = MFMA16(*(const LAS bf16x8*)(lds + C128(RL_KTT, k, 4 * ks + q)), av[ks], a);
            a = MFMA16(ld_frag2(lds, RL_BTT + C128(0, k, 0 + (q >> 1)) + (q & 1) * 8, RL_BTT + C128(0, k, 2 + (q >> 1)) + (q & 1) * 8), nsp0, a);
            a = MFMA16(ld_frag2(lds, RL_BTT + C128(0, k, 4 + (q >> 1)) + (q & 1) * 8, RL_BTT + C128(0, k, 6 + (q >> 1)) + (q & 1) * 8), nsp1, a);
            float o[4];
#pragma unroll
            for (int e = 0; e < 4; ++e) o[e] = PL[16 * kb + 4 * q + e] * a[e];
            u32x2_t pk_; pk_.x = pk2(o[0], o[1]); pk_.y = pk2(o[2], o[3]);
            if (!dry) *(GAS u32x2_t*)(GH + 4096 + ((kb * 4 + cb) * 64 + lane) * 4) = pk_; }
      } }
    __syncthreads();
}

#ifndef RWKV_LOCAL_FAST
#define RWKV_LOCAL_FAST 1
#endif
__device__ __forceinline__ void rwkv_local_simple(const Args& args, Frame& F, int unit, bool dry = false) {
    LAS float* Tb = (LAS float*)F.lds; LAS float* PL = Tb + 9 * 64 * TS;
    const int tid = F.tid, ch = tid & 63, tq = tid >> 6;
    const int h = unit & 15, c = (unit >> 4) & 63, b = unit >> 10;
    const int row0 = b * SEQ + c * 64, hc = h * 64 + ch;
    bf16* Rb = (bf16*)(F.ws + WS_RKVG); bf16* Kb = Rb + (size_t)M * 1024; bf16* Vb = Kb + (size_t)M * 1024;
    const bf16* HALO = (const bf16*)(F.ws + WS_HALO); const float* SMALL = (const float*)(F.ws + WS_SMALL);
    const float* mu = args.in[10]; const float* w0 = args.in[11]; const float* w2 = args.in[12]; const float* a0 = args.in[13]; const float* a2 = args.in[14];
    const float* k_k = args.in[15]; const float* k_a = args.in[16]; const float* r_k = args.in[17];
    { const int t8 = tid >> 3, c8 = (tid & 7) * 8; const size_t rg = (size_t)(row0 + t8); const bool hasp = (c * 64 + t8) > 0;
      const f32x4 z4 = (f32x4){0.f, 0.f, 0.f, 0.f}; const v4u zu = (v4u){0u, 0u, 0u, 0u};
      { const GAS f32x4* sw = (const GAS f32x4*)(SMALL + rg * 256 + 32 + c8); const GAS f32x4* sa = (const GAS f32x4*)(SMALL + rg * 256 + 96 + c8);
        f32x4 cw0 = sw[0], cw1 = sw[1], ca0 = sa[0], ca1 = sa[1], pw0 = z4, pw1 = z4, pa0 = z4, pa1 = z4;
        if (hasp) { pw0 = sw[-64]; pw1 = sw[-63]; pa0 = sa[-64]; pa1 = sa[-63]; }
        const v4u w2v = *(const GAS v4u*)((const bf16*)(F.ws + WS_W2T) + (size_t)(h * 64 + t8) * 64 + c8), a2v = *(const GAS v4u*)((const bf16*)(F.ws + WS_A2T) + (size_t)(h * 64 + t8) * 64 + c8);
        const f32x4 mw0 = *(const GAS f32x4*)(mu + 4096 + c8), mw1 = *(const GAS f32x4*)(mu + 4100 + c8), ma0 = *(const GAS f32x4*)(mu + 4160 + c8), ma1 = *(const GAS f32x4*)(mu + 4164 + c8);
        float xw[8], xa[8];
#pragma unroll
        for (int e = 0; e < 8; ++e) {
          const float cwv = e < 4 ? cw0[e & 3] : cw1[e & 3], pwv = e < 4 ? pw0[e & 3] : pw1[e & 3], cav = e < 4 ? ca0[e & 3] : ca1[e & 3], pav = e < 4 ? pa0[e & 3] : pa1[e & 3];
          const float muw = e < 4 ? mw0[e & 3] : mw1[e & 3], mua = e < 4 ? ma0[e & 3] : ma1[e & 3];
          const float x_ = cwv + muw * (pwv - cwv);
          xw[e] = 1.f - 2.f / (1.f + __expf(2.f * x_)); xa[e] = cav + mua * (pav - cav); }
        v4u o; o.x = pk2(xw[0], xw[1]); o.y = pk2(xw[2], xw[3]); o.z = pk2(xw[4], xw[5]); o.w = pk2(xw[6], xw[7]); *(LAS v4u*)(F.lds + C128(RLL_XW, t8, tid & 7)) = o;
        o.x = pk2(xa[0], xa[1]); o.y = pk2(xa[2], xa[3]); o.z = pk2(xa[4], xa[5]); o.w = pk2(xa[6], xa[7]); *(LAS v4u*)(F.lds + C128(RLL_XA, t8, tid & 7)) = o;
        *(LAS v4u*)(F.lds + C128(RLL_W2, t8, tid & 7)) = w2v; *(LAS v4u*)(F.lds + C128(RLL_A2, t8, tid & 7)) = a2v; }
      asm volatile("" ::: "memory");
      { const v4u cr = *(const GAS v4u*)(Rb + rg * 1024 + h * 64 + c8), ck = *(const GAS v4u*)(Kb + rg * 1024 + h * 64 + c8), cv = *(const GAS v4u*)(Vb + rg * 1024 + h * 64 + c8);
        v4u pr = zu, pk = zu, pv = zu;
        if (t8 > 0) { pr = *(const GAS v4u*)(Rb + (rg - 1) * 1024 + h * 64 + c8); pk = *(const GAS v4u*)(Kb + (rg - 1) * 1024 + h * 64 + c8); pv = *(const GAS v4u*)(Vb + (rg - 1) * 1024 + h * 64 + c8); }
        else if (c > 0) { const bf16* hr = HALO + (size_t)((row0 >> 6) - 1) * 4096 + h * 64 + c8; pr = *(const GAS v4u*)(hr); pk = *(const GAS v4u*)(hr + 1024); pv = *(const GAS v4u*)(hr + 2048); }
        const GAS f32x4* mup = (const GAS f32x4*)(mu + h * 64 + c8);
        const f32x4 mr0 = mup[0], mr1 = mup[1], mk0 = mup[256], mk1 = mup[257], mv0 = mup[512], mv1 = mup[513];
#pragma unroll
        for (int e = 0; e < 8; ++e) { const int o = t8 * TS + c8 + e;
          const unsigned crw = cr[e >> 1], ckw = ck[e >> 1], cvw = cv[e >> 1], prw = pr[e >> 1], pkw = pk[e >> 1], pvw = pv[e >> 1];
          const float crf = (e & 1) ? bf_hi_(crw) : bf_lo_(crw), ckf = (e & 1) ? bf_hi_(ckw) : bf_lo_(ckw), cvf = (e & 1) ? bf_hi_(cvw) : bf_lo_(cvw);
          const float prf = (e & 1) ? bf_hi_(prw) : bf_lo_(prw), pkf = (e & 1) ? bf_hi_(pkw) : bf_lo_(pkw), pvf = (e & 1) ? bf_hi_(pvw) : bf_lo_(pvw);
          const float mur = e < 4 ? mr0[e & 3] : mr1[e & 3], muk = e < 4 ? mk0[e & 3] : mk1[e & 3], muv = e < 4 ? mv0[e & 3] : mv1[e & 3];
          TL(5)[o] = crf + mur * (prf - crf); TL(4)[o] = ckf + muk * (pkf - ckf); TL(7)[o] = cvf + muv * (pvf - cvf); } } }
    __syncthreads();
    { const int lane = F.lane, w = F.wave, q = lane >> 4, r16 = lane & 15, tb = w >> 1;
      bf16x8 fw[2], fa[2];
#pragma unroll
      for (int ks = 0; ks < 2; ++ks) { fw[ks] = *(const LAS bf16x8*)(F.lds + C128(RLL_XW, 16 * tb + r16, 4 * ks + q)); fa[ks] = *(const LAS bf16x8*)(F.lds + C128(RLL_XA, 16 * tb + r16, 4 * ks + q)); }
#pragma unroll
      for (int cc = 0; cc < 2; ++cc) { const int cbk = 2 * (w & 1) + cc, ccol = 16 * cbk + r16; f32x4 aw = (f32x4){0.f, 0.f, 0.f, 0.f}, aa = (f32x4){0.f, 0.f, 0.f, 0.f};
#pragma unroll
        for (int ks = 0; ks < 2; ++ks) { aw = MFMA16(fw[ks], *(const LAS bf16x8*)(F.lds + C128(RLL_W2, ccol, 4 * ks + q)), aw); aa = MFMA16(fa[ks], *(const LAS bf16x8*)(F.lds + C128(RLL_A2, ccol, 4 * ks + q)), aa); }
        const float w0c = w0[h * 64 + ccol], a0c = a0[h * 64 + ccol];
#pragma unroll
        for (int e = 0; e < 4; ++e) { const int t = 16 * tb + 4 * q + e; const float wlog = -softplusf_(-(aw[e] + w0c)) - 0.5f; TL(2)[t * TS + ccol] = -__expf(wlog); TL(3)[t * TS + ccol] = sigm_(aa[e] + a0c); } } }
    __syncthreads();
    { const float kkc = k_k[hc], kac = k_a[hc], rkc = r_k[h * 64 + ch];
#pragma unroll
      for (int i = 0; i < 8; ++i) { const int t = tq + 8 * i; const size_t rg = (size_t)(row0 + t);
        const float rr = TL(5)[t * TS + ch], kx = TL(4)[t * TS + ch];
        const float a = TL(3)[t * TS + ch]; const float kkr = kx * kkc, k2 = kx * (1.f + (a - 1.f) * kac);
        const float nrm = wave_sum(kkr * kkr), sbs = wave_sum(rr * k2 * rkc);
        const float kk = kkr / fmaxf(sqrtf(nrm), 1e-12f);
        TL(4)[t * TS + ch] = kk; TL(6)[t * TS + ch] = k2; TL(0)[t * TS + ch] = kk * a;
        if (ch == 0 && !dry) ((float*)(F.ws + WS_SB))[rg * 16 + h] = sbs; } }
    __syncthreads();
    {
#pragma unroll
      for (int i = 0; i < 8; ++i) { const int cc = 8 * tq + i; float v = TL(2)[ch * TS + cc];
#pragma unroll
        for (int off = 1; off < 64; off <<= 1) { const float t_ = __shfl_up(v, off); if (ch >= off) v += t_; }
        TL(1)[ch * TS + cc] = v; } }
    __syncthreads();
#pragma unroll
    for (int i = 0; i < 8; ++i) { const int t = tq + 8 * i; const float cl = TL(1)[t * TS + ch], ld = TL(2)[t * TS + ch]; const float en = __expf(-cl);
        TL(6)[t * TS + ch] *= en; TL(0)[t * TS + ch] *= en; TL(4)[t * TS + ch] *= __expf(cl - ld); TL(5)[t * TS + ch] *= __expf(cl); if (t == 63) PL[ch] = __expf(cl); }
    __syncthreads();
#if RWKV_LOCAL_FAST
    rwkv_local_mfma_part(args, F, row0, b, h, c, dry); return;
#endif
    { float qb[8], qk[8], rk[8], rb[8];
#pragma unroll
      for (int i = 0; i < 8; ++i) { qb[i] = 0.f; qk[i] = 0.f; rk[i] = 0.f; rb[i] = 0.f; }
#pragma unroll 2
      for (int j = 0; j < 64; ++j) { const float bi = TL(0)[ch * TS + j], ki = TL(6)[ch * TS + j];
#pragma unroll
        for (int i = 0; i < 8; ++i) { const int t = tq + 8 * i; const float q = TL(4)[t * TS + j], r = TL(5)[t * TS + j]; qb[i] += q * bi; qk[i] += q * ki; rk[i] += r * ki; rb[i] += r * bi; } }
      __syncthreads();
#pragma unroll
      for (int i = 0; i < 8; ++i) { const int t = tq + 8 * i; const bool st = ch < t, in = ch <= t;
        TL(1)[t * TS + ch] = st ? qb[i] : 0.f; TL(2)[t * TS + ch] = st ? qk[i] : 0.f; TL(3)[t * TS + ch] = in ? rk[i] : 0.f; TL(8)[t * TS + ch] = in ? rb[i] : 0.f; } }
    __syncthreads();
    { float o[8];
#pragma unroll
      for (int i = 0; i < 8; ++i) o[i] = 0.f;
#pragma unroll 2
      for (int j = 0; j < 64; ++j) { const float vj = TL(7)[j * TS + ch];
#pragma unroll
        for (int i = 0; i < 8; ++i) o[i] += TL(2)[(tq + 8 * i) * TS + j] * vj; }
      __syncthreads();
#pragma unroll
      for (int i = 0; i < 8; ++i) TL(2)[(tq + 8 * i) * TS + ch] = o[i]; }
    __syncthreads();
    if (tid < 128) { LAS float* tile = (tid < 64) ? TL(4) : TL(2); const int col = tid & 63;
#pragma unroll 1
        for (int t = 1; t < 64; ++t) { float s = tile[t * TS + col];
#pragma unroll 4
            for (int i = 0; i < t; ++i) s -= TL(1)[t * TS + i] * tile[i * TS + col];
            tile[t * TS + col] = s; } }
    __syncthreads();
    { float o1[8], o2[8];
#pragma unroll
      for (int i = 0; i < 8; ++i) { o1[i] = TL(5)[(tq + 8 * i) * TS + ch]; o2[i] = 0.f; }
#pragma unroll 2
      for (int j = 0; j < 64; ++j) { const float qj = TL(4)[j * TS + ch], vj = TL(7)[j * TS + ch], xj = TL(2)[j * TS + ch];
#pragma unroll
        for (int i = 0; i < 8; ++i) { const int t = tq + 8 * i; const float arb = TL(8)[t * TS + j], ark = TL(3)[t * TS + j]; o1[i] -= arb * qj; o2[i] += ark * vj - arb * xj; } }
      __syncthreads();
#pragma unroll
      for (int i = 0; i < 8; ++i) { TL(5)[(tq + 8 * i) * TS + ch] = o1[i]; TL(3)[(tq + 8 * i) * TS + ch] = o2[i]; } }
    __syncthreads();
    { bf16* GH = (bf16*)(F.ws + WS_GH) + (size_t)((b * 16 + h) * 64 + c) * 8192;
      const int blk = ch >> 4, gg = (ch & 15) >> 2, jj = ch & 3;
      { float g[8];
#pragma unroll
        for (int i = 0; i < 8; ++i) g[i] = 0.f;
#pragma unroll 2
        for (int t = 0; t < 64; ++t) { const float qh = TL(4)[t * TS + ch];
#pragma unroll
          for (int i = 0; i < 8; ++i) g[i] += TL(0)[t * TS + tq + 8 * i] * qh; }
#pragma unroll
        for (int i = 0; i < 8; ++i) { const int k = tq + 8 * i; const float pl = PL[k];
          const int xfrag = (((k >> 4) * 2 + (blk >> 1)) * 64 + gg * 16 + (k & 15)) * 8 + (blk & 1) * 4 + jj;
          GH[xfrag] = (bf16)f2bf(pl * ((k == ch ? 1.f : 0.f) - g[i]));
          Rb[fp_off(row0, h, xfrag)] = (bf16)f2bf(TL(5)[k * TS + ch]); } }
      { float hh[8];
#pragma unroll
        for (int i = 0; i < 8; ++i) hh[i] = 0.f;
#pragma unroll 2
        for (int t = 0; t < 64; ++t) { const float vm = TL(7)[t * TS + ch], xx = TL(2)[t * TS + ch];
#pragma unroll
          for (int i = 0; i < 8; ++i) { const int k = tq + 8 * i; hh[i] += TL(6)[t * TS + k] * vm - TL(0)[t * TS + k] * xx; } }
#pragma unroll
        for (int i = 0; i < 8; ++i) { const int k = tq + 8 * i; const float pl = PL[k];
          GH[4096 + (((k >> 4) * 4 + (ch >> 4)) * 64 + ((k & 15) >> 2) * 16 + (ch & 15)) * 4 + (k & 3)] = (bf16)f2bf(pl * hh[i]);
          Kb[fp_off(row0, h, (((k >> 4) * 4 + (ch >> 4)) * 64 + ((ch & 15) >> 2) * 16 + (k & 15)) * 4 + (ch & 3))] = (bf16)f2bf(TL(3)[k * TS + ch]); } } }
    __syncthreads();
}

__device__ __forceinline__ void rwkv_scan_simple(const Args& args, Frame& F, int unit) {
    LAS float* Tb = (LAS float*)F.lds;
    const int tid = F.tid, ch = tid & 63, tq = tid >> 6;
    const int h = unit & 15, b = unit >> 4, hc = h * 64 + ch;
    const bf16* Rb = (const bf16*)(F.ws + WS_RKVG); const bf16* Kb = Rb + (size_t)M * 1024; const bf16* Vb = Kb + (size_t)M * 1024; bf16* Gb = (bf16*)(Vb + (size_t)M * 1024);
    const bf16* HALO = (const bf16*)(F.ws + WS_HALO); const float* SB = (const float*)(F.ws + WS_SB);
    const float* mu = args.in[10]; const float gng = args.in[18][hc], gnb = args.in[19][hc]; const float muv = mu[2048 + hc], mug = mu[3072 + hc];
#pragma unroll
    for (int i = 0; i < 8; ++i) TL(0)[(tq + 8 * i) * TS + ch] = 0.f;
    __syncthreads();
    for (int c = 0; c < NCHUNK; ++c) {
        const int row0 = b * SEQ + c * 64;
        const bf16* GH = (const bf16*)(F.ws + WS_GH) + (size_t)((b * 16 + h) * 64 + c) * 8192;
        float gsh[8], vsh[8];
#pragma unroll
        for (int i = 0; i < 8; ++i) { const int t = tq + 8 * i; const size_t rg = (size_t)(row0 + t);
            TL(1)[t * TS + ch] = bf2f(GH[t * 64 + ch]); TL(2)[t * TS + ch] = bf2f(GH[4096 + t * 64 + ch]);
            TL(3)[t * TS + ch] = bf2f(Rb[rg * 1024 + hc]); TL(4)[t * TS + ch] = bf2f(Kb[rg * 1024 + hc]);
            const float cg = bf2f(Gb[rg * 1024 + hc]), cv = bf2f(Vb[rg * 1024 + hc]); float pg = 0.f, pv = 0.f;
            if (t > 0) { pg = bf2f(Gb[(rg - 1) * 1024 + hc]); pv = bf2f(Vb[(rg - 1) * 1024 + hc]); }
            else if (c > 0) { const bf16* hr = HALO + (size_t)((row0 >> 6) - 1) * 4096; pg = bf2f(hr[3072 + hc]); pv = bf2f(hr[2048 + hc]); }
            gsh[i] = cg + mug * (pg - cg); vsh[i] = cv + muv * (pv - cv); }
        __syncthreads();
        float y[8], zn[8];
#pragma unroll
        for (int i = 0; i < 8; ++i) { y[i] = TL(4)[(tq + 8 * i) * TS + ch]; zn[i] = TL(2)[(tq + 8 * i) * TS + ch]; }
#pragma unroll 2
        for (int j = 0; j < 64; ++j) { const float zj = TL(0)[j * TS + ch];
#pragma unroll
            for (int i = 0; i < 8; ++i) { const int t = tq + 8 * i; y[i] += TL(3)[t * TS + j] * zj; zn[i] += TL(1)[t * TS + j] * zj; } }
#pragma unroll
        for (int i = 0; i < 8; ++i) { const int t = tq + 8 * i; const size_t rg = (size_t)(row0 + t);
            const float mean = wave_sum(y[i]) * (1.f / 64.f); const float d = y[i] - mean; const float var = wave_sum(d * d) * (1.f / 64.f);
            float o = d * (1.f / sqrtf(var + GN_EPS)) * gng + gnb + SB[rg * 16 + h] * vsh[i];
            o *= siluf_(gsh[i]);
            Gb[rg * 1024 + hc] = (bf16)f2bf(o); }
        __syncthreads();
#pragma unroll
        for (int i = 0; i < 8; ++i) TL(0)[(tq + 8 * i) * TS + ch] = zn[i];
        __syncthreads();
    }
}

#define TS2 129
__device__ __forceinline__ void ssd_scan_simple(const Args& args, Frame& F, int unit) {
    LAS float* X = (LAS float*)F.lds; LAS float* Bm = X + 64 * TS; LAS float* Cm = Bm + 64 * TS2; LAS float* Gs = Cm + 64 * TS2; LAS float* St = Gs + 64 * TS;
    LAS float* acum = St + 64 * TS2; LAS float* dtv = acum + 64;
    const int tid = F.tid, ch = tid & 63, tq = tid >> 6;
    const int hd = unit & 31, b = unit >> 5, g = hd >> 3;
    const bf16* XBC = (const bf16*)(F.ws + WS_XBC); bf16* Zb = (bf16*)(F.ws + WS_Z); const float* SMALL = (const float*)(F.ws + WS_SMALL); float* SSQ = (float*)(F.ws + WS_SSQ);
    const float* conv_w = args.in[4]; const float* conv_b = args.in[5];
    const float dtb = args.in[6][hd], Aneg = -__expf(args.in[7][hd]), Dsk = args.in[8][hd];
    for (int i = tid; i < 64 * TS2; i += 512) St[i] = 0.f;
    __syncthreads();
    for (int c = 0; c < NCHUNK; ++c) {
        const int row0 = b * SEQ + c * 64;
        { const int chan = hd * 64 + ch; const float w0_ = conv_w[chan], w1_ = conv_w[3072 + chan], w2_ = conv_w[2 * 3072 + chan], w3_ = conv_w[3 * 3072 + chan], cb = conv_b[chan];
#pragma unroll
          for (int i = 0; i < 8; ++i) { const int l = tq + 8 * i; const int tp = c * 64 + l; const size_t rg = (size_t)(row0 + l);
            float a = cb + w3_ * bf2f(XBC[rg * 3072 + chan]);
            if (tp >= 1) a += w2_ * bf2f(XBC[(rg - 1) * 3072 + chan]);
            if (tp >= 2) a += w1_ * bf2f(XBC[(rg - 2) * 3072 + chan]);
            if (tp >= 3) a += w0_ * bf2f(XBC[(rg - 3) * 3072 + chan]);
            X[l * TS + ch] = siluf_(a); } }
        { const int n = tid & 127, lq = tid >> 7;
#pragma unroll
          for (int which = 0; which < 2; ++which) { const int chan = 2048 + which * 512 + g * 128 + n; LAS float* dst = which ? Cm : Bm;
            const float w0_ = conv_w[chan], w1_ = conv_w[3072 + chan], w2_ = conv_w[2 * 3072 + chan], w3_ = conv_w[3 * 3072 + chan], cb = conv_b[chan];
            for (int i = 0; i < 16; ++i) { const int l = lq + 4 * i; const int tp = c * 64 + l; const size_t rg = (size_t)(row0 + l);
                float a = cb + w3_ * bf2f(XBC[rg * 3072 + chan]);
                if (tp >= 1) a += w2_ * bf2f(XBC[(rg - 1) * 3072 + chan]);
                if (tp >= 2) a += w1_ * bf2f(XBC[(rg - 2) * 3072 + chan]);
                if (tp >= 3) a += w0_ * bf2f(XBC[(rg - 3) * 3072 + chan]);
                dst[l * TS2 + n] = siluf_(a); } } }
        if (tid < 64) { const float dt = softplusf_(SMALL[(size_t)(row0 + tid) * 256 + hd] + dtb); dtv[tid] = dt; acum[tid] = dt * Aneg; }
        __syncthreads();
        if (tid == 0) { float s = 0.f; for (int l = 0; l < 64; ++l) { s += acum[l]; acum[l] = s; } }
        __syncthreads();
        { float o[8];
#pragma unroll
          for (int i = 0; i < 8; ++i) o[i] = 0.f;
#pragma unroll 2
          for (int n = 0; n < 128; ++n) { const float bs = Bm[ch * TS2 + n];
#pragma unroll
            for (int i = 0; i < 8; ++i) o[i] += Cm[(tq + 8 * i) * TS2 + n] * bs; }
#pragma unroll
          for (int i = 0; i < 8; ++i) { const int l = tq + 8 * i; Gs[l * TS + ch] = (ch <= l) ? o[i] * __expf(acum[l] - acum[ch]) * dtv[ch] : 0.f; } }
        __syncthreads();
        { float yd[8], yo[8];
#pragma unroll
          for (int i = 0; i < 8; ++i) { yd[i] = 0.f; yo[i] = 0.f; }
#pragma unroll 2
          for (int s = 0; s < 64; ++s) { const float xs = X[s * TS + ch];
#pragma unroll
            for (int i = 0; i < 8; ++i) yd[i] += Gs[(tq + 8 * i) * TS + s] * xs; }
#pragma unroll 2
          for (int n = 0; n < 128; ++n) { const float sp = St[ch * TS2 + n];
#pragma unroll
            for (int i = 0; i < 8; ++i) yo[i] += Cm[(tq + 8 * i) * TS2 + n] * sp; }
#pragma unroll
          for (int i = 0; i < 8; ++i) { const int l = tq + 8 * i; const size_t rg = (size_t)(row0 + l);
            const float yv = yd[i] + __expf(acum[l]) * yo[i] + Dsk * X[l * TS + ch];
            const float z = bf2f(Zb[rg * 2048 + hd * 64 + ch]); const float yz = yv * siluf_(z);
            Zb[rg * 2048 + hd * 64 + ch] = (bf16)f2bf(yz);
            const float ss = wave_sum(yz * yz); if (ch == 0) { SSQ[rg * 64 + hd * 2] = ss; SSQ[rg * 64 + hd * 2 + 1] = 0.f; } } }
        __syncthreads();
        { const int p = tid >> 3, n0 = tid & 7; float o[16]; const float a63 = acum[63]; const float dec = __expf(a63);
#pragma unroll
          for (int i = 0; i < 16; ++i) o[i] = dec * St[p * TS2 + n0 + 8 * i];
#pragma unroll 2
          for (int l = 0; l < 64; ++l) { const float xs = X[l * TS + p] * dtv[l] * __expf(a63 - acum[l]);
#pragma unroll
            for (int i = 0; i < 16; ++i) o[i] += xs * Bm[l * TS2 + n0 + 8 * i]; }
#pragma unroll
          for (int i = 0; i < 16; ++i) St[p * TS2 + n0 + 8 * i] = o[i]; }
        __syncthreads();
    }
}

__device__ __forceinline__ void rwkv_gate_rows(const Args& args, Frame& F) {
    const int gw = F.vcu * NWAVES + F.wave, NGW = F.G * NWAVES, lane = F.lane;
    bf16* Yo = (bf16*)((unsigned char*)F.out + WS_YRWKV_OUT); const bf16* Gb = (const bf16*)(F.ws + WS_RKVG) + (size_t)3 * M * 1024;
    f32x4 mg[4];
#pragma unroll
    for (int j = 0; j < 4; ++j) mg[j] = *(const GAS f32x4*)(args.in[10] + 3072 + lane * 16 + 4 * j);
    for (int m = gw; m < M; m += NGW) {
        GAS v4u* up = (GAS v4u*)(Yo + (size_t)m * 1024 + lane * 16); const GAS v4u* gp = (const GAS v4u*)(Gb + (size_t)m * 1024 + lane * 16);
#define LD16_SC1(p) ({ const unsigned long long a_ = __hip_atomic_load((const GAS unsigned long long*)(p), __ATOMIC_RELAXED, __HIP_MEMORY_SCOPE_AGENT), b_ = __hip_atomic_load((const GAS unsigned long long*)(p) + 1, __ATOMIC_RELAXED, __HIP_MEMORY_SCOPE_AGENT); \
        v4u r_; r_.x = (unsigned)a_; r_.y = (unsigned)(a_ >> 32); r_.z = (unsigned)b_; r_.w = (unsigned)(b_ >> 32); r_; })
        const v4u u0 = LD16_SC1(up), u1 = LD16_SC1(up + 1), g0 = LD16_SC1(gp), g1 = LD16_SC1(gp + 1); v4u p0 = (v4u){0u, 0u, 0u, 0u}, p1 = p0;
        if ((m & (SEQ - 1)) != 0) { p0 = LD16_SC1(gp - 128); p1 = LD16_SC1(gp - 127); }
        v4u o0, o1;
#pragma unroll
        for (int e = 0; e < 4; ++e) {
            { const float gl = bf_lo_(g0[e]), gh = bf_hi_(g0[e]), pl = bf_lo_(p0[e]), ph = bf_hi_(p0[e]); const float ml = mg[e >> 1][(2 * e) & 3], mh = mg[e >> 1][(2 * e + 1) & 3];
              o0[e] = pk2(bf_lo_(u0[e]) * siluf_(gl + ml * (pl - gl)), bf_hi_(u0[e]) * siluf_(gh + mh * (ph - gh))); }
            { const float gl = bf_lo_(g1[e]), gh = bf_hi_(g1[e]), pl = bf_lo_(p1[e]), ph = bf_hi_(p1[e]); const float ml = mg[2 + (e >> 1)][(2 * e) & 3], mh = mg[2 + (e >> 1)][(2 * e + 1) & 3];
              o1[e] = pk2(bf_lo_(u1[e]) * siluf_(gl + ml * (pl - gl)), bf_hi_(u1[e]) * siluf_(gh + mh * (ph - gh))); } }
        up[0] = o0; up[1] = o1;
    }
}
__device__ __forceinline__ void ssd_conv_unit(const Args& args, Frame& F, int wu, bool dry = false) {
    const int lane = F.lane, q = lane & 7, rgp = lane >> 3;
    const int bc = wu / 48, slab = wu - bc * 48, c = bc & 63;
    const int row0 = bc * 64, ch0 = slab * 64 + q * 8;
    bf16* XBC = (bf16*)(F.ws + WS_XBC); const bf16* HALOX = (const bf16*)(F.ws + WS_HALOX);
    const float* conv_w = args.in[4]; const float* conv_b = args.in[5];
    v4u raw[11];
#pragma unroll
    for (int i = 0; i < 11; ++i) { const int l = rgp * 8 - 3 + i;
        if (l >= 0) raw[i] = *(const GAS v4u*)(XBC + (size_t)(row0 + l) * 3072 + ch0);
        else if (c > 0) raw[i] = *(const GAS v4u*)(HALOX + ((size_t)(bc - 1) * 3 + (3 + l)) * 3072 + ch0);
        else raw[i] = (v4u){0u, 0u, 0u, 0u}; }
    float wt[4][8], bs[8];
#pragma unroll
    for (int j = 0; j < 4; ++j) { const f32x4 a = *(const GAS f32x4*)(conv_w + j * 3072 + ch0), b = *(const GAS f32x4*)(conv_w + j * 3072 + ch0 + 4);
        wt[j][0] = a.x; wt[j][1] = a.y; wt[j][2] = a.z; wt[j][3] = a.w; wt[j][4] = b.x; wt[j][5] = b.y; wt[j][6] = b.z; wt[j][7] = b.w; }
    { const f32x4 a = *(const GAS f32x4*)(conv_b + ch0), b = *(const GAS f32x4*)(conv_b + ch0 + 4); bs[0] = a.x; bs[1] = a.y; bs[2] = a.z; bs[3] = a.w; bs[4] = b.x; bs[5] = b.y; bs[6] = b.z; bs[7] = b.w; }
    asm volatile("s_waitcnt vmcnt(0)" ::: "memory");
    float o[8][8];
#pragma unroll
    for (int r = 0; r < 8; ++r)
#pragma unroll
        for (int e = 0; e < 8; ++e) { float a = bs[e];
#pragma unroll
            for (int j = 0; j < 4; ++j) { const unsigned w = raw[r + j][e >> 1]; const float v = (e & 1) ? __builtin_bit_cast(float, w & 0xffff0000u) : __builtin_bit_cast(float, w << 16); a += wt[j][e] * v; }
            o[r][e] = siluf_(a); }
    if (dry) { asm volatile("" :: "v"(o[0][0]), "v"(o[7][7]), "v"(o[3][4])); return; }
    if (slab < 32) {
#pragma unroll
        for (int e = 0; e < 8; ++e) { v4u w; w.x = pk2(o[0][e], o[1][e]); w.y = pk2(o[2][e], o[3][e]); w.z = pk2(o[4][e], o[5][e]); w.w = pk2(o[6][e], o[7][e]);
            *(GAS v4u*)(XBC + (size_t)(row0 + q * 8 + e) * 3072 + slab * 64 + rgp * 8) = w; }
    } else {
#pragma unroll
        for (int r = 0; r < 8; ++r) { v4u w; w.x = pk2(o[r][0], o[r][1]); w.y = pk2(o[r][2], o[r][3]); w.z = pk2(o[r][4], o[r][5]); w.w = pk2(o[r][6], o[r][7]);
            *(GAS v4u*)(XBC + (size_t)(row0 + rgp * 8 + r) * 3072 + ch0) = w; }
        if (slab < 40) { bf16* BT = (bf16*)(F.ws + WS_BT); const int g = (slab - 32) >> 1, n0 = ((slab - 32) & 1) * 64 + q * 8;
#pragma unroll
            for (int e = 0; e < 8; ++e) { v4u w; w.x = pk2(o[0][e], o[1][e]); w.y = pk2(o[2][e], o[3][e]); w.z = pk2(o[4][e], o[5][e]); w.w = pk2(o[6][e], o[7][e]);
                *(GAS v4u*)(BT + ((size_t)(bc * 4 + g) * 128 + n0 + e) * 64 + rgp * 8) = w; } }
    }
}

#define L256(base, row, ch) ((base) + (row) * 256 + ((((ch) ^ ((row) & 15))) << 4))
#define L128(base, row, ch) ((base) + (row) * 128 + ((((ch) ^ ((row) & 7))) << 4))
constexpr int SS_CM = 0, SS_BM = 16384, SS_BT = 32768, SS_XT = 49152, SS_XW = 57344, SS_MM = 65536, SS_STB = 73728, SS_SC = 90112;
struct SsdStage { v4u rC[2], rB[2], rT[2], rX; float rdt; };
struct SsdCtx { const bf16* XBC; const bf16* BT; bf16* Zb; const float* SMALL; float* SSQ; float dtb, Aneg, Dsk; int hd, b, g; int cmrow0, cmrow1, cmch, btrow0, btrow1, btch, xtrow, xtch; };
__device__ __forceinline__ void ssd_stage_load(const SsdCtx& X, SsdStage& S, int cc, int tid) {
    const int row0_ = X.b * SEQ + cc * 64;
    S.rC[0] = *(const GAS v4u*)(X.XBC + (size_t)(row0_ + X.cmrow0) * 3072 + 2560 + X.g * 128 + X.cmch * 8); S.rC[1] = *(const GAS v4u*)(X.XBC + (size_t)(row0_ + X.cmrow1) * 3072 + 2560 + X.g * 128 + X.cmch * 8);
    S.rB[0] = *(const GAS v4u*)(X.XBC + (size_t)(row0_ + X.cmrow0) * 3072 + 2048 + X.g * 128 + X.cmch * 8); S.rB[1] = *(const GAS v4u*)(X.XBC + (size_t)(row0_ + X.cmrow1) * 3072 + 2048 + X.g * 128 + X.cmch * 8);
    S.rT[0] = *(const GAS v4u*)(X.BT + ((size_t)((row0_ >> 6) * 4 + X.g) * 128 + X.btrow0) * 64 + X.btch * 8); S.rT[1] = *(const GAS v4u*)(X.BT + ((size_t)((row0_ >> 6) * 4 + X.g) * 128 + X.btrow1) * 64 + X.btch * 8);
    S.rX = *(const GAS v4u*)(X.XBC + (size_t)(row0_ + X.xtrow) * 3072 + X.hd * 64 + X.xtch * 8);
    if (tid < 64) S.rdt = X.SMALL[(size_t)(row0_ + tid) * 256 + X.hd];
}
__device__ __forceinline__ void ssd_chunk(const SsdCtx& X, SsdStage& S, int c, LAS unsigned char* lds, f32x4 (&accS)[4], int tid, int lane, int w, bool dry) {
    LAS float* dtv = (LAS float*)(lds + SS_SC); LAS float* acum = dtv + 64; LAS float* scl = acum + 64;
    const int q = lane >> 4, r16 = lane & 15; const int hd = X.hd; const int row0 = X.b * SEQ + c * 64;
    *(LAS v4u*)(lds + L256(SS_CM, X.cmrow0, X.cmch)) = S.rC[0]; *(LAS v4u*)(lds + L256(SS_CM, X.cmrow1, X.cmch)) = S.rC[1];
    *(LAS v4u*)(lds + L256(SS_BM, X.cmrow0, X.cmch)) = S.rB[0]; *(LAS v4u*)(lds + L256(SS_BM, X.cmrow1, X.cmch)) = S.rB[1];
    *(LAS v4u*)(lds + L128(SS_BT, X.btrow0, X.btch)) = S.rT[0]; *(LAS v4u*)(lds + L128(SS_BT, X.btrow1, X.btch)) = S.rT[1];
    *(LAS v4u*)(lds + L128(SS_XT, X.xtrow, X.xtch)) = S.rX;
    if (w == 0) { const float dt = softplusf_(S.rdt + X.dtb); float a = dt * X.Aneg;
#pragma unroll
        for (int off = 1; off < 64; off <<= 1) { const float t = __shfl_up(a, off); if (lane >= off) a += t; }
        const float a63 = __shfl(a, 63); dtv[lane] = dt; acum[lane] = a; scl[lane] = dt * __expf(a63 - a); }
    LDS_BARRIER();
    if (c + 2 < NCHUNK) ssd_stage_load(X, S, c + 2, tid);
    { const int sb = w >> 1, s0 = 16 * sb;
#pragma unroll
      for (int t = 0; t < 2; ++t) { const int lb = 2 * (w & 1) + t, l0 = 16 * lb; f32x4 acc = (f32x4){0.f, 0.f, 0.f, 0.f};
        if (sb <= lb) {
#pragma unroll
            for (int ks = 0; ks < 4; ++ks) { const bf16x8 a = *(const LAS bf16x8*)(lds + L256(SS_BM, s0 + r16, 4 * ks + q)); const bf16x8 bb = *(const LAS bf16x8*)(lds + L256(SS_CM, l0 + r16, 4 * ks + q));
                acc = __builtin_amdgcn_mfma_f32_16x16x32_bf16(a, bb, acc, 0, 0, 0); } }
        const int l = l0 + r16; const float al = acum[l]; float v[4];
#pragma unroll
        for (int e = 0; e < 4; ++e) { const int s = s0 + 4 * q + e; v[e] = (s <= l) ? acc[e] * __expf(fminf(al - acum[s], 0.f)) * dtv[s] : 0.f; }
        u32x2_t pk; pk.x = pk2(v[0], v[1]); pk.y = pk2(v[2], v[3]);
        *(LAS u32x2_t*)(lds + L128(SS_MM, l, 2 * sb + (q >> 1)) + (q & 1) * 8) = pk; } }
    { const v4u xv = *(const LAS v4u*)(lds + L128(SS_XT, X.xtrow, X.xtch)); v4u o;
#pragma unroll
      for (int e = 0; e < 4; ++e) { const unsigned ww = xv[e]; const float lo = __builtin_bit_cast(float, ww << 16) * scl[X.xtch * 8 + 2 * e], hi = __builtin_bit_cast(float, ww & 0xffff0000u) * scl[X.xtch * 8 + 2 * e + 1]; o[e] = pk2(lo, hi); }
      *(LAS v4u*)(lds + L128(SS_XW, X.xtrow, X.xtch)) = o; }
    LDS_BARRIER();
    { const int lb = w >> 1, l0 = 16 * lb, l = l0 + r16; const float el = __expf(acum[l]); float ss = 0.f;
#pragma unroll
      for (int t = 0; t < 2; ++t) { const int pb = 2 * (w & 1) + t, p0 = 16 * pb; f32x4 a1 = (f32x4){0.f, 0.f, 0.f, 0.f}, a2 = (f32x4){0.f, 0.f, 0.f, 0.f};
#pragma unroll
        for (int ks = 0; ks < 2; ++ks) { const bf16x8 a = *(const LAS bf16x8*)(lds + L128(SS_XT, p0 + r16, 4 * ks + q)); const bf16x8 bb = *(const LAS bf16x8*)(lds + L128(SS_MM, l0 + r16, 4 * ks + q));
            a1 = __builtin_amdgcn_mfma_f32_16x16x32_bf16(a, bb, a1, 0, 0, 0); }
#pragma unroll
        for (int ks = 0; ks < 4; ++ks) { const bf16x8 a = *(const LAS bf16x8*)(lds + L256(SS_STB, p0 + r16, 4 * ks + q)); const bf16x8 bb = *(const LAS bf16x8*)(lds + L256(SS_CM, l0 + r16, 4 * ks + q));
            a2 = __builtin_amdgcn_mfma_f32_16x16x32_bf16(a, bb, a2, 0, 0, 0); }
        bf16* zp = X.Zb + (size_t)(row0 + l) * 2048 + hd * 64 + p0 + 4 * q; const u32x2_t zz = *(const GAS u32x2_t*)zp; float yv[4];
#pragma unroll
        for (int e = 0; e < 4; ++e) { const int p = p0 + 4 * q + e; const float xlp = bf2f(*(const LAS bf16*)(lds + L128(SS_XT, p, l >> 3) + (l & 7) * 2));
            const unsigned zw = zz[e >> 1]; const float z = (e & 1) ? __builtin_bit_cast(float, zw & 0xffff0000u) : __builtin_bit_cast(float, zw << 16);
            const float y = (a1[e] + el * a2[e] + X.Dsk * xlp) * siluf_(z); yv[e] = y; ss += y * y; }
        u32x2_t pk; pk.x = pk2(yv[0], yv[1]); pk.y = pk2(yv[2], yv[3]); if (!dry) *(GAS u32x2_t*)zp = pk; }
      ss += __shfl_xor(ss, 16); ss += __shfl_xor(ss, 32);
      if (q == 0 && !dry) X.SSQ[(size_t)(row0 + l) * 64 + hd * 2 + (w & 1)] = ss; }
    { const float dec = __expf(acum[63]); const int n0 = 16 * w;
#pragma unroll
      for (int pb = 0; pb < 4; ++pb) { accS[pb] = accS[pb] * dec;
#pragma unroll
        for (int ks = 0; ks < 2; ++ks) { const bf16x8 a = *(const LAS bf16x8*)(lds + L128(SS_BT, n0 + r16, 4 * ks + q)); const bf16x8 bb = *(const LAS bf16x8*)(lds + L128(SS_XW, 16 * pb + r16, 4 * ks + q));
            accS[pb] = __builtin_amdgcn_mfma_f32_16x16x32_bf16(a, bb, accS[pb], 0, 0, 0); } } }
    LDS_BARRIER();
#pragma unroll
    for (int pb = 0; pb < 4; ++pb) { u32x2_t pk; pk.x = pk2(accS[pb][0], accS[pb][1]); pk.y = pk2(accS[pb][2], accS[pb][3]);
        *(LAS u32x2_t*)(lds + L256(SS_STB, 16 * pb + r16, 2 * w + (q >> 1)) + (q & 1) * 8) = pk; }
}
__device__ __forceinline__ void ssd_scan_mfma(const Args& args, Frame& F, int unit, bool dry = false) {
    LAS unsigned char* lds = F.lds;
    const int tid = F.tid, lane = F.lane, w = F.wave;
    SsdCtx X;
    X.hd = unit & 31; X.b = unit >> 5; X.g = X.hd >> 3;
    X.XBC = (const bf16*)(F.ws + WS_XBC); X.BT = (const bf16*)(F.ws + WS_BT); X.Zb = (bf16*)(F.ws + WS_Z); X.SMALL = (const float*)(F.ws + WS_SMALL); X.SSQ = (float*)(F.ws + WS_SSQ);
    X.dtb = args.in[6][X.hd]; X.Aneg = -__expf(args.in[7][X.hd]); X.Dsk = args.in[8][X.hd];
    X.cmrow0 = tid >> 4; X.cmrow1 = (tid + 512) >> 4; X.cmch = tid & 15; X.btrow0 = tid >> 3; X.btrow1 = (tid + 512) >> 3; X.btch = tid & 7; X.xtrow = tid >> 3; X.xtch = tid & 7;
    for (int i = tid; i < 16384 / 16; i += 512) *(LAS v4u*)(lds + SS_STB + i * 16) = (v4u){0u, 0u, 0u, 0u};
    f32x4 accS[4];
#pragma unroll
    for (int i = 0; i < 4; ++i) accS[i] = (f32x4){0.f, 0.f, 0.f, 0.f};
    SsdStage SA, SB_; SA.rdt = 0.f; SB_.rdt = 0.f;
    ssd_stage_load(X, SA, 0, tid); ssd_stage_load(X, SB_, 1, tid);
    for (int c = 0; c < NCHUNK; c += 2) { ssd_chunk(X, SA, c, lds, accS, tid, lane, w, dry); ssd_chunk(X, SB_, c + 1, lds, accS, tid, lane, w, dry); }
    LDS_BARRIER();
}

__device__ __forceinline__ void ssd_norm_rows(const Args& args, Frame& F) {
    const int gw = F.vcu * NWAVES + F.wave, NGW = F.G * NWAVES;
    bf16* Zb = (bf16*)(F.ws + WS_Z); const float* SSQ = (const float*)(F.ws + WS_SSQ); const float* gain = args.in[9];
    for (int m = gw; m < M; m += NGW) {
        const int grp = F.lane >> 4; float ss = 0.f;
#pragma unroll
        for (int j = 0; j < 16; ++j) ss += SSQ[(size_t)m * 64 + grp * 16 + j];
        const float rstd = 1.f / sqrtf(ss * (1.f / 512.f) + EPS);
        GAS v4u* p = (GAS v4u*)(Zb + (size_t)m * 2048 + F.lane * 32);
#pragma unroll
        for (int q = 0; q < 4; ++q) { v4u w = p[q]; const float* gp = gain + F.lane * 32 + q * 8; unsigned o[4];
#pragma unroll
            for (int e = 0; e < 4; ++e) { const unsigned ww = w[e]; const float lo = __builtin_bit_cast(float, ww << 16) * rstd * gp[2 * e], hi = __builtin_bit_cast(float, ww & 0xffff0000u) * rstd * gp[2 * e + 1]; o[e] = pk2(lo, hi); }
            v4u ov; ov.x = o[0]; ov.y = o[1]; ov.z = o[2]; ov.w = o[3]; p[q] = ov; }
    }
}
__device__ __forceinline__ void final_norm_rows(const Args& args, Frame& F) {
    const int gw = F.vcu * NWAVES + F.wave, NGW = F.G * NWAVES;
    const float* x = args.in[0]; const float* pg = args.in[23];
    f32x4 gv[4];
#pragma unroll
    for (int j = 0; j < 4; ++j) gv[j] = ((const GAS f32x4*)pg)[F.lane + 64 * j];
    for (int m = gw; m < M; m += NGW) {
        GAS f32x4* orow = (GAS f32x4*)(F.out + (size_t)m * D) + F.lane; const GAS f32x4* xr = (const GAS f32x4*)(x + (size_t)m * D) + F.lane;
        f32x4 v[4]; float s = 0.f;
#pragma unroll
        for (int j = 0; j < 4; ++j) { v[j] = orow[64 * j]; s += (v[j].x * v[j].x + v[j].y * v[j].y) + (v[j].z * v[j].z + v[j].w * v[j].w); }
        const float rstd = 1.f / sqrtf(wave_sum(s) * (1.f / D) + EPS);
#pragma unroll
        for (int j = 0; j < 4; ++j) orow[64 * j] = xr[64 * j] + v[j] * rstd * gv[j];
    }
}

#ifndef SSD_SIMPLE
#define SSD_SIMPLE 0
#endif
__global__ void __launch_bounds__(NWAVES * 64, 2) hybrid_fwd(Args args) {
    extern __shared__ __attribute__((aligned(16))) unsigned char lds[];
    Frame F;
    F.lds = (LAS unsigned char*)lds;
    F.MISC = (volatile LAS unsigned*)(F.lds + MISC_OFF);
    F.tid = threadIdx.x; F.lane = F.tid & 63; F.wave = __builtin_amdgcn_readfirstlane(F.tid >> 6);
    F.G = gridDim.x; { const int bx = blockIdx.x; F.vcu = (F.G % 8 == 0) ? (bx % 8) * (F.G / 8) + bx / 8 : bx; }
    F.out = args.out; F.ws = args.ws;
    F.ctl = (gu32*)(F.ws + WS_CTL);
    for (int u = F.tid; u < (LDS_BYTES - LDSCTL_OFF) / 4; u += NWAVES * 64) ((LAS unsigned*)(F.lds + LDSCTL_OFF))[u] = 0u;
    __syncthreads();
    XcdBarrier bar; bar.bar = (unsigned*)(F.ctl + CW_BAR); bar.x = 0; bar.st = nullptr;
    if (N_LAUNCHES == 1) bar = xcd_barrier_post((unsigned*)(F.ctl + CW_BAR), F.MISC + 8);
#define GRID_BAR() do { if (N_LAUNCHES == 1) xcd_barrier(bar); } while (0)
    const int lo = args.ph_lo, hi = args.ph_hi;
#ifndef PH_MASK
#define PH_MASK 0x1FFF
#endif
#define IN(k) ((((PH_MASK) >> (k)) & 1) && lo <= (k) && (k) < hi)
#define BOTH(k) (IN(k) && IN((k) + 1))
#ifndef REP_MASK
#define REP_MASK 0
#endif
#define REP(k) (((REP_MASK) >> (k)) & 1)
    bf16* Win_t = (bf16*)(F.ws + WS_WIN);
    bf16* Hb = (bf16*)F.out;

    if (IN(0)) { p0_prologue(args, F); if (REP(0)) { GRID_BAR(); p0_prologue(args, F); } if (BOTH(0)) GRID_BAR(); }
    if (IN(1)) {
      for (int rep = 0; rep < (REP(1) ? 2 : 1); ++rep) {
        pg8::Gemm g{Hb, Win_t, M, NT_RW * 256, D}; pg8::StaticOrder S; S.init(M, NT_RW * 256, F.G, (int)blockIdx.x);
        pg8::EpiRW E{(bf16*)(F.ws + WS_RKVG), (bf16*)(F.ws + WS_HALO), (float*)(F.ws + WS_SMALL), M};
        pg8::gemm_phase<pg8::EpiRW, pg8::StaticOrder, PG8_ALIGN, PG8_SP2>(F.lds + RING_OFF, g, S, E);
        if (rep == 0 && REP(1)) GRID_BAR(); }
        if (BOTH(1)) GRID_BAR();
    }
    if (IN(2)) { if (REP(2)) { for (int u = F.vcu; u < NB * NCHUNK * 16; u += F.G) rwkv_local_simple(args, F, u, true); GRID_BAR(); }
                 for (int u = F.vcu; u < NB * NCHUNK * 16; u += F.G) rwkv_local_simple(args, F, u, false); if (BOTH(2)) GRID_BAR(); }
#ifndef SCAN_VAR
#define SCAN_VAR 1
#endif
    if (IN(3)) { if (REP(3)) { for (int u = (int)blockIdx.x; u < NB * 16; u += F.G) rwkv_scan_mfma<SCAN_VAR>(args, F, u); GRID_BAR(); }
                 for (int u = (int)blockIdx.x; u < NB * 16; u += F.G) rwkv_scan_mfma<0>(args, F, u); if (BOTH(3)) GRID_BAR(); }
    if (IN(4)) {
      for (int rep = 0; rep < (REP(4) ? 2 : 1); ++rep) {
        pg8::Gemm g{Hb, Win_t + (size_t)NT_RW * 256 * D, M, NT_SSD * 256, D}; pg8::StaticOrder S; S.init(M, NT_SSD * 256, F.G, (int)blockIdx.x);
        pg8::EpiSSD E{(bf16*)(F.ws + WS_Z), (bf16*)(F.ws + WS_XBC), (bf16*)(F.ws + WS_HALOX)};
        pg8::gemm_phase<pg8::EpiSSD, pg8::StaticOrder, PG8_ALIGN, PG8_SP2>(F.lds + RING_OFF, g, S, E);
        if (rep == 0 && REP(4)) GRID_BAR(); }
        if (BOTH(4)) GRID_BAR();
    }
#if SSD_SIMPLE
    if (IN(5)) { if (BOTH(5)) GRID_BAR(); }
    if (IN(6)) { for (int u = F.vcu; u < NB * 32; u += F.G) ssd_scan_simple(args, F, u); if (BOTH(6)) GRID_BAR(); }
#else
    if (IN(5)) { if (REP(5)) { for (int wu = F.vcu * NWAVES + F.wave; wu < NB * NCHUNK * 48; wu += F.G * NWAVES) ssd_conv_unit(args, F, wu, true); GRID_BAR(); }
                 for (int wu = F.vcu * NWAVES + F.wave; wu < NB * NCHUNK * 48; wu += F.G * NWAVES) ssd_conv_unit(args, F, wu, false);
                 rwkv_gate_rows(args, F); if (BOTH(5)) GRID_BAR(); }
    if (IN(6)) { if (REP(6)) { for (int u = (int)blockIdx.x; u < NB * 32; u += F.G) ssd_scan_mfma(args, F, u, true); GRID_BAR(); }
                 for (int u = (int)blockIdx.x; u < NB * 32; u += F.G) ssd_scan_mfma(args, F, u, false); if (BOTH(6)) GRID_BAR(); }
#endif
    if (IN(7)) { ssd_norm_rows(args, F); if (BOTH(7)) GRID_BAR(); }
    if (IN(8)) {
      for (int rep = 0; rep < (REP(8) ? 2 : 1); ++rep) {
        pg8::Gemm g{Hb, Win_t + (size_t)(NT_RW + NT_SSD) * 256 * D, M, NT_GATE * 256, D}; pg8::StaticOrder S; S.init(M, NT_GATE * 256, F.G, (int)blockIdx.x);
        pg8::EpiGate E{(bf16*)(F.ws + WS_GATES), args.in[3]};
        pg8::gemm_phase<pg8::EpiGate, pg8::StaticOrder, PG8_ALIGN, PG8_SP2>(F.lds + RING_OFF, g, S, E);
        if (rep == 0 && REP(8)) GRID_BAR(); }
        if (BOTH(8)) GRID_BAR();
    }
    if (IN(9)) {
      for (int rep = 0; rep < (REP(9) ? 2 : 1); ++rep) {
        pg8::Gemm g{(const bf16*)(F.ws + WS_Z), (const bf16*)(F.ws + WS_WSSM), M, D, 2048}; pg8::StaticOrder S; S.init(M, D, F.G, (int)blockIdx.x);
        pg8::EpiT1 E{(float*)(F.ws + WS_T1), (const bf16*)(F.ws + WS_GATES)};
        pg8::gemm_phase<pg8::EpiT1, pg8::StaticOrder, PG8_ALIGN, PG8_SP2>(F.lds + RING_OFF, g, S, E);
        if (rep == 0 && REP(9)) GRID_BAR(); }
        if (BOTH(9)) GRID_BAR();
    }
    if (IN(10)) {
      for (int rep = 0; rep < (REP(10) ? 2 : 1); ++rep) {
        pg8::Gemm g{(const bf16*)((const unsigned char*)F.out + WS_YRWKV_OUT), (const bf16*)(F.ws + WS_WRWKV), M, D, D}; pg8::StaticOrder S; S.init(M, D, F.G, (int)blockIdx.x);
        pg8::EpiMerge E{(bf16*)(F.ws + WS_MERGED), (const float*)(F.ws + WS_T1), (const bf16*)(F.ws + WS_GATES)};
        pg8::gemm_phase<pg8::EpiMerge, pg8::StaticOrder, PG8_ALIGN, PG8_SP2>(F.lds + RING_OFF, g, S, E);
        if (rep == 0 && REP(10)) GRID_BAR(); }
        if (BOTH(10)) GRID_BAR();
    }
    if (IN(11)) {
      for (int rep = 0; rep < (REP(11) ? 2 : 1); ++rep) {
        pg8::Gemm g{(const bf16*)(F.ws + WS_MERGED), (const bf16*)(F.ws + WS_WOUT), M, D, D}; pg8::StaticOrder S; S.init(M, D, F.G, (int)blockIdx.x);
        pg8::EpiF32 E{F.out, D};
        pg8::gemm_phase<pg8::EpiF32, pg8::StaticOrder, PG8_ALIGN, PG8_SP2>(F.lds + RING_OFF, g, S, E);
        if (rep == 0 && REP(11)) GRID_BAR(); }
        if (BOTH(11)) GRID_BAR();
    }
    if (IN(12)) { final_norm_rows(args, F); }
#undef IN
#undef BOTH
}

extern "C" void kernel_launch(void* const* d_in, const int* in_sizes, int n_in, void* d_out, int out_size, void* d_ws, size_t ws_size, hipStream_t stream) {
    static int grid = 0;
    if (grid == 0) {
        if (n_in != 24 || in_sizes[0] != M * D || out_size != M * D || ws_size < WS_END) { fprintf(stderr, "kernel_launch: unexpected shapes (n_in %d, in0 %d, out %d, ws %zu)\n", n_in, n_in > 0 ? in_sizes[0] : -1, out_size, ws_size); grid = -1; return; }
        int dev = 0, cus = 0;
        if (hipGetDevice(&dev) != hipSuccess || hipDeviceGetAttribute(&cus, hipDeviceAttributeMultiprocessorCount, dev) != hipSuccess) { grid = -1; return; }
        if (hipFuncSetAttribute((const void*)hybrid_fwd, hipFuncAttributeMaxDynamicSharedMemorySize, LDS_BYTES) != hipSuccess) { fprintf(stderr, "kernel_launch: hipFuncSetAttribute failed\n"); grid = -1; return; }
        (void)hipGetLastError();
        grid = cus;
    }
    if (grid < 0) return;
    if (hipMemsetAsync((char*)d_ws + WS_CTL, 0, CTL_ZERO_BYTES, stream) != hipSuccess) return;
    Args a{};
    for (int i = 0; i < 24; ++i) a.in[i] = (const float*)d_in[i];
    a.out = (float*)d_out; a.ws = (unsigned char*)d_ws;
    for (int li = 0; li < N_LAUNCHES; ++li) {
        if (N_LAUNCHES == 1) { a.ph_lo = 0; a.ph_hi = N_PHASES; } else { a.ph_lo = li; a.ph_hi = li + 1; }
        a.li = li;
        hipLaunchKernelGGL(hybrid_fwd, dim3(grid), dim3(NWAVES * 64), LDS_BYTES, stream, a);
    }
}
```
